# Optimizing an MI355X kernel written in HIP

```python
import math
import jax, jax.numpy as jnp
from jax import lax
import numpy as np

D_MODEL = 1024
BATCH = 16
SEQ = 256
DEPTH = 4
DEC_BATCH = 4
DEC_SEQ = 2048
PAST_LEN = 256

GRID_W = 64
N_DIRS = 2
D_A = D_MODEL // 4
RW_HEAD = 64
H_A = D_A // RW_HEAD
LORA_W = 64
LORA_A = 64
LORA_G = 128
D_B = D_MODEL // 2
DIFF_DH = 64
H_B = D_B // (2 * DIFF_DH)
D_C = D_MODEL // 4
HY_ORDER = 2
HY_DIRS = 2
HY_BANDS = 16
HY_EMB = 1 + 2 * HY_BANDS
HY_FFN = 64
HY_TARGET = 1e-2
HY_SHORT_PCT = 0.3
HY_LONG_PCT = 1.5
D_FF = 4 * D_MODEL
ROPE_BASE = 10000.0
Q_BLOCK = 128
RMS_EPS = 1e-6
GN_EPS = 64e-5
COL_SIZES = (3 * D_A, 2 * LORA_W, 2 * LORA_A, LORA_G, D_B, D_B, D_B, 3 * D_C)
IN_COLS = sum(COL_SIZES)

kernel_name = 'hybrid_rwkv7_diffattn_hyena_dit_step'


def _rmsnorm(x, g):
    xf = x.astype(jnp.float32)
    y = xf * lax.rsqrt(jnp.mean(xf * xf, axis=-1, keepdims=True) + RMS_EPS)
    return (y * g.astype(jnp.float32)).astype(x.dtype)


def _split_cols(u):
    idx = []
    s = 0
    for n in COL_SIZES[:-1]:
        s += n
        idx.append(s)
    return jnp.split(u, idx, axis=-1)


def _short_conv(u, w):
    up = jnp.pad(u, ((0, 0), (1, 1), (0, 0)))
    return w[0] * up[:, :-2] + w[1] * up[:, 1:-1] + w[2] * up[:, 2:]


def _axial_rope_tables(L):
    rows = L // GRID_W
    row = jnp.repeat(jnp.arange(rows), GRID_W).astype(jnp.float32)
    col = jnp.tile(jnp.arange(GRID_W), rows).astype(jnp.float32)
    half = DIFF_DH // 2
    inv = ROPE_BASE ** (-jnp.arange(0, half, 2, dtype=jnp.float32) / half)
    ang_r = row[:, None] * inv[None]
    ang_c = col[:, None] * inv[None]
    ang = jnp.concatenate([ang_r, ang_r, ang_c, ang_c], axis=-1)
    return jnp.cos(ang), jnp.sin(ang)


def _apply_rope(x, cos, sin):
    x1, x2, x3, x4 = jnp.split(x, 4, axis=-1)
    rot = jnp.concatenate([-x2, x1, -x4, x3], axis=-1)
    cb = cos[None, :, None, None, :]
    sb = sin[None, :, None, None, :]
    return (x.astype(jnp.float32) * cb + rot.astype(jnp.float32) * sb).astype(x.dtype)


def _diff_attention(q, k, v, lam):
    bsz, lq, nh, nm, dh = q.shape
    nb = lq // Q_BLOCK
    qb = jnp.moveaxis(q.reshape(bsz, nb, Q_BLOCK, nh, nm, dh), 1, 0)
    scale = dh ** -0.5

    def block(qblk):
        s = jnp.einsum('bqhmd,bkhmd->bhmqk', qblk, k).astype(jnp.float32) * scale
        p = jax.nn.softmax(s, axis=-1)
        wts = p[:, :, 0] - lam * p[:, :, 1]
        return jnp.einsum('bhqk,bkhe->bqhe', wts.astype(v.dtype), v)

    o = lax.map(block, qb)
    return jnp.moveaxis(o, 0, 1).reshape(bsz, lq, nh, v.shape[-1])


def _rwkv_scan(s0, r, w, kk, a, k, v, reverse):
    xs = tuple(jnp.swapaxes(t, 0, 1) for t in (r, w, kk, a, k, v))

    def step(s, xt):
        r_t, w_t, kk_t, a_t, k_t, v_t = xt
        sa = jnp.einsum('bhvk,bhk->bhv', s, -kk_t)
        s = (s * w_t[:, :, None, :] + sa[..., None] * (kk_t * a_t)[:, :, None, :]
             + v_t[..., None] * k_t[:, :, None, :])
        return s, jnp.einsum('bhvk,bhk->bhv', s, r_t)

    s_fin, ys = lax.scan(step, s0, xs, reverse=reverse)
    return jnp.swapaxes(ys, 0, 1), s_fin


def _rwkv_mix(u_rkv, u_w, u_a, u_g, s0, p):
    bsz, L, _ = u_rkv.shape
    f32 = jnp.float32

    def heads(t):
        return t.astype(f32).reshape(bsz, L, H_A, RW_HEAD)

    rkv = _short_conv(u_rkv, p['rwkv_conv'])
    r, k, v = jnp.split(rkv, 3, axis=-1)
    g = jax.nn.sigmoid(u_g) @ p['rwkv_g2']
    kk = heads(k * p['rwkv_kk'])
    kk = kk * lax.rsqrt(jnp.sum(kk * kk, axis=-1, keepdims=True) + 1e-12)
    rh, vh = heads(r), heads(v)
    uw = jnp.split(u_w, N_DIRS, axis=-1)
    ua = jnp.split(u_a, N_DIRS, axis=-1)
    ys, bonuses, finals = [], [], []
    for d in range(N_DIRS):
        wl = -jax.nn.softplus(-(p['rwkv_w0'][d] + jnp.tanh(uw[d]) @ p['rwkv_w2'][d]).astype(f32)) - 0.5
        decay = jnp.exp(-jnp.exp(wl))
        a = jax.nn.sigmoid(p['rwkv_a0'][d] + ua[d] @ p['rwkv_a2'][d])
        kd = heads(k * (1.0 + (a - 1.0) * p['rwkv_ka']))
        if s0 is None:
            init = jnp.zeros((bsz, H_A, RW_HEAD, RW_HEAD), f32)
        else:
            init = s0[:, d].astype(f32)
        yd, s_fin = _rwkv_scan(init, rh, heads(decay), kk, heads(a), kd, vh, reverse=(d == 1))
        ys.append(yd)
        bonuses.append(jnp.sum(rh * kd * p['rwkv_rk'].astype(f32), axis=-1, keepdims=True) * vh)
        finals.append(s_fin)
    y = ys[0] + ys[1]
    mu = jnp.mean(y, axis=-1, keepdims=True)
    var = jnp.mean(jnp.square(y - mu), axis=-1, keepdims=True)
    yn = ((y - mu) * lax.rsqrt(var + GN_EPS)).reshape(bsz, L, D_A)
    yn = yn * p['rwkv_ln_w'].astype(f32) + p['rwkv_ln_b'].astype(f32)
    out = (yn + (bonuses[0] + bonuses[1]).reshape(bsz, L, D_A)) * g.astype(f32)
    return out.astype(u_rkv.dtype), jnp.stack(finals, axis=1)


def _hyena_filters_freq(L, p):
    f32 = jnp.float32
    t = jnp.linspace(0.0, 1.0, L, dtype=f32)[:, None]
    ang = (2.0 * math.pi / L) * jnp.arange(L, dtype=f32)[:, None]
    bands = jnp.linspace(1e-4, HY_BANDS - 1, HY_BANDS, dtype=f32)[None, :]
    emb = jnp.concatenate([t, jnp.cos(bands * ang), -jnp.sin(bands * ang)], axis=-1)
    freq = p['hy_freq'].astype(f32)
    h = jnp.sin(freq * (emb @ p['hy_w1'].astype(f32) + p['hy_b1'].astype(f32)))
    h = jnp.sin(freq * (h @ p['hy_w2'].astype(f32) + p['hy_b2'].astype(f32)))
    h = (h @ p['hy_w3'].astype(f32)).reshape(L, HY_ORDER, HY_DIRS, D_C)
    h = h * jnp.exp(-t[:, :, None, None] * jnp.abs(p['hy_decay'].astype(f32)))
    h_fwd, h_bwd = h[:, :, 0], h[:, :, 1]
    filt = jnp.concatenate([h_fwd, jnp.zeros((1, HY_ORDER, D_C), f32), h_bwd[:0:-1]], axis=0)
    filt = filt * lax.rsqrt(jnp.sum(filt * filt, axis=0, keepdims=True) + 1e-6)
    return jnp.fft.rfft(filt, axis=0)


def _long_conv(z, filt_f, bias):
    L = z.shape[1]
    zf = jnp.fft.rfft(z.astype(jnp.float32), n=2 * L, axis=1)
    y = jnp.fft.irfft(zf * filt_f[None], n=2 * L, axis=1)[:, :L]
    return (y + bias.astype(jnp.float32) * z.astype(jnp.float32)).astype(z.dtype)


def _hyena_mix(u, p):
    L = u.shape[1]
    u = _short_conv(u, p['hy_conv_w']) + p['hy_conv_b']
    x1, x2, v = jnp.split(u, 3, axis=-1)
    filt_f = _hyena_filters_freq(L, p)
    z = x1 * _long_conv(v, filt_f[:, 0], p['hy_bias'][0])
    z = x2 * _long_conv(z, filt_f[:, 1], p['hy_bias'][1])
    return z


def _trunk_layer(x, mod, p, lam_init, cache):
    bsz, L, _ = x.shape
    f32 = jnp.float32
    sh1, sc1, gt1, sh2, sc2, gt2 = jnp.split(mod, 6, axis=-1)
    h = _rmsnorm(x, p['g_mix_pre']) * (1.0 + sc1) + sh1
    u_rkv, u_w, u_a, u_g, u_q, u_k, u_v, u_hy = _split_cols(h @ p['w_in'])
    y_a, s_fin = _rwkv_mix(u_rkv, u_w, u_a, u_g, None if cache is None else cache[0], p)
    q = u_q.reshape(bsz, L, H_B, 2, DIFF_DH)
    k = u_k.reshape(bsz, L, H_B, 2, DIFF_DH)
    v = u_v.reshape(bsz, L, H_B, 2 * DIFF_DH)
    lam = (jnp.exp(jnp.dot(p['diff_lq1'].astype(f32), p['diff_lk1'].astype(f32)))
           - jnp.exp(jnp.dot(p['diff_lq2'].astype(f32), p['diff_lk2'].astype(f32))) + lam_init)
    if cache is None:
        o = _diff_attention(q, k, v, lam)
    else:
        cos, sin = _axial_rope_tables(L)
        keys = jnp.concatenate([cache[1], _apply_rope(k, cos, sin)], axis=1)
        vals = jnp.concatenate([cache[2], v], axis=1)
        o = _diff_attention(_apply_rope(q, cos, sin), keys, vals, lam)
    y_b = (_rmsnorm(o, p['diff_subln']) * (1.0 - lam_init)).reshape(bsz, L, D_B)
    y_c = _hyena_mix(u_hy, p)
    mix = jnp.concatenate([y_a, y_b.astype(x.dtype), y_c.astype(x.dtype)], axis=-1) @ p['w_out']
    x = x + gt1 * _rmsnorm(mix, p['g_mix_post'])
    h = _rmsnorm(x, p['g_ffn_pre']) * (1.0 + sc2) + sh2
    f = jnp.square(jax.nn.relu(h @ p['w_ff1'])) @ p['w_ff2']
    x = x + gt2 * _rmsnorm(f, p['g_ffn_post'])
    return x, (s_fin, k, v)


def setup_inputs(seed: int = 0) -> dict:
    key = jax.random.key(seed)
    ks = jax.random.split(key, 48)

    def nrm(i, shape, scale=1.0):
        return jax.random.normal(ks[i], shape, jnp.float32) * scale

    D = D_MODEL
    conv_base = jnp.array([0.25, 1.0, 0.25], jnp.float32)[None, :, None]
    hy_rates = jnp.linspace(-math.log(HY_TARGET) / HY_LONG_PCT, -math.log(HY_TARGET) / HY_SHORT_PCT, D_C,
                            dtype=jnp.float32)
    return {
        'x_prompt': nrm(0, (BATCH, SEQ, D)),
        'x_sample': nrm(1, (DEC_BATCH, DEC_SEQ, D)),
        'state_rwkv': nrm(2, (DEC_BATCH, DEPTH, N_DIRS, H_A, RW_HEAD, RW_HEAD), 0.1),
        'cache_k': nrm(3, (DEC_BATCH, DEPTH, PAST_LEN, H_B, 2, DIFF_DH)),
        'cache_v': nrm(4, (DEC_BATCH, DEPTH, PAST_LEN, H_B, 2 * DIFF_DH)),
        'c': nrm(5, (DEC_BATCH, D)),
        'c_ctx': nrm(6, (D,)),
        'w_mod': nrm(7, (DEPTH, D, 6 * D), 0.5 * D ** -0.5),
        'b_mod': nrm(8, (DEPTH, 6 * D), 0.1),
        'g_mix_pre': 1.0 + nrm(9, (DEPTH, D), 0.05),
        'g_mix_post': 1.0 + nrm(10, (DEPTH, D), 0.05),
        'g_ffn_pre': 1.0 + nrm(11, (DEPTH, D), 0.05),
        'g_ffn_post': 1.0 + nrm(12, (DEPTH, D), 0.05),
        'w_in': nrm(13, (DEPTH, D, IN_COLS), D ** -0.5),
        'rwkv_conv': conv_base + nrm(14, (DEPTH, 3, 3 * D_A), 0.05),
        'rwkv_w0': jnp.linspace(-6.0, -1.0, D_A, dtype=jnp.float32) + nrm(15, (DEPTH, N_DIRS, D_A), 0.1),
        'rwkv_w2': nrm(16, (DEPTH, N_DIRS, LORA_W, D_A), 0.5 * LORA_W ** -0.5),
        'rwkv_a0': nrm(17, (DEPTH, N_DIRS, D_A), 0.1),
        'rwkv_a2': nrm(18, (DEPTH, N_DIRS, LORA_A, D_A), 0.5 * LORA_A ** -0.5),
        'rwkv_g2': nrm(19, (DEPTH, LORA_G, D_A), LORA_G ** -0.5),
        'rwkv_kk': 0.85 + nrm(20, (DEPTH, D_A), 0.05),
        'rwkv_ka': 1.0 + nrm(21, (DEPTH, D_A), 0.05),
        'rwkv_rk': nrm(22, (DEPTH, H_A, RW_HEAD), 0.1),
        'rwkv_ln_w': 1.0 + nrm(23, (DEPTH, D_A), 0.05),
        'rwkv_ln_b': nrm(24, (DEPTH, D_A), 0.02),
        'diff_lq1': nrm(25, (DEPTH, DIFF_DH), 0.1),
        'diff_lk1': nrm(26, (DEPTH, DIFF_DH), 0.1),
        'diff_lq2': nrm(27, (DEPTH, DIFF_DH), 0.1),
        'diff_lk2': nrm(28, (DEPTH, DIFF_DH), 0.1),
        'diff_subln': 1.0 + nrm(29, (DEPTH, 2 * DIFF_DH), 0.05),
        'hy_conv_w': conv_base + nrm(30, (DEPTH, 3, 3 * D_C), 0.05),
        'hy_conv_b': nrm(31, (DEPTH, 3 * D_C), 0.02),
        'hy_w1': nrm(32, (DEPTH, HY_EMB, HY_FFN), HY_EMB ** -0.5),
        'hy_b1': nrm(33, (DEPTH, HY_FFN), 0.1),
        'hy_freq': 1.0 + nrm(34, (DEPTH, HY_FFN), 0.05),
        'hy_w2': nrm(35, (DEPTH, HY_FFN, HY_FFN), HY_FFN ** -0.5),
        'hy_b2': nrm(36, (DEPTH, HY_FFN), 0.1),
        'hy_w3': nrm(37, (DEPTH, HY_FFN, HY_ORDER * HY_DIRS * D_C), HY_FFN ** -0.5),
        'hy_decay': hy_rates * (1.0 + nrm(38, (DEPTH, D_C), 0.05)),
        'hy_bias': nrm(39, (DEPTH, HY_ORDER, D_C), 0.1),
        'w_out': nrm(40, (DEPTH, D, D), D ** -0.5),
        'w_ff1': nrm(41, (DEPTH, D, D_FF), D ** -0.5),
        'w_ff2': nrm(42, (DEPTH, D_FF, D), D_FF ** -0.5),
    }


def reference(x_prompt, x_sample, state_rwkv, cache_k, cache_v, c, c_ctx, w_mod, b_mod,
              g_mix_pre, g_mix_post, g_ffn_pre, g_ffn_post, w_in, rwkv_conv, rwkv_w0, rwkv_w2,
              rwkv_a0, rwkv_a2, rwkv_g2, rwkv_kk, rwkv_ka, rwkv_rk, rwkv_ln_w, rwkv_ln_b,
              diff_lq1, diff_lk1, diff_lq2, diff_lk2, diff_subln, hy_conv_w, hy_conv_b,
              hy_w1, hy_b1, hy_freq, hy_w2, hy_b2, hy_w3, hy_decay, hy_bias,
              w_out, w_ff1, w_ff2):
    xp = x_prompt
    xs = x_sample
    st_list, k_list, v_list = [], [], []
    for l in range(DEPTH):
        p = {
            'g_mix_pre': g_mix_pre[l], 'g_mix_post': g_mix_post[l],
            'g_ffn_pre': g_ffn_pre[l], 'g_ffn_post': g_ffn_post[l],
            'w_in': w_in[l], 'rwkv_conv': rwkv_conv[l], 'rwkv_w0': rwkv_w0[l], 'rwkv_w2': rwkv_w2[l],
            'rwkv_a0': rwkv_a0[l], 'rwkv_a2': rwkv_a2[l], 'rwkv_g2': rwkv_g2[l],
            'rwkv_kk': rwkv_kk[l], 'rwkv_ka': rwkv_ka[l], 'rwkv_rk': rwkv_rk[l],
            'rwkv_ln_w': rwkv_ln_w[l], 'rwkv_ln_b': rwkv_ln_b[l],
            'diff_lq1': diff_lq1[l], 'diff_lk1': diff_lk1[l], 'diff_lq2': diff_lq2[l],
            'diff_lk2': diff_lk2[l], 'diff_subln': diff_subln[l],
            'hy_conv_w': hy_conv_w[l], 'hy_conv_b': hy_conv_b[l], 'hy_w1': hy_w1[l], 'hy_b1': hy_b1[l],
            'hy_freq': hy_freq[l], 'hy_w2': hy_w2[l], 'hy_b2': hy_b2[l], 'hy_w3': hy_w3[l],
            'hy_decay': hy_decay[l], 'hy_bias': hy_bias[l],
            'w_out': w_out[l], 'w_ff1': w_ff1[l], 'w_ff2': w_ff2[l],
        }
        lam_init = 0.8 - 0.6 * math.exp(-0.3 * l)
        mod_ctx = (jax.nn.silu(c_ctx) @ w_mod[l] + b_mod[l])[None, None, :]
        xp, (s_ctx, k_ctx, v_ctx) = _trunk_layer(xp, mod_ctx, p, lam_init, None)
        st_list.append(s_ctx.astype(x_prompt.dtype))
        k_list.append(k_ctx)
        v_list.append(v_ctx)
        mod_lat = (jax.nn.silu(c) @ w_mod[l] + b_mod[l])[:, None, :]
        xs, _ = _trunk_layer(xs, mod_lat, p, lam_init, (state_rwkv[:, l], cache_k[:, l], cache_v[:, l]))
    new_state_rwkv = jnp.stack(st_list, axis=1)
    new_cache_k = jnp.stack(k_list, axis=1)
    new_cache_v = jnp.stack(v_list, axis=1)
    return (xp, xs, new_state_rwkv, new_cache_k, new_cache_v)
```

```cpp
#include <hip/hip_runtime.h>
#include <hip/hip_cooperative_groups.h>
#include <stdint.h>
#include <stdio.h>
namespace cg = cooperative_groups;

#ifndef ONE_LAUNCH
#define ONE_LAUNCH 0
#endif

#define DI __device__ __forceinline__
typedef unsigned short u16;
using bf16x8 = __attribute__((ext_vector_type(8))) short;
using s16x4  = __attribute__((ext_vector_type(4))) short;
using f32x4  = __attribute__((ext_vector_type(4))) float;
using f32x16 = __attribute__((ext_vector_type(16))) float;

constexpr int NT = 512;
constexpr int TT = 12288;
constexpr int NU = 3456;
constexpr size_t LDS_BYTES = 110592;

constexpr size_t WS_CTL = 0;
constexpr size_t WS_MOD = 4096;
constexpr size_t WS_W   = WS_MOD + 491520;
constexpr size_t W_IN_B = 3584ull * 1024 * 2, W_OUT_B = 1024ull * 1024 * 2, W_FF_B = 4096ull * 1024 * 2;
constexpr size_t W_SLOT = W_IN_B + W_OUT_B + 2 * W_FF_B;
constexpr size_t WS_H   = WS_W + 2 * W_SLOT;
constexpr size_t WS_U   = WS_H + (size_t)TT * 1024 * 2;
constexpr size_t WS_MIXCAT = WS_U + (size_t)TT * NU * 2;
constexpr size_t WS_KL  = WS_MIXCAT + (size_t)TT * 1024 * 2;
constexpr size_t WS_VL  = WS_KL + 4ull * 2304 * 512 * 2;
constexpr size_t WS_RW  = WS_VL + 4ull * 2304 * 512 * 2;
constexpr size_t WS_G   = WS_RW + (size_t)TT * 4 * 9 * 64 * 4;
constexpr size_t WS_BC  = WS_G + (size_t)TT * 256 * 4;
constexpr size_t WS_HYT = WS_BC + (size_t)TT * 4 * 4;
constexpr size_t WS_FILT = WS_HYT + 3ull * 256 * TT * 4;
constexpr size_t WS_END = WS_FILT + 2ull * 256 * (512 + 4096) * 4;
constexpr size_t WS_Q  = WS_H;
constexpr size_t WS_KC = WS_Q + (size_t)TT * 512 * 2;
constexpr size_t WS_VC = WS_KC + 16ull * 256 * 512 * 2;
constexpr size_t WS_YS = WS_U;
constexpr size_t WS_YC = WS_U + 2ull * TT * 256 * 4;
constexpr size_t WS_F  = WS_U;
constexpr size_t WS_A  = WS_RW;
static_assert(WS_VC + 16ull * 256 * 512 * 2 <= WS_U, "alias");
static_assert(WS_YC + 256ull * TT * 4 <= WS_MIXCAT, "alias");
static_assert((size_t)TT * 4096 * 2 <= (size_t)TT * 4 * 9 * 64 * 4, "alias");

constexpr size_t OUT_STATE = 12582912, OUT_CK = 14680064, OUT_CV = 23068672;

struct Params {
  const float* in[43];
  float* out;
  unsigned char* ws;
};

DI u16 f2bf(float x) { unsigned u = __float_as_uint(x); u += 0x7fffu + ((u >> 16) & 1u); return (u16)(u >> 16); }
DI float bf2f(u16 b) { return __uint_as_float(((unsigned)b) << 16); }
DI unsigned pack2(float a, float b) { return (unsigned)f2bf(a) | ((unsigned)f2bf(b) << 16); }
DI float wave_sum(float v) {
#pragma unroll
  for (int o = 32; o > 0; o >>= 1) v += __shfl_xor(v, o);
  return v;
}
template <int CTRL> DI float dppf(float x) {
  return __builtin_bit_cast(float, __builtin_amdgcn_update_dpp(0, __builtin_bit_cast(int, x), CTRL, 0xF, 0xF, true));
}
DI float allreduce16(float x) {
  x += dppf<0xB1>(x); x += dppf<0x4E>(x); x += dppf<0x124>(x); x += dppf<0x128>(x);
  return x;
}
DI void seq_of(int row, int& s, int& t, int& L, int& row0) {
  if (row < 4096) { s = row >> 8; t = row & 255; L = 256; row0 = s * 256; }
  else { int r = row - 4096; s = 16 + (r >> 11); t = r & 2047; L = 2048; row0 = 4096 + (r >> 11) * 2048; }
}
DI int otid() { int t = threadIdx.x; asm volatile("" : "+v"(t)); return t; }
DI float sigmoidf_(float x) { return 1.f / (1.f + expf(-x)); }

DI void tr_tile(const float* __restrict__ W, int K, int N, u16* __restrict__ Wt, int k0, int n0, float* lds) {
  const int tid = otid();
#pragma unroll
  for (int i = 0; i < 8; ++i) { int idx = tid + i * 512; int kk = idx >> 6, nn = idx & 63; lds[kk * 65 + nn] = W[(size_t)(k0 + kk) * N + n0 + nn]; }
  __syncthreads();
  const int n = tid >> 3, kg = tid & 7;
  unsigned pk[4];
#pragma unroll
  for (int j = 0; j < 4; ++j) pk[j] = pack2(lds[(kg * 8 + 2 * j) * 65 + n], lds[(kg * 8 + 2 * j + 1) * 65 + n]);
  *(uint4*)(Wt + (size_t)(n0 + n) * K + k0 + kg * 8) = make_uint4(pk[0], pk[1], pk[2], pk[3]);
  __syncthreads();
}

DI void filt_item(const Params& p, int l, int it, float* lds) {
  const int Lsel = it >= 32; const int chunk = Lsel ? it - 32 : it; const int L = Lsel ? 2048 : 256;
  float* emb = lds; float* h1 = lds + 8 * 36; float* h2 = h1 + 512;
  const int tid = otid();
  const float* w1 = p.in[32] + l * 33 * 64; const float* b1 = p.in[33] + l * 64; const float* fr = p.in[34] + l * 64;
  const float* w2 = p.in[35] + l * 4096; const float* b2 = p.in[36] + l * 64; const float* w3 = p.in[37] + (size_t)l * 64 * 1024;
  const float* dec = p.in[38] + l * 256;
  if (tid < 8 * 33) {
    int ti = tid / 33, j = tid % 33; int i = chunk * 8 + ti; float v;
    float ang = (float)(2.0 * 3.14159265358979323846 / (double)L) * (float)i;
    if (j == 0) v = (float)i / (float)(L - 1);
    else if (j <= 16) { float band = 1e-4f + (float)(j - 1) * ((15.f - 1e-4f) / 15.f); v = cosf(band * ang); }
    else { float band = 1e-4f + (float)(j - 17) * ((15.f - 1e-4f) / 15.f); v = -sinf(band * ang); }
    emb[ti * 36 + j] = v;
  }
  __syncthreads();
  { int ti = tid >> 6, j = tid & 63; float a = b1[j]; for (int k = 0; k < 33; ++k) a += emb[ti * 36 + k] * w1[k * 64 + j]; h1[ti * 64 + j] = sinf(fr[j] * a); }
  __syncthreads();
  { int ti = tid >> 6, j = tid & 63; float a = b2[j]; for (int k = 0; k < 64; ++k) a += h1[ti * 64 + k] * w2[k * 64 + j]; h2[ti * 64 + j] = sinf(fr[j] * a); }
  __syncthreads();
  float* FILT = (float*)(p.ws + WS_FILT) + (Lsel ? 262144 : 0);
#pragma unroll
  for (int cc = 0; cc < 2; ++cc) {
    int col = tid + cc * 512; float acc[8];
#pragma unroll
    for (int ti = 0; ti < 8; ++ti) acc[ti] = 0.f;
    for (int k = 0; k < 64; ++k) { float w = w3[k * 1024 + col];
#pragma unroll
      for (int ti = 0; ti < 8; ++ti) acc[ti] += h2[ti * 64 + k] * w; }
    int order = col >> 9, dir = (col >> 8) & 1, c = col & 255; float dc = fabsf(dec[c]);
    float* g = FILT + (size_t)(order * 256 + c) * (2 * L);
#pragma unroll
    for (int ti = 0; ti < 8; ++ti) {
      int i = chunk * 8 + ti; float t = (float)i / (float)(L - 1); float val = acc[ti] * expf(-t * dc);
      if (dir == 0) g[L + i] = val; else { if (i == 0) g[0] = 0.f; else g[L - i] = val; }
    }
  }
  __syncthreads();
}

constexpr int AUX_ITEMS = 864 + 256 + 1024 + 1024 + 1 + 288;
DI void aux_item(const Params& p, int l, int it, float* lds) {
  unsigned char* slot = p.ws + WS_W + (size_t)(l & 1) * W_SLOT;
  u16* win = (u16*)slot; u16* wout = (u16*)(slot + W_IN_B); u16* wff1 = (u16*)(slot + W_IN_B + W_OUT_B); u16* wff2 = (u16*)(slot + W_IN_B + W_OUT_B + W_FF_B);
  if (it < 864) { int kt = it / 54, nt = it % 54; tr_tile(p.in[13] + (size_t)l * 1024 * NU, 1024, NU, win, kt * 64, nt * 64, lds); return; }
  it -= 864;
  if (it < 256) { int kt = it >> 4, nt = it & 15; tr_tile(p.in[40] + (size_t)l * 1024 * 1024, 1024, 1024, wout, kt * 64, nt * 64, lds); return; }
  it -= 256;
  if (it < 1024) { int kt = it >> 6, nt = it & 63; tr_tile(p.in[41] + (size_t)l * 1024 * 4096, 1024, 4096, wff1, kt * 64, nt * 64, lds); return; }
  it -= 1024;
  if (it < 1024) { int kt = it >> 4, nt = it & 15; tr_tile(p.in[42] + (size_t)l * 4096 * 1024, 4096, 1024, wff2, kt * 64, nt * 64, lds); return; }
  it -= 1024;
  if (it < 1) { uint4* z = (uint4*)(win + (size_t)NU * 1024); for (int i = otid(); i < 16384; i += 512) z[i] = make_uint4(0, 0, 0, 0); return; }
  it -= 1;
  filt_item(p, l, it, lds);
}

DI void mod_item(const Params& p, int it, float* lds) {
  const int l = it / 96, cgp = it % 96, tid = otid();
  float* sc = lds; float* red = lds + 5120;
  for (int i = tid; i < 5120; i += 512) { int j = i >> 10, k = i & 1023; float c = (j == 0) ? p.in[6][k] : p.in[5][(j - 1) * 1024 + k]; sc[i] = c / (1.f + expf(-c)); }
  __syncthreads();
  const int c = tid & 63, kg = tid >> 6; const float* w = p.in[7] + (size_t)l * 1024 * 6144 + cgp * 64 + c;
  float acc[5] = {0.f, 0.f, 0.f, 0.f, 0.f};
  for (int k = kg; k < 1024; k += 8) { float wv = w[(size_t)k * 6144];
#pragma unroll
    for (int j = 0; j < 5; ++j) acc[j] += sc[j * 1024 + k] * wv; }
#pragma unroll
  for (int j = 0; j < 5; ++j) red[(kg * 5 + j) * 64 + c] = acc[j];
  __syncthreads();
  if (tid < 320) { int j = tid >> 6, cc = tid & 63; float s = 0.f; for (int g = 0; g < 8; ++g) s += red[(g * 5 + j) * 64 + cc];
    s += p.in[8][l * 6144 + cgp * 64 + cc]; ((float*)(p.ws + WS_MOD))[(l * 5 + j) * 6144 + cgp * 64 + cc] = s; }
  __syncthreads();
}

DI void row_phase(const Params& p, int l, int mode) {
  const int tid = otid(), lane = tid & 63; const int gw = blockIdx.x * 8 + (tid >> 6), nw = gridDim.x * 8;
  float* x = p.out; const float* F = (const float*)(p.ws + WS_F); u16* H = (u16*)(p.ws + WS_H); const float* MOD = (const float*)(p.ws + WS_MOD);
  const float* gpost = nullptr; const float* gpre = nullptr; int gate_ch = 0, sc_ch = 0, sh_ch = 0, lm = l; bool do_h = true;
  if (mode == 0) { gpre = p.in[9] + l * 1024; sc_ch = 1; sh_ch = 0; lm = l; }
  else if (mode == 1) { gpost = p.in[10] + l * 1024; gate_ch = 2; gpre = p.in[11] + l * 1024; sc_ch = 4; sh_ch = 3; lm = l; }
  else { gpost = p.in[12] + l * 1024; gate_ch = 5; if (l < 3) { gpre = p.in[9] + (l + 1) * 1024; sc_ch = 1; sh_ch = 0; lm = l + 1; } else do_h = false; }
  for (int row = gw; row < TT; row += nw) {
    const int j = row < 4096 ? 0 : 1 + ((row - 4096) >> 11);
    const float* xs = (mode == 0) ? (row < 4096 ? p.in[0] + (size_t)row * 1024 : p.in[1] + (size_t)(row - 4096) * 1024) : x + (size_t)row * 1024;
    float4 xv[4];
#pragma unroll
    for (int i = 0; i < 4; ++i) xv[i] = *(const float4*)(xs + i * 256 + lane * 4);
    if (mode != 0) {
      float4 dv[4]; float ss = 0.f;
#pragma unroll
      for (int i = 0; i < 4; ++i) { dv[i] = *(const float4*)(F + (size_t)row * 1024 + i * 256 + lane * 4); ss += dv[i].x * dv[i].x + dv[i].y * dv[i].y + dv[i].z * dv[i].z + dv[i].w * dv[i].w; }
      ss = wave_sum(ss); const float rs = rsqrtf(ss * (1.f / 1024.f) + 1e-6f);
      const float* gt = MOD + (l * 5 + j) * 6144 + gate_ch * 1024;
#pragma unroll
      for (int i = 0; i < 4; ++i) { int col = i * 256 + lane * 4; float4 g4 = *(const float4*)(gt + col); float4 p4 = *(const float4*)(gpost + col);
        xv[i].x += g4.x * dv[i].x * rs * p4.x; xv[i].y += g4.y * dv[i].y * rs * p4.y; xv[i].z += g4.z * dv[i].z * rs * p4.z; xv[i].w += g4.w * dv[i].w * rs * p4.w; }
    }
#pragma unroll
    for (int i = 0; i < 4; ++i) *(float4*)(x + (size_t)row * 1024 + i * 256 + lane * 4) = xv[i];
    if (do_h) {
      float ss = 0.f;
#pragma unroll
      for (int i = 0; i < 4; ++i) ss += xv[i].x * xv[i].x + xv[i].y * xv[i].y + xv[i].z * xv[i].z + xv[i].w * xv[i].w;
      ss = wave_sum(ss); const float rs = rsqrtf(ss * (1.f / 1024.f) + 1e-6f);
      const float* sc = MOD + (lm * 5 + j) * 6144 + sc_ch * 1024; const float* sh = MOD + (lm * 5 + j) * 6144 + sh_ch * 1024;
#pragma unroll
      for (int i = 0; i < 4; ++i) { int col = i * 256 + lane * 4; float4 g4 = *(const float4*)(gpre + col); float4 s4 = *(const float4*)(sc + col); float4 h4 = *(const float4*)(sh + col);
        float a = xv[i].x * rs * g4.x * (1.f + s4.x) + h4.x, b = xv[i].y * rs * g4.y * (1.f + s4.y) + h4.y;
        float c = xv[i].z * rs * g4.z * (1.f + s4.z) + h4.z, d = xv[i].w * rs * g4.w * (1.f + s4.w) + h4.w;
        *(uint2*)(H + (size_t)row * 1024 + col) = make_uint2(pack2(a, b), pack2(c, d)); }
    }
  }
}

template <int EPI>
DI void gemm_phase(const Params& p, const u16* __restrict__ A, const u16* __restrict__ Wt, int K, int NTn, int l, void* Cout, int ldc, unsigned char* smem) {
  u16* As = (u16*)smem; u16* Bs = As + 2 * 128 * 72;
  const int tid = otid(), lane = tid & 63, wid = tid >> 6, wm = wid & 1, wn = wid >> 1, fr = lane & 15, fq = lane >> 4;
  const int ntiles = 96 * NTn, nk = K / 64;
  for (int tile = blockIdx.x; tile < ntiles; tile += gridDim.x) {
    const int mt = tile / NTn, nt = tile % NTn; const int m0 = mt * 128, n0 = nt * 256;
    f32x4 acc[4][4];
#pragma unroll
    for (int i = 0; i < 4; ++i)
#pragma unroll
      for (int j = 0; j < 4; ++j) acc[i][j] = f32x4{0.f, 0.f, 0.f, 0.f};
    uint4 ra[2], rb[4];
    const int lrow = tid >> 3, lkc = tid & 7;
    const u16* ag = A + (size_t)(m0 + lrow) * K + lkc * 8;
    const u16* bg = Wt + (size_t)(n0 + lrow) * K + lkc * 8;
#define GLOAD(kt) { _Pragma("unroll") for (int i = 0; i < 2; ++i) ra[i] = *(const uint4*)(ag + (size_t)i * 64 * K + (kt) * 64); \
                    _Pragma("unroll") for (int i = 0; i < 4; ++i) rb[i] = *(const uint4*)(bg + (size_t)i * 64 * K + (kt) * 64); }
#define SSTORE(buf) { _Pragma("unroll") for (int i = 0; i < 2; ++i) *(uint4*)(As + (buf) * 128 * 72 + (lrow + i * 64) * 72 + lkc * 8) = ra[i]; \
                      _Pragma("unroll") for (int i = 0; i < 4; ++i) *(uint4*)(Bs + (buf) * 256 * 72 + (lrow + i * 64) * 72 + lkc * 8) = rb[i]; }
    GLOAD(0); SSTORE(0); __syncthreads();
    for (int kt = 0; kt < nk; ++kt) {
      if (kt + 1 < nk) GLOAD(kt + 1);
      const u16* as = As + (kt & 1) * 128 * 72 + (wm * 64 + fr) * 72 + fq * 8;
      const u16* bs = Bs + (kt & 1) * 256 * 72 + (wn * 64 + fr) * 72 + fq * 8;
#pragma unroll
      for (int ks = 0; ks < 2; ++ks) {
        bf16x8 wf[4], af[4];
#pragma unroll
        for (int i = 0; i < 4; ++i) { wf[i] = *(const bf16x8*)(bs + i * 16 * 72 + ks * 32); af[i] = *(const bf16x8*)(as + i * 16 * 72 + ks * 32); }
#pragma unroll
        for (int i = 0; i < 4; ++i)
#pragma unroll
          for (int j = 0; j < 4; ++j) acc[i][j] = __builtin_amdgcn_mfma_f32_16x16x32_bf16(wf[i], af[j], acc[i][j], 0, 0, 0);
      }
      if (kt + 1 < nk) SSTORE((kt + 1) & 1);
      __syncthreads();
    }
#undef GLOAD
#undef SSTORE
#pragma unroll
    for (int i = 0; i < 4; ++i)
#pragma unroll
      for (int j = 0; j < 4; ++j) {
        const int row = m0 + wm * 64 + j * 16 + fr; const int col = n0 + wn * 64 + i * 16 + fq * 4; const f32x4 v = acc[i][j];
        if (EPI == 0) {
          if (col < NU) {
            *(uint2*)((u16*)Cout + (size_t)row * NU + col) = make_uint2(pack2(v[0], v[1]), pack2(v[2], v[3]));
            if (row < 4096 && col >= 1664 && col < 2688) {
              int b = row >> 8, t = row & 255;
              float* dst = (col < 2176) ? p.out + OUT_CK + ((size_t)((b * 4 + l) * 256 + t)) * 512 + (col - 1664)
                                        : p.out + OUT_CV + ((size_t)((b * 4 + l) * 256 + t)) * 512 + (col - 2176);
              *(float4*)dst = make_float4(v[0], v[1], v[2], v[3]);
            }
          }
        } else if (EPI == 1) {
          *(float4*)((float*)Cout + (size_t)row * ldc + col) = make_float4(v[0], v[1], v[2], v[3]);
        } else {
          float a = fmaxf(v[0], 0.f), b = fmaxf(v[1], 0.f), c = fmaxf(v[2], 0.f), d = fmaxf(v[3], 0.f);
          *(uint2*)((u16*)Cout + (size_t)row * ldc + col) = make_uint2(pack2(a * a, b * b), pack2(c * c, d * d));
        }
      }
  }
}

DI void rwkv_prep_item(const Params& p, int l, int tile, float* lds) {
  const int tid = otid();
  const int rowb = tile * 32; int s, t0, L, row0; seq_of(rowb, s, t0, L, row0);
  const u16* U = (const u16*)(p.ws + WS_U);
  float* tw = lds; float* ua = lds + 4096; float* sg = lds + 8192;
  for (int idx = tid; idx < 32 * 384; idx += 512) {
    int tok = idx / 384, c = idx % 384; float v = bf2f(U[(size_t)(rowb + tok) * NU + 768 + c]);
    if (c < 128) tw[tok * 128 + c] = tanhf(v); else if (c < 256) ua[tok * 128 + c - 128] = v; else sg[tok * 128 + c - 256] = sigmoidf_(v);
  }
  __syncthreads();
  const int c = tid & 255, tg = tid >> 8, h = c >> 6;
  float ag[16], awf[16], awb[16], aaf[16], aab[16];
#pragma unroll
  for (int i = 0; i < 16; ++i) { ag[i] = 0.f; awf[i] = 0.f; awb[i] = 0.f; aaf[i] = 0.f; aab[i] = 0.f; }
  const float* g2 = p.in[19] + (size_t)l * 128 * 256 + c; const float* w2 = p.in[16] + (size_t)l * 2 * 64 * 256 + c; const float* a2 = p.in[18] + (size_t)l * 2 * 64 * 256 + c;
  for (int k = 0; k < 128; k += 4) {
    float w0 = g2[(k) * 256], w1 = g2[(k + 1) * 256], w2_ = g2[(k + 2) * 256], w3 = g2[(k + 3) * 256];
#pragma unroll
    for (int tt = 0; tt < 16; ++tt) { float4 sv = *(const float4*)(sg + (tg * 16 + tt) * 128 + k); ag[tt] += sv.x * w0 + sv.y * w1 + sv.z * w2_ + sv.w * w3; }
  }
  for (int k = 0; k < 64; k += 4) {
    float wf[4], wb[4], af[4], ab[4];
#pragma unroll
    for (int q = 0; q < 4; ++q) { wf[q] = w2[(k + q) * 256]; wb[q] = w2[(64 + k + q) * 256]; af[q] = a2[(k + q) * 256]; ab[q] = a2[(64 + k + q) * 256]; }
#pragma unroll
    for (int tt = 0; tt < 16; ++tt) {
      const int tok = tg * 16 + tt;
      float4 t1 = *(const float4*)(tw + tok * 128 + k), t2 = *(const float4*)(tw + tok * 128 + 64 + k);
      float4 u1 = *(const float4*)(ua + tok * 128 + k), u2 = *(const float4*)(ua + tok * 128 + 64 + k);
      awf[tt] += t1.x * wf[0] + t1.y * wf[1] + t1.z * wf[2] + t1.w * wf[3];
      awb[tt] += t2.x * wb[0] + t2.y * wb[1] + t2.z * wb[2] + t2.w * wb[3];
      aaf[tt] += u1.x * af[0] + u1.y * af[1] + u1.z * af[2] + u1.w * af[3];
      aab[tt] += u2.x * ab[0] + u2.y * ab[1] + u2.z * ab[2] + u2.w * ab[3];
    }
  }
  const float* cw = p.in[14] + (size_t)l * 3 * 768;
  float cr[3], ck[3], cv[3];
#pragma unroll
  for (int q = 0; q < 3; ++q) { cr[q] = cw[q * 768 + c]; ck[q] = cw[q * 768 + 256 + c]; cv[q] = cw[q * 768 + 512 + c]; }
  const float kkw = p.in[20][l * 256 + c], ka = p.in[21][l * 256 + c], rk = p.in[22][l * 256 + c];
  const float w0f = p.in[15][(l * 2 + 0) * 256 + c], w0b = p.in[15][(l * 2 + 1) * 256 + c];
  const float a0f = p.in[17][(l * 2 + 0) * 256 + c], a0b = p.in[17][(l * 2 + 1) * 256 + c];
  float* RW = (float*)(p.ws + WS_RW); float* G = (float*)(p.ws + WS_G); float* BC = (float*)(p.ws + WS_BC);
#pragma unroll
  for (int tt = 0; tt < 16; ++tt) {
    const int tok = tg * 16 + tt, row = rowb + tok, t = t0 + tok;
    const u16* ur = U + (size_t)row * NU + c;
    float r0 = bf2f(ur[0]), k0 = bf2f(ur[256]), v0 = bf2f(ur[512]);
    float rm = 0.f, km = 0.f, vm = 0.f, rp = 0.f, kp = 0.f, vp = 0.f;
    if (t > 0) { rm = bf2f(ur[-NU]); km = bf2f(ur[256 - NU]); vm = bf2f(ur[512 - NU]); }
    if (t + 1 < L) { rp = bf2f(ur[NU]); kp = bf2f(ur[256 + NU]); vp = bf2f(ur[512 + NU]); }
    const float r = cr[0] * rm + cr[1] * r0 + cr[2] * rp;
    const float k = ck[0] * km + ck[1] * k0 + ck[2] * kp;
    const float v = cv[0] * vm + cv[1] * v0 + cv[2] * vp;
    const float kkr = k * kkw; const float ss = wave_sum(kkr * kkr); const float kk = kkr * rsqrtf(ss + 1e-12f);
    const float sgf = sigmoidf_(w0f + awf[tt]); const float decf = expf(-0.60653066f * sgf);
    const float sgb = sigmoidf_(w0b + awb[tt]); const float decb = expf(-0.60653066f * sgb);
    const float af_ = sigmoidf_(a0f + aaf[tt]), ab_ = sigmoidf_(a0b + aab[tt]);
    const float kdf = k * (1.f + (af_ - 1.f) * ka), kdb = k * (1.f + (ab_ - 1.f) * ka);
    const float bonus = wave_sum(r * (kdf + kdb) * rk);
    float* dst = RW + ((size_t)(row * 4 + h) * 9) * 64 + (c & 63);
    dst[0] = r; dst[64] = kk; dst[128] = v; dst[192] = decf; dst[256] = kk * af_; dst[320] = kdf; dst[384] = decb; dst[448] = kk * ab_; dst[512] = kdb;
    G[(size_t)row * 256 + c] = ag[tt];
    if ((c & 63) == 0) BC[row * 4 + h] = bonus;
  }
  __syncthreads();
}

DI void attn_prep_item(const Params& p, int l, int tile) {
  const int tid = otid();
  const int rowb = tile * 32; int s, t0, L, row0; seq_of(rowb, s, t0, L, row0);
  const bool lat = s >= 16;
  const u16* U = (const u16*)(p.ws + WS_U);
  u16* Q = (u16*)(p.ws + WS_Q);
  u16* Kd = lat ? (u16*)(p.ws + WS_KL) + ((size_t)(s - 16) * 2304 + 256) * 512 : (u16*)(p.ws + WS_KC) + (size_t)s * 256 * 512;
  u16* Vd = lat ? (u16*)(p.ws + WS_VL) + ((size_t)(s - 16) * 2304 + 256) * 512 : (u16*)(p.ws + WS_VC) + (size_t)s * 256 * 512;
  for (int uidx = tid; uidx < 2048; uidx += 512) {
    const int g = uidx & 1, pb = (uidx >> 1) & 1, hm = (uidx >> 2) & 7, which = (uidx >> 5) & 1, tok = uidx >> 6;
    const int row = rowb + tok, t = t0 + tok;
    const u16* src = U + (size_t)row * NU + (which ? 1664 : 1152) + hm * 64 + pb * 32 + g * 8;
    const uint4 va = *(const uint4*)src; const uint4 vb = *(const uint4*)(src + 16);
    const unsigned wa[4] = {va.x, va.y, va.z, va.w}, wb[4] = {vb.x, vb.y, vb.z, vb.w};
    float oa[8], ob[8];
#pragma unroll
    for (int j = 0; j < 8; ++j) {
      float xa = bf2f((u16)(wa[j >> 1] >> ((j & 1) * 16))), xb = bf2f((u16)(wb[j >> 1] >> ((j & 1) * 16)));
      if (lat) {
        const int pidx = pb == 0 ? (t >> 6) : (t & 63); const int i = g * 8 + j;
        const float inv = exp2f(-(float)(2 * i) * (13.287712379549449f / 32.f)); const float ang = (float)pidx * inv;
        const float cs = cosf(ang), sn = sinf(ang);
        oa[j] = xa * cs - xb * sn; ob[j] = xb * cs + xa * sn;
      } else { oa[j] = xa; ob[j] = xb; }
    }
    u16* dst = (which == 0) ? Q + (size_t)row * 512 + hm * 64 + pb * 32 + g * 8 : Kd + (size_t)t * 512 + hm * 64 + pb * 32 + g * 8;
    *(uint4*)dst = make_uint4(pack2(oa[0], oa[1]), pack2(oa[2], oa[3]), pack2(oa[4], oa[5]), pack2(oa[6], oa[7]));
    *(uint4*)(dst + 16) = make_uint4(pack2(ob[0], ob[1]), pack2(ob[2], ob[3]), pack2(ob[4], ob[5]), pack2(ob[6], ob[7]));
  }
  for (int uidx = tid; uidx < 2048; uidx += 512) {
    const int tok = uidx >> 6, ch = uidx & 63;
    *(uint4*)(Vd + (size_t)(t0 + tok) * 512 + ch * 8) = *(const uint4*)(U + (size_t)(rowb + tok) * NU + 2176 + ch * 8);
  }
}

DI void cache_item(const Params& p, int l, int it) {
  const int b = it >> 3, pc = it & 7;
  u16* KL = (u16*)(p.ws + WS_KL); u16* VL = (u16*)(p.ws + WS_VL);
  for (int idx = otid(); idx < 32 * 128; idx += 512) {
    const int r = idx >> 7, c4 = idx & 127, prow = pc * 32 + r;
    const size_t so = ((size_t)(b * 4 + l) * 256 + prow) * 512 + c4 * 4; const size_t d_o = ((size_t)b * 2304 + prow) * 512 + c4 * 4;
    float4 kv = *(const float4*)(p.in[3] + so); float4 vv = *(const float4*)(p.in[4] + so);
    *(uint2*)(KL + d_o) = make_uint2(pack2(kv.x, kv.y), pack2(kv.z, kv.w));
    *(uint2*)(VL + d_o) = make_uint2(pack2(vv.x, vv.y), pack2(vv.z, vv.w));
  }
}

DI void hy_prep_item(const Params& p, int l, int tile, float* lds) {
  const int tid = otid();
  const int rowb = tile * 64; int s, t0, L, row0; seq_of(rowb, s, t0, L, row0);
  const u16* U = (const u16*)(p.ws + WS_U); float* HYT = (float*)(p.ws + WS_HYT);
  for (int which = 0; which < 3; ++which) {
    const int c = tid & 255, tg = tid >> 8, col = which * 256 + c;
    const float w0 = p.in[30][(size_t)l * 3 * 768 + col], w1 = p.in[30][(size_t)l * 3 * 768 + 768 + col], w2 = p.in[30][(size_t)l * 3 * 768 + 1536 + col];
    const float bias = p.in[31][l * 768 + col];
    for (int tt = 0; tt < 32; ++tt) {
      const int tok = tg * 32 + tt, row = rowb + tok, t = t0 + tok;
      const u16* ur = U + (size_t)row * NU + 2688 + col;
      float um = t > 0 ? bf2f(ur[-NU]) : 0.f, u0 = bf2f(ur[0]), up = (t + 1 < L) ? bf2f(ur[NU]) : 0.f;
      lds[tok * 257 + c] = w0 * um + w1 * u0 + w2 * up + bias;
    }
    __syncthreads();
    const int cc = tid >> 1, half = tid & 1;
    float* dst = HYT + (size_t)(which * 256 + cc) * TT + rowb + half * 32;
#pragma unroll
    for (int i = 0; i < 32; i += 4) {
      float4 v = make_float4(lds[(half * 32 + i) * 257 + cc], lds[(half * 32 + i + 1) * 257 + cc], lds[(half * 32 + i + 2) * 257 + cc], lds[(half * 32 + i + 3) * 257 + cc]);
      *(float4*)(dst + i) = v;
    }
    __syncthreads();
  }
}

DI void scan_item(const Params& p, int l, int s, int h, int d, int rg, float* lds) {
  int L, row0; if (s < 16) { L = 256; row0 = s * 256; } else { L = 2048; row0 = 4096 + (s - 16) * 2048; }
  const float* RW = (const float*)(p.ws + WS_RW); float* YS = (float*)(p.ws + WS_YS) + (size_t)d * TT * 256;
  const int tid = otid(), lane = tid & 63, wid = tid >> 6, lane16 = lane & 15, rsub = lane >> 4;
  const int row = rg * 16 + (wid & 3) * 4 + rsub;
  float4 st = make_float4(0.f, 0.f, 0.f, 0.f);
  if (s >= 16 && wid < 4) st = *(const float4*)(p.in[2] + ((((size_t)(s - 16) * 4 + l) * 2 + d) * 4 + h) * 4096 + row * 64 + lane16 * 4);
  const int nch = L / 32;
  float4 pre0, pre1, pre2, pre3, pre4, pre5;
  auto ldpre = [&](int ch, int j) -> float4 {
    int f = tid + j * 512; int step = f / 96, within = f % 96; int slot6 = within >> 4, q = within & 15;
    int srcslot = slot6 < 3 ? slot6 : 3 + 3 * d + (slot6 - 3); int i = ch * 32 + step; int t = d ? L - 1 - i : i;
    return *(const float4*)(RW + ((size_t)((row0 + t) * 4 + h) * 9 + srcslot) * 64 + q * 4); };
#define PREFETCH(ch) { pre0 = ldpre(ch, 0); pre1 = ldpre(ch, 1); pre2 = ldpre(ch, 2); pre3 = ldpre(ch, 3); pre4 = ldpre(ch, 4); pre5 = ldpre(ch, 5); }
  PREFETCH(0);
  for (int ch = 0; ch < nch; ++ch) {
    *(float4*)(lds + (size_t)(tid + 0 * 512) * 4) = pre0; *(float4*)(lds + (size_t)(tid + 1 * 512) * 4) = pre1;
    *(float4*)(lds + (size_t)(tid + 2 * 512) * 4) = pre2; *(float4*)(lds + (size_t)(tid + 3 * 512) * 4) = pre3;
    *(float4*)(lds + (size_t)(tid + 4 * 512) * 4) = pre4; *(float4*)(lds + (size_t)(tid + 5 * 512) * 4) = pre5;
    __syncthreads();
    if (ch + 1 < nch) PREFETCH(ch + 1);
    if (wid < 4) {
#pragma unroll 4
      for (int step = 0; step < 32; ++step) {
        const float* base = lds + step * 384;
        const float4 r4 = *(const float4*)(base + lane16 * 4), kk4 = *(const float4*)(base + 64 + lane16 * 4);
        const float vrow = base[128 + row];
        const float4 w4 = *(const float4*)(base + 192 + lane16 * 4), b4 = *(const float4*)(base + 256 + lane16 * 4), kd4 = *(const float4*)(base + 320 + lane16 * 4);
        float sa = -(st.x * kk4.x + st.y * kk4.y + st.z * kk4.z + st.w * kk4.w);
        sa = allreduce16(sa);
        st.x = st.x * w4.x + (sa * b4.x + vrow * kd4.x);
        st.y = st.y * w4.y + (sa * b4.y + vrow * kd4.y);
        st.z = st.z * w4.z + (sa * b4.z + vrow * kd4.z);
        st.w = st.w * w4.w + (sa * b4.w + vrow * kd4.w);
        float y = st.x * r4.x + st.y * r4.y + st.z * r4.z + st.w * r4.w;
        y = allreduce16(y);
        if (lane16 == 0) { int i = ch * 32 + step; int t = d ? L - 1 - i : i; YS[(size_t)(row0 + t) * 256 + h * 64 + row] = y; }
      }
    }
    __syncthreads();
  }
#undef PREFETCH
  if (s < 16 && wid < 4) *(float4*)(p.out + OUT_STATE + ((((size_t)s * 4 + l) * 2 + d) * 4 + h) * 4096 + row * 64 + lane16 * 4) = st;
}

DI void attn_item(const Params& p, int l, int s, int h, int qt, unsigned char* smem, float lam, float lam_init) {
  u16* Ks = (u16*)smem; u16* Vs = Ks + 64 * 136; float* Ex = (float*)(smem + 2 * 17408);
  const bool lat = s >= 16; const int Lk = lat ? 2304 : 256;
  const u16* Kg = lat ? (const u16*)(p.ws + WS_KL) + (size_t)(s - 16) * 2304 * 512 : (const u16*)(p.ws + WS_KC) + (size_t)s * 256 * 512;
  const u16* Vg = lat ? (const u16*)(p.ws + WS_VL) + (size_t)(s - 16) * 2304 * 512 : (const u16*)(p.ws + WS_VC) + (size_t)s * 256 * 512;
  const int row0 = lat ? 4096 + (s - 16) * 2048 : s * 256; const int qrow0 = row0 + qt * 128;
  const u16* Q = (const u16*)(p.ws + WS_Q);
  const int tid = otid(), lane = tid & 63, wid = tid >> 6, m = wid & 1, qs = wid >> 1, r = lane & 31, hh = lane >> 5;
  bf16x8 qf[4];
#pragma unroll
  for (int ks = 0; ks < 4; ++ks) qf[ks] = *(const bf16x8*)(Q + (size_t)(qrow0 + qs * 32 + r) * 512 + h * 128 + m * 64 + ks * 16 + hh * 8);
  f32x16 o[4];
#pragma unroll
  for (int et = 0; et < 4; ++et)
#pragma unroll
    for (int i = 0; i < 16; ++i) o[et][i] = 0.f;
  float mrun = -1e30f, lsum = 0.f; const float cs = 0.125f * 1.4426950408889634f;
  for (int kt0 = 0; kt0 < Lk; kt0 += 64) {
    __syncthreads();
#pragma unroll
    for (int i = 0; i < 2; ++i) { int id = tid + i * 512; int key = id >> 4, ch = id & 15;
      *(uint4*)(Ks + key * 136 + ch * 8) = *(const uint4*)(Kg + (size_t)(kt0 + key) * 512 + h * 128 + ch * 8); }
#pragma unroll
    for (int i = 0; i < 2; ++i) { int id = tid + i * 512; int key = id & 63, e8 = id >> 6;
      const uint4 v = *(const uint4*)(Vg + (size_t)(kt0 + key) * 512 + h * 128 + e8 * 8);
      const unsigned w[4] = {v.x, v.y, v.z, v.w};
#pragma unroll
      for (int j = 0; j < 8; ++j) Vs[(e8 * 8 + j) * 68 + key] = (u16)(w[j >> 1] >> ((j & 1) * 16)); }
    __syncthreads();
    f32x16 st[2];
#pragma unroll
    for (int kt = 0; kt < 2; ++kt) {
#pragma unroll
      for (int i = 0; i < 16; ++i) st[kt][i] = 0.f;
#pragma unroll
      for (int ks = 0; ks < 4; ++ks) { const bf16x8 kf = *(const bf16x8*)(Ks + (kt * 32 + r) * 136 + m * 64 + ks * 16 + hh * 8);
        st[kt] = __builtin_amdgcn_mfma_f32_32x32x16_bf16(kf, qf[ks], st[kt], 0, 0, 0); }
    }
    float mx = st[0][0];
#pragma unroll
    for (int i = 0; i < 16; ++i) { mx = fmaxf(mx, st[0][i]); mx = fmaxf(mx, st[1][i]); }
    mx = fmaxf(mx, __shfl_xor(mx, 32));
    const float mnew = fmaxf(mrun, mx); const float alpha = exp2f((mrun - mnew) * cs); mrun = mnew;
    lsum *= alpha;
#pragma unroll
    for (int et = 0; et < 4; ++et)
#pragma unroll
      for (int i = 0; i < 16; ++i) o[et][i] *= alpha;
#pragma unroll
    for (int kt = 0; kt < 2; ++kt)
#pragma unroll
      for (int i = 0; i < 16; ++i) { float pv = exp2f((st[kt][i] - mnew) * cs); lsum += pv; st[kt][i] = pv; }
#pragma unroll
    for (int kt = 0; kt < 2; ++kt)
#pragma unroll
      for (int ss = 0; ss < 2; ++ss) {
        bf16x8 pf;
#pragma unroll
        for (int j = 0; j < 8; ++j) pf[j] = (short)f2bf(st[kt][8 * ss + j]);
#pragma unroll
        for (int et = 0; et < 4; ++et) {
          const u16* vp = Vs + (et * 32 + r) * 68 + kt * 32 + 16 * ss + 4 * hh;
          const s16x4 lo = *(const s16x4*)vp, hi = *(const s16x4*)(vp + 8);
          const bf16x8 vf = __builtin_shufflevector(lo, hi, 0, 1, 2, 3, 4, 5, 6, 7);
          o[et] = __builtin_amdgcn_mfma_f32_32x32x16_bf16(vf, pf, o[et], 0, 0, 0);
        }
      }
  }
  lsum += __shfl_xor(lsum, 32); const float inv = 1.f / lsum;
  float* ex = Ex + qs * (32 * 132);
  if (m == 1) {
#pragma unroll
    for (int et = 0; et < 4; ++et)
#pragma unroll
      for (int i = 0; i < 16; ++i) { int e = et * 32 + (i & 3) + 8 * (i >> 2) + 4 * hh; ex[r * 132 + e] = o[et][i] * inv; }
  }
  __syncthreads();
  if (m == 0) {
    float ssq = 0.f;
#pragma unroll
    for (int et = 0; et < 4; ++et)
#pragma unroll
      for (int i = 0; i < 16; ++i) { int e = et * 32 + (i & 3) + 8 * (i >> 2) + 4 * hh; float v = o[et][i] * inv - lam * ex[r * 132 + e]; o[et][i] = v; ssq += v * v; }
    ssq += __shfl_xor(ssq, 32);
    const float rs = rsqrtf(ssq * (1.f / 128.f) + 1e-6f) * (1.f - lam_init);
    const float* subln = p.in[29] + l * 128;
    u16* dstrow = (u16*)(p.ws + WS_MIXCAT) + (size_t)(qrow0 + qs * 32 + r) * 1024 + 256 + h * 128;
#pragma unroll
    for (int et = 0; et < 4; ++et)
#pragma unroll
      for (int g4 = 0; g4 < 4; ++g4) {
        const int e0 = et * 32 + 8 * g4 + 4 * hh; const float4 sl = *(const float4*)(subln + e0);
        *(uint2*)(dstrow + e0) = make_uint2(pack2(o[et][4 * g4] * rs * sl.x, o[et][4 * g4 + 1] * rs * sl.y), pack2(o[et][4 * g4 + 2] * rs * sl.z, o[et][4 * g4 + 3] * rs * sl.w));
      }
  }
}

DI void hy_conv(const float* g, const float* z, int L, int t0, float& a0, float& a1, float& a2, float& a3) {
  a0 = a1 = a2 = a3 = 0.f;
  const float* gp = g + L + t0 - 4;
  const int nb = L >> 2;
#pragma unroll 4
  for (int sb = 0; sb < nb; ++sb) {
    const float4 zz = *(const float4*)(z + sb * 4);
    const float4 ga = *(const float4*)(gp - 4 * sb), gb = *(const float4*)(gp - 4 * sb + 4);
    a0 += gb.x * zz.x + ga.w * zz.y + ga.z * zz.z + ga.y * zz.w;
    a1 += gb.y * zz.x + gb.x * zz.y + ga.w * zz.z + ga.z * zz.w;
    a2 += gb.z * zz.x + gb.y * zz.y + gb.x * zz.z + ga.w * zz.w;
    a3 += gb.w * zz.x + gb.z * zz.y + gb.y * zz.z + gb.x * zz.w;
  }
}

DI void hyena_item(const Params& p, int l, int s, int c0, float* lds) {
  const bool lat = s >= 16; const int L = lat ? 2048 : 256; const int row0 = lat ? 4096 + (s - 16) * 2048 : s * 256;
  const int TPC = L >> 2; const int tid = otid(), lane = tid & 63, wid = tid >> 6;
  const int ch = tid / TPC, tl = tid % TPC, t0 = tl * 4, c = c0 + ch;
  float* G = lds; float* Z = lds + 8192; float* red = lds + 8192 + 2048;
  const float* F = (const float*)(p.ws + WS_FILT) + (lat ? 262144 : 0);
  const float* HYT = (const float*)(p.ws + WS_HYT);
  float ssq[2];
#pragma unroll
  for (int o = 0; o < 2; ++o) {
    const float* src = F + (size_t)(o * 256 + c) * (2 * L); float* dst = G + (size_t)(ch * 2 + o) * (2 * L); float sacc = 0.f;
#pragma unroll
    for (int i = 0; i < 2; ++i) { int idx = (tl + i * TPC) * 4; float4 v = *(const float4*)(src + idx); *(float4*)(dst + idx) = v; sacc += v.x * v.x + v.y * v.y + v.z * v.z + v.w * v.w; }
    ssq[o] = wave_sum(sacc);
  }
  if (lane == 0) { red[wid * 2] = ssq[0]; red[wid * 2 + 1] = ssq[1]; }
  const float4 x1 = *(const float4*)(HYT + (size_t)(0 * 256 + c) * TT + row0 + t0);
  const float4 x2 = *(const float4*)(HYT + (size_t)(1 * 256 + c) * TT + row0 + t0);
  const float4 v4 = *(const float4*)(HYT + (size_t)(2 * 256 + c) * TT + row0 + t0);
  *(float4*)(Z + ch * L + t0) = v4;
  __syncthreads();
  const int wpc = TPC >> 6, w0 = ch * wpc; float sc0 = 0.f, sc1 = 0.f;
  for (int w = 0; w < wpc; ++w) { sc0 += red[(w0 + w) * 2]; sc1 += red[(w0 + w) * 2 + 1]; }
  sc0 = rsqrtf(sc0 + 1e-6f); sc1 = rsqrtf(sc1 + 1e-6f);
  const float bias0 = p.in[39][(l * 2 + 0) * 256 + c], bias1 = p.in[39][(l * 2 + 1) * 256 + c];
  float a0, a1, a2, a3;
  hy_conv(G + (size_t)(ch * 2 + 0) * (2 * L), Z + ch * L, L, t0, a0, a1, a2, a3);
  float4 z1;
  z1.x = x1.x * (sc0 * a0 + bias0 * v4.x); z1.y = x1.y * (sc0 * a1 + bias0 * v4.y); z1.z = x1.z * (sc0 * a2 + bias0 * v4.z); z1.w = x1.w * (sc0 * a3 + bias0 * v4.w);
  __syncthreads();
  *(float4*)(Z + ch * L + t0) = z1;
  __syncthreads();
  hy_conv(G + (size_t)(ch * 2 + 1) * (2 * L), Z + ch * L, L, t0, a0, a1, a2, a3);
  float4 yo;
  yo.x = x2.x * (sc1 * a0 + bias1 * z1.x); yo.y = x2.y * (sc1 * a1 + bias1 * z1.y); yo.z = x2.z * (sc1 * a2 + bias1 * z1.z); yo.w = x2.w * (sc1 * a3 + bias1 * z1.w);
  *(float4*)((float*)(p.ws + WS_YC) + (size_t)c * TT + row0 + t0) = yo;
  __syncthreads();
}

DI void fin_item(const Params& p, int l, int tile, float* lds) {
  const int tid = otid(), lane = tid & 63, wid = tid >> 6; const int rowb = tile * 64;
  const float* YS0 = (const float*)(p.ws + WS_YS); const float* YS1 = YS0 + (size_t)TT * 256;
  const float* RW = (const float*)(p.ws + WS_RW); const float* G = (const float*)(p.ws + WS_G); const float* BC = (const float*)(p.ws + WS_BC);
  u16* MC = (u16*)(p.ws + WS_MIXCAT);
  for (int q = 0; q < 32; ++q) {
    const int pair = wid * 32 + q, tok = pair >> 2, h = pair & 3, row = rowb + tok, c = h * 64 + lane;
    const float y = YS0[(size_t)row * 256 + c] + YS1[(size_t)row * 256 + c];
    const float mu = wave_sum(y) * (1.f / 64.f); const float dv = y - mu; const float var = wave_sum(dv * dv) * (1.f / 64.f);
    const float yn = dv * rsqrtf(var + 64e-5f) * p.in[23][l * 256 + c] + p.in[24][l * 256 + c];
    const float v = RW[((size_t)(row * 4 + h) * 9 + 2) * 64 + lane]; const float bc = BC[row * 4 + h]; const float g = G[(size_t)row * 256 + c];
    MC[(size_t)row * 1024 + c] = f2bf((yn + bc * v) * g);
  }
  const float* YC = (const float*)(p.ws + WS_YC);
  for (int idx = tid; idx < 16384; idx += 512) { int c = idx >> 6, tt = idx & 63; lds[c * 65 + tt] = YC[(size_t)c * TT + rowb + tt]; }
  __syncthreads();
  for (int idx = tid; idx < 16384; idx += 512) { int tt = idx >> 8, c = idx & 255; MC[(size_t)(rowb + tt) * 1024 + 768 + c] = f2bf(lds[c * 65 + tt]); }
  __syncthreads();
}

constexpr int NPH = 2 + 9 * 4;

DI void run_phase(const Params& p, int ph, unsigned char* smem) {
  float* lds = (float*)smem;
  const int nb = gridDim.x, bid = blockIdx.x;
  if (ph == 0) {
    for (int it = bid; it < 384 + AUX_ITEMS; it += nb) { if (it < 384) mod_item(p, it, lds); else aux_item(p, 0, it - 384, lds); }
    return;
  }
  if (ph == 1) { row_phase(p, 0, 0); return; }
  const int l = (ph - 2) / 9, k = (ph - 2) % 9;
  unsigned char* slot = p.ws + WS_W + (size_t)(l & 1) * W_SLOT;
  const u16* win = (const u16*)slot; const u16* wout = (const u16*)(slot + W_IN_B); const u16* wff1 = (const u16*)(slot + W_IN_B + W_OUT_B); const u16* wff2 = (const u16*)(slot + W_IN_B + W_OUT_B + W_FF_B);
  switch (k) {
    case 0: gemm_phase<0>(p, (const u16*)(p.ws + WS_H), win, 1024, 14, l, p.ws + WS_U, NU, smem); break;
    case 1:
      for (int it = bid; it < 992; it += nb) {
        if (it < 384) rwkv_prep_item(p, l, it, lds);
        else if (it < 768) attn_prep_item(p, l, it - 384);
        else if (it < 800) cache_item(p, l, it - 768);
        else hy_prep_item(p, l, it - 800, lds);
      }
      break;
    case 2: {
      __shared__ int s_item; __shared__ float s_lam;
      const float lam_init = 0.8f - 0.6f * expf(-0.3f * (float)l);
      const int tid2 = otid();
      if (tid2 < 64) {
        int ln = tid2; float a = p.in[25][l * 64 + ln] * p.in[26][l * 64 + ln]; float b = p.in[27][l * 64 + ln] * p.in[28][l * 64 + ln];
        a = wave_sum(a); b = wave_sum(b); if (ln == 0) s_lam = expf(a) - expf(b) + lam_init;
      }
      __syncthreads();
      const float lam = s_lam;
      unsigned* ctr = (unsigned*)(p.ws + WS_CTL) + l * 64;
      for (;;) {
        __syncthreads();
        if (threadIdx.x == 0) s_item = (int)atomicAdd(ctr, 1u);
        __syncthreads();
        int it = s_item;
        if (it >= 2560) break;
        if (it < 128) { scan_item(p, l, 16 + (it >> 5), (it >> 3) & 3, (it >> 2) & 1, it & 3, lds); }
        else if (it < 384) { int j = it - 128; attn_item(p, l, 16 + (j >> 6), (j >> 4) & 3, j & 15, smem, lam, lam_init); }
        else if (it < 1408) { int j = it - 384; hyena_item(p, l, 16 + (j >> 8), j & 255, lds); }
        else if (it < 1920) { int j = it - 1408; scan_item(p, l, j >> 5, (j >> 3) & 3, (j >> 2) & 1, j & 3, lds); }
        else if (it < 2048) { int j = it - 1920; attn_item(p, l, j >> 3, (j >> 1) & 3, j & 1, smem, lam, lam_init); }
        else { int j = it - 2048; hyena_item(p, l, j >> 5, (j & 31) * 8, lds); }
      }
    } break;
    case 3: for (int it = bid; it < 192; it += nb) fin_item(p, l, it, lds); break;
    case 4: gemm_phase<1>(p, (const u16*)(p.ws + WS_MIXCAT), wout, 1024, 4, l, p.ws + WS_F, 1024, smem); break;
    case 5:
      row_phase(p, l, 1);
      if (l < 3) for (int it = bid; it < AUX_ITEMS; it += nb) aux_item(p, l + 1, it, lds);
      break;
    case 6: gemm_phase<2>(p, (const u16*)(p.ws + WS_H), wff1, 1024, 16, l, p.ws + WS_A, 4096, smem); break;
    case 7: gemm_phase<1>(p, (const u16*)(p.ws + WS_A), wff2, 4096, 4, l, p.ws + WS_F, 1024, smem); break;
    case 8: row_phase(p, l, 2); break;
  }
}

__global__ void __launch_bounds__(512) mega(Params p, int ph_lo, int ph_hi) {
  extern __shared__ __attribute__((aligned(16))) unsigned char smem[];
  for (int ph = ph_lo; ph < ph_hi; ++ph) {
    if (ph > ph_lo) cg::this_grid().sync();
    run_phase(p, ph, smem);
  }
}

extern "C" void kernel_launch(void* const* d_in, const int* in_sizes, int n_in, void* d_out, int out_size, void* d_ws, size_t ws_size, hipStream_t stream) {
  static int grid = 0;
  if (!grid) {
    int dev = 0, cus = 0, per_cu = 0;
    hipGetDevice(&dev);
    hipDeviceGetAttribute(&cus, hipDeviceAttributeMultiprocessorCount, dev);
    hipFuncSetAttribute((const void*)mega, hipFuncAttributeMaxDynamicSharedMemorySize, (int)LDS_BYTES);
    hipOccupancyMaxActiveBlocksPerMultiprocessor(&per_cu, (const void*)mega, NT, LDS_BYTES);
    if (per_cu < 1) { fprintf(stderr, "occupancy query says %d blocks/CU\n", per_cu); per_cu = 1; }
    grid = cus;
  }
  if (n_in != 43 || ws_size < WS_END) { fprintf(stderr, "kernel_launch: bad n_in %d or ws %zu < %zu\n", n_in, ws_size, (size_t)WS_END); return; }
  Params p{};
  for (int i = 0; i < 43; ++i) p.in[i] = (const float*)d_in[i];
  p.out = (float*)d_out; p.ws = (unsigned char*)d_ws;
  hipMemsetAsync((unsigned char*)d_ws + WS_CTL, 0, 4096, stream);
#if ONE_LAUNCH
  int lo = 0, hi = NPH; void* args[] = {&p, &lo, &hi};
  hipError_t e = hipLaunchCooperativeKernel((const void*)mega, dim3(grid), dim3(NT), args, LDS_BYTES, stream);
  if (e != hipSuccess) fprintf(stderr, "cooperative launch failed: %s\n", hipGetErrorString(e));
#else
  for (int ph = 0; ph < NPH; ++ph) hipLaunchKernelGGL(mega, dim3(grid), dim3(NT), LDS_BYTES, stream, p, ph, ph + 1);
#endif
}
```

```cpp
#include <hip/hip_runtime.h>
#include <hip/hip_cooperative_groups.h>
#include <stdint.h>
#include <stdio.h>
namespace cg = cooperative_groups;

#ifndef ONE_LAUNCH
#define ONE_LAUNCH 1
#endif

#define DI __device__ __forceinline__
typedef unsigned short u16;
using bf16x8 = __attribute__((ext_vector_type(8))) short;
using s16x4  = __attribute__((ext_vector_type(4))) short;
using f32x4  = __attribute__((ext_vector_type(4))) float;
using f32x16 = __attribute__((ext_vector_type(16))) float;

constexpr int NT = 512;
constexpr int TT = 12288;
constexpr int NU = 3456;
constexpr size_t LDS_BYTES = 110592;

constexpr size_t WS_CTL = 0;
constexpr size_t WS_MOD = 4096;
constexpr size_t WS_W   = WS_MOD + 491520;
constexpr size_t W_IN_B = 3584ull * 1024 * 2, W_OUT_B = 1024ull * 1024 * 2, W_FF_B = 4096ull * 1024 * 2;
constexpr size_t W_SLOT = W_IN_B + W_OUT_B + 2 * W_FF_B;
constexpr size_t WS_H   = WS_W + 2 * W_SLOT;
constexpr size_t WS_U   = WS_H + (size_t)TT * 1024 * 2;
constexpr size_t WS_MIXCAT = WS_U + (size_t)TT * NU * 2;
constexpr size_t WS_KL  = WS_MIXCAT + (size_t)TT * 1024 * 2;
constexpr size_t WS_VL  = WS_KL + 4ull * 2304 * 512 * 2;
constexpr size_t WS_RW  = WS_VL + 4ull * 2304 * 512 * 2;
constexpr size_t WS_G   = WS_RW + (size_t)TT * 4 * 9 * 64 * 4;
constexpr size_t WS_BC  = WS_G + (size_t)TT * 256 * 4;
constexpr size_t WS_HYT = WS_BC + (size_t)TT * 4 * 4;
constexpr size_t WS_FILT = WS_HYT + 3ull * 256 * TT * 4;
constexpr size_t WS_END = WS_FILT + 2ull * 256 * (512 + 4096) * 4;
constexpr size_t WS_Q  = WS_H;
constexpr size_t WS_KC = WS_Q + (size_t)TT * 512 * 2;
constexpr size_t WS_VC = WS_KC + 16ull * 256 * 512 * 2;
constexpr size_t WS_YS = WS_U;
constexpr size_t WS_YC = WS_U + 2ull * TT * 256 * 4;
constexpr size_t WS_F  = WS_U;
constexpr size_t WS_A  = WS_RW;
static_assert(WS_VC + 16ull * 256 * 512 * 2 <= WS_U, "alias");
static_assert(WS_YC + 256ull * TT * 4 <= WS_MIXCAT, "alias");
static_assert((size_t)TT * 4096 * 2 <= (size_t)TT * 4 * 9 * 64 * 4, "alias");

constexpr size_t OUT_STATE = 12582912, OUT_CK = 14680064, OUT_CV = 23068672;

struct Params {
  const float* in[43];
  float* out;
  unsigned char* ws;
};

DI u16 f2bf(float x) { unsigned u = __float_as_uint(x); u += 0x7fffu + ((u >> 16) & 1u); return (u16)(u >> 16); }
DI float bf2f(u16 b) { return __uint_as_float(((unsigned)b) << 16); }
DI unsigned pack2(float a, float b) { return (unsigned)f2bf(a) | ((unsigned)f2bf(b) << 16); }
DI float wave_sum(float v) {
#pragma unroll
  for (int o = 32; o > 0; o >>= 1) v += __shfl_xor(v, o);
  return v;
}
template <int CTRL> DI float dppf(float x) {
  return __builtin_bit_cast(float, __builtin_amdgcn_update_dpp(0, __builtin_bit_cast(int, x), CTRL, 0xF, 0xF, true));
}
DI float allreduce16(float x) {
  x += dppf<0xB1>(x); x += dppf<0x4E>(x); x += dppf<0x124>(x); x += dppf<0x128>(x);
  return x;
}
DI void seq_of(int row, int& s, int& t, int& L, int& row0) {
  if (row < 4096) { s = row >> 8; t = row & 255; L = 256; row0 = s * 256; }
  else { int r = row - 4096; s = 16 + (r >> 11); t = r & 2047; L = 2048; row0 = 4096 + (r >> 11) * 2048; }
}
DI int otid() { int t = threadIdx.x; asm volatile("" : "+v"(t)); return t; }
DI float sigmoidf_(float x) { return 1.f / (1.f + expf(-x)); }

DI void tr_tile(const float* __restrict__ W, int K, int N, u16* __restrict__ Wt, int k0, int n0, float* lds) {
  const int tid = otid();
#pragma unroll
  for (int i = 0; i < 8; ++i) { int idx = tid + i * 512; int kk = idx >> 6, nn = idx & 63; lds[kk * 65 + nn] = W[(size_t)(k0 + kk) * N + n0 + nn]; }
  __syncthreads();
  const int n = tid >> 3, kg = tid & 7;
  unsigned pk[4];
#pragma unroll
  for (int j = 0; j < 4; ++j) pk[j] = pack2(lds[(kg * 8 + 2 * j) * 65 + n], lds[(kg * 8 + 2 * j + 1) * 65 + n]);
  *(uint4*)(Wt + (size_t)(n0 + n) * K + k0 + kg * 8) = make_uint4(pk[0], pk[1], pk[2], pk[3]);
  __syncthreads();
}

DI void filt_item(const Params& p, int l, int it, float* lds) {
  const int Lsel = it >= 32; const int chunk = Lsel ? it - 32 : it; const int L = Lsel ? 2048 : 256;
  float* emb = lds; float* h1 = lds + 8 * 36; float* h2 = h1 + 512;
  const int tid = otid();
  const float* w1 = p.in[32] + l * 33 * 64; const float* b1 = p.in[33] + l * 64; const float* fr = p.in[34] + l * 64;
  const float* w2 = p.in[35] + l * 4096; const float* b2 = p.in[36] + l * 64; const float* w3 = p.in[37] + (size_t)l * 64 * 1024;
  const float* dec = p.in[38] + l * 256;
  if (tid < 8 * 33) {
    int ti = tid / 33, j = tid % 33; int i = chunk * 8 + ti; float v;
    float ang = (float)(2.0 * 3.14159265358979323846 / (double)L) * (float)i;
    if (j == 0) v = (float)i / (float)(L - 1);
    else if (j <= 16) { float band = 1e-4f + (float)(j - 1) * ((15.f - 1e-4f) / 15.f); v = cosf(band * ang); }
    else { float band = 1e-4f + (float)(j - 17) * ((15.f - 1e-4f) / 15.f); v = -sinf(band * ang); }
    emb[ti * 36 + j] = v;
  }
  __syncthreads();
  { int ti = tid >> 6, j = tid & 63; float a = b1[j]; for (int k = 0; k < 33; ++k) a += emb[ti * 36 + k] * w1[k * 64 + j]; h1[ti * 64 + j] = sinf(fr[j] * a); }
  __syncthreads();
  { int ti = tid >> 6, j = tid & 63; float a = b2[j]; for (int k = 0; k < 64; ++k) a += h1[ti * 64 + k] * w2[k * 64 + j]; h2[ti * 64 + j] = sinf(fr[j] * a); }
  __syncthreads();
  float* FILT = (float*)(p.ws + WS_FILT) + (Lsel ? 262144 : 0);
#pragma unroll
  for (int cc = 0; cc < 2; ++cc) {
    int col = tid + cc * 512; float acc[8];
#pragma unroll
    for (int ti = 0; ti < 8; ++ti) acc[ti] = 0.f;
    for (int k = 0; k < 64; ++k) { float w = w3[k * 1024 + col];
#pragma unroll
      for (int ti = 0; ti < 8; ++ti) acc[ti] += h2[ti * 64 + k] * w; }
    int order = col >> 9, dir = (col >> 8) & 1, c = col & 255; float dc = fabsf(dec[c]);
    float* g = FILT + (size_t)(order * 256 + c) * (2 * L);
#pragma unroll
    for (int ti = 0; ti < 8; ++ti) {
      int i = chunk * 8 + ti; float t = (float)i / (float)(L - 1); float val = acc[ti] * expf(-t * dc);
      if (dir == 0) g[L + i] = val; else { if (i == 0) g[0] = 0.f; else g[L - i] = val; }
    }
  }
  __syncthreads();
}

constexpr int AUX_ITEMS = 864 + 256 + 1024 + 1024 + 1 + 288;
DI void aux_item(const Params& p, int l, int it, float* lds) {
  unsigned char* slot = p.ws + WS_W + (size_t)(l & 1) * W_SLOT;
  u16* win = (u16*)slot; u16* wout = (u16*)(slot + W_IN_B); u16* wff1 = (u16*)(slot + W_IN_B + W_OUT_B); u16* wff2 = (u16*)(slot + W_IN_B + W_OUT_B + W_FF_B);
  if (it < 864) { int kt = it / 54, nt = it % 54; tr_tile(p.in[13] + (size_t)l * 1024 * NU, 1024, NU, win, kt * 64, nt * 64, lds); return; }
  it -= 864;
  if (it < 256) { int kt = it >> 4, nt = it & 15; tr_tile(p.in[40] + (size_t)l * 1024 * 1024, 1024, 1024, wout, kt * 64, nt * 64, lds); return; }
  it -= 256;
  if (it < 1024) { int kt = it >> 6, nt = it & 63; tr_tile(p.in[41] + (size_t)l * 1024 * 4096, 1024, 4096, wff1, kt * 64, nt * 64, lds); return; }
  it -= 1024;
  if (it < 1024) { int kt = it >> 4, nt = it & 15; tr_tile(p.in[42] + (size_t)l * 4096 * 1024, 4096, 1024, wff2, kt * 64, nt * 64, lds); return; }
  it -= 1024;
  if (it < 1) { uint4* z = (uint4*)(win + (size_t)NU * 1024); for (int i = otid(); i < 16384; i += 512) z[i] = make_uint4(0, 0, 0, 0); return; }
  it -= 1;
  filt_item(p, l, it, lds);
}

DI void mod_item(const Params& p, int it, float* lds) {
  const int l = it / 96, cgp = it % 96, tid = otid();
  float* sc = lds; float* red = lds + 5120;
  for (int i = tid; i < 5120; i += 512) { int j = i >> 10, k = i & 1023; float c = (j == 0) ? p.in[6][k] : p.in[5][(j - 1) * 1024 + k]; sc[i] = c / (1.f + expf(-c)); }
  __syncthreads();
  const int c = tid & 63, kg = tid >> 6; const float* w = p.in[7] + (size_t)l * 1024 * 6144 + cgp * 64 + c;
  float acc[5] = {0.f, 0.f, 0.f, 0.f, 0.f};
  for (int k = kg; k < 1024; k += 8) { float wv = w[(size_t)k * 6144];
#pragma unroll
    for (int j = 0; j < 5; ++j) acc[j] += sc[j * 1024 + k] * wv; }
#pragma unroll
  for (int j = 0; j < 5; ++j) red[(kg * 5 + j) * 64 + c] = acc[j];
  __syncthreads();
  if (tid < 320) { int j = tid >> 6, cc = tid & 63; float s = 0.f; for (int g = 0; g < 8; ++g) s += red[(g * 5 + j) * 64 + cc];
    s += p.in[8][l * 6144 + cgp * 64 + cc]; ((float*)(p.ws + WS_MOD))[(l * 5 + j) * 6144 + cgp * 64 + cc] = s; }
  __syncthreads();
}

DI void row_phase(const Params& p, int l, int mode) {
  const int tid = otid(), lane = tid & 63; const int gw = blockIdx.x * 8 + (tid >> 6), nw = gridDim.x * 8;
  float* x = p.out; const float* F = (const float*)(p.ws + WS_F); u16* H = (u16*)(p.ws + WS_H); const float* MOD = (const float*)(p.ws + WS_MOD);
  const float* gpost = nullptr; const float* gpre = nullptr; int gate_ch = 0, sc_ch = 0, sh_ch = 0, lm = l; bool do_h = true;
  if (mode == 0) { gpre = p.in[9] + l * 1024; sc_ch = 1; sh_ch = 0; lm = l; }
  else if (mode == 1) { gpost = p.in[10] + l * 1024; gate_ch = 2; gpre = p.in[11] + l * 1024; sc_ch = 4; sh_ch = 3; lm = l; }
  else { gpost = p.in[12] + l * 1024; gate_ch = 5; if (l < 3) { gpre = p.in[9] + (l + 1) * 1024; sc_ch = 1; sh_ch = 0; lm = l + 1; } else do_h = false; }
  for (int row = gw; row < TT; row += nw) {
    const int j = row < 4096 ? 0 : 1 + ((row - 4096) >> 11);
    const float* xs = (mode == 0) ? (row < 4096 ? p.in[0] + (size_t)row * 1024 : p.in[1] + (size_t)(row - 4096) * 1024) : x + (size_t)row * 1024;
    float4 xv[4];
#pragma unroll
    for (int i = 0; i < 4; ++i) xv[i] = *(const float4*)(xs + i * 256 + lane * 4);
    if (mode != 0) {
      float4 dv[4]; float ss = 0.f;
#pragma unroll
      for (int i = 0; i < 4; ++i) { dv[i] = *(const float4*)(F + (size_t)row * 1024 + i * 256 + lane * 4); ss += dv[i].x * dv[i].x + dv[i].y * dv[i].y + dv[i].z * dv[i].z + dv[i].w * dv[i].w; }
      ss = wave_sum(ss); const float rs = rsqrtf(ss * (1.f / 1024.f) + 1e-6f);
      const float* gt = MOD + (l * 5 + j) * 6144 + gate_ch * 1024;
#pragma unroll
      for (int i = 0; i < 4; ++i) { int col = i * 256 + lane * 4; float4 g4 = *(const float4*)(gt + col); float4 p4 = *(const float4*)(gpost + col);
        xv[i].x += g4.x * dv[i].x * rs * p4.x; xv[i].y += g4.y * dv[i].y * rs * p4.y; xv[i].z += g4.z * dv[i].z * rs * p4.z; xv[i].w += g4.w * dv[i].w * rs * p4.w; }
    }
#pragma unroll
    for (int i = 0; i < 4; ++i) *(float4*)(x + (size_t)row * 1024 + i * 256 + lane * 4) = xv[i];
    if (do_h) {
      float ss = 0.f;
#pragma unroll
      for (int i = 0; i < 4; ++i) ss += xv[i].x * xv[i].x + xv[i].y * xv[i].y + xv[i].z * xv[i].z + xv[i].w * xv[i].w;
      ss = wave_sum(ss); const float rs = rsqrtf(ss * (1.f / 1024.f) + 1e-6f);
      const float* sc = MOD + (lm * 5 + j) * 6144 + sc_ch * 1024; const float* sh = MOD + (lm * 5 + j) * 6144 + sh_ch * 1024;
#pragma unroll
      for (int i = 0; i < 4; ++i) { int col = i * 256 + lane * 4; float4 g4 = *(const float4*)(gpre + col); float4 s4 = *(const float4*)(sc + col); float4 h4 = *(const float4*)(sh + col);
        float a = xv[i].x * rs * g4.x * (1.f + s4.x) + h4.x, b = xv[i].y * rs * g4.y * (1.f + s4.y) + h4.y;
        float c = xv[i].z * rs * g4.z * (1.f + s4.z) + h4.z, d = xv[i].w * rs * g4.w * (1.f + s4.w) + h4.w;
        *(uint2*)(H + (size_t)row * 1024 + col) = make_uint2(pack2(a, b), pack2(c, d)); }
    }
  }
}

template <int EPI>
DI void gemm_phase(const Params& p, const u16* __restrict__ A, const u16* __restrict__ Wt, int K, int NTn, int l, void* Cout, int ldc, unsigned char* smem) {
  u16* As = (u16*)smem; u16* Bs = As + 2 * 128 * 72;
  const int tid = otid(), lane = tid & 63, wid = tid >> 6, wm = wid & 1, wn = wid >> 1, fr = lane & 15, fq = lane >> 4;
  const int ntiles = 96 * NTn, nk = K / 64;
  for (int tile = blockIdx.x; tile < ntiles; tile += gridDim.x) {
    const int mt = tile / NTn, nt = tile % NTn; const int m0 = mt * 128, n0 = nt * 256;
    f32x4 acc[4][4];
#pragma unroll
    for (int i = 0; i < 4; ++i)
#pragma unroll
      for (int j = 0; j < 4; ++j) acc[i][j] = f32x4{0.f, 0.f, 0.f, 0.f};
    uint4 ra[2], rb[4];
    const int lrow = tid >> 3, lkc = tid & 7;
    const u16* ag = A + (size_t)(m0 + lrow) * K + lkc * 8;
    const u16* bg = Wt + (size_t)(n0 + lrow) * K + lkc * 8;
#define GLOAD(kt) { _Pragma("unroll") for (int i = 0; i < 2; ++i) ra[i] = *(const uint4*)(ag + (size_t)i * 64 * K + (kt) * 64); \
                    _Pragma("unroll") for (int i = 0; i < 4; ++i) rb[i] = *(const uint4*)(bg + (size_t)i * 64 * K + (kt) * 64); }
#define SSTORE(buf) { _Pragma("unroll") for (int i = 0; i < 2; ++i) *(uint4*)(As + (buf) * 128 * 72 + (lrow + i * 64) * 72 + lkc * 8) = ra[i]; \
                      _Pragma("unroll") for (int i = 0; i < 4; ++i) *(uint4*)(Bs + (buf) * 256 * 72 + (lrow + i * 64) * 72 + lkc * 8) = rb[i]; }
    GLOAD(0); SSTORE(0); __syncthreads();
    for (int kt = 0; kt < nk; ++kt) {
      if (kt + 1 < nk) GLOAD(kt + 1);
      const u16* as = As + (kt & 1) * 128 * 72 + (wm * 64 + fr) * 72 + fq * 8;
      const u16* bs = Bs + (kt & 1) * 256 * 72 + (wn * 64 + fr) * 72 + fq * 8;
#pragma unroll
      for (int ks = 0; ks < 2; ++ks) {
        bf16x8 wf[4], af[4];
#pragma unroll
        for (int i = 0; i < 4; ++i) { wf[i] = *(const bf16x8*)(bs + i * 16 * 72 + ks * 32); af[i] = *(const bf16x8*)(as + i * 16 * 72 + ks * 32); }
#pragma unroll
        for (int i = 0; i < 4; ++i)
#pragma unroll
          for (int j = 0; j < 4; ++j) acc[i][j] = __builtin_amdgcn_mfma_f32_16x16x32_bf16(wf[i], af[j], acc[i][j], 0, 0, 0);
      }
      if (kt + 1 < nk) SSTORE((kt + 1) & 1);
      __syncthreads();
    }
#undef GLOAD
#undef SSTORE
#pragma unroll
    for (int i = 0; i < 4; ++i)
#pragma unroll
      for (int j = 0; j < 4; ++j) {
        const int row = m0 + wm * 64 + j * 16 + fr; const int col = n0 + wn * 64 + i * 16 + fq * 4; const f32x4 v = acc[i][j];
        if (EPI == 0) {
          if (col < NU) {
            *(uint2*)((u16*)Cout + (size_t)row * NU + col) = make_uint2(pack2(v[0], v[1]), pack2(v[2], v[3]));
            if (row < 4096 && col >= 1664 && col < 2688) {
              int b = row >> 8, t = row & 255;
              float* dst = (col < 2176) ? p.out + OUT_CK + ((size_t)((b * 4 + l) * 256 + t)) * 512 + (col - 1664)
                                        : p.out + OUT_CV + ((size_t)((b * 4 + l) * 256 + t)) * 512 + (col - 2176);
              *(float4*)dst = make_float4(v[0], v[1], v[2], v[3]);
            }
          }
        } else if (EPI == 1) {
          *(float4*)((float*)Cout + (size_t)row * ldc + col) = make_float4(v[0], v[1], v[2], v[3]);
        } else {
          float a = fmaxf(v[0], 0.f), b = fmaxf(v[1], 0.f), c = fmaxf(v[2], 0.f), d = fmaxf(v[3], 0.f);
          *(uint2*)((u16*)Cout + (size_t)row * ldc + col) = make_uint2(pack2(a * a, b * b), pack2(c * c, d * d));
        }
      }
  }
}

DI void rwkv_prep_item(const Params& p, int l, int tile, float* lds) {
  const int tid = otid();
  const int rowb = tile * 32; int s, t0, L, row0; seq_of(rowb, s, t0, L, row0);
  const u16* U = (const u16*)(p.ws + WS_U);
  float* tw = lds; float* ua = lds + 4096; float* sg = lds + 8192;
  for (int idx = tid; idx < 32 * 384; idx += 512) {
    int tok = idx / 384, c = idx % 384; float v = bf2f(U[(size_t)(rowb + tok) * NU + 768 + c]);
    if (c < 128) tw[tok * 128 + c] = tanhf(v); else if (c < 256) ua[tok * 128 + c - 128] = v; else sg[tok * 128 + c - 256] = sigmoidf_(v);
  }
  __syncthreads();
  const int c = tid & 255, tg = tid >> 8, h = c >> 6;
  float ag[16], awf[16], awb[16], aaf[16], aab[16];
#pragma unroll
  for (int i = 0; i < 16; ++i) { ag[i] = 0.f; awf[i] = 0.f; awb[i] = 0.f; aaf[i] = 0.f; aab[i] = 0.f; }
  const float* g2 = p.in[19] + (size_t)l * 128 * 256 + c; const float* w2 = p.in[16] + (size_t)l * 2 * 64 * 256 + c; const float* a2 = p.in[18] + (size_t)l * 2 * 64 * 256 + c;
  for (int k = 0; k < 128; k += 4) {
    float w0 = g2[(k) * 256], w1 = g2[(k + 1) * 256], w2_ = g2[(k + 2) * 256], w3 = g2[(k + 3) * 256];
#pragma unroll
    for (int tt = 0; tt < 16; ++tt) { float4 sv = *(const float4*)(sg + (tg * 16 + tt) * 128 + k); ag[tt] += sv.x * w0 + sv.y * w1 + sv.z * w2_ + sv.w * w3; }
  }
  for (int k = 0; k < 64; k += 4) {
    float wf[4], wb[4], af[4], ab[4];
#pragma unroll
    for (int q = 0; q < 4; ++q) { wf[q] = w2[(k + q) * 256]; wb[q] = w2[(64 + k + q) * 256]; af[q] = a2[(k + q) * 256]; ab[q] = a2[(64 + k + q) * 256]; }
#pragma unroll
    for (int tt = 0; tt < 16; ++tt) {
      const int tok = tg * 16 + tt;
      float4 t1 = *(const float4*)(tw + tok * 128 + k), t2 = *(const float4*)(tw + tok * 128 + 64 + k);
      float4 u1 = *(const float4*)(ua + tok * 128 + k), u2 = *(const float4*)(ua + tok * 128 + 64 + k);
      awf[tt] += t1.x * wf[0] + t1.y * wf[1] + t1.z * wf[2] + t1.w * wf[3];
      awb[tt] += t2.x * wb[0] + t2.y * wb[1] + t2.z * wb[2] + t2.w * wb[3];
      aaf[tt] += u1.x * af[0] + u1.y * af[1] + u1.z * af[2] + u1.w * af[3];
      aab[tt] += u2.x * ab[0] + u2.y * ab[1] + u2.z * ab[2] + u2.w * ab[3];
    }
  }
  const float* cw = p.in[14] + (size_t)l * 3 * 768;
  float cr[3], ck[3], cv[3];
#pragma unroll
  for (int q = 0; q < 3; ++q) { cr[q] = cw[q * 768 + c]; ck[q] = cw[q * 768 + 256 + c]; cv[q] = cw[q * 768 + 512 + c]; }
  const float kkw = p.in[20][l * 256 + c], ka = p.in[21][l * 256 + c], rk = p.in[22][l * 256 + c];
  const float w0f = p.in[15][(l * 2 + 0) * 256 + c], w0b = p.in[15][(l * 2 + 1) * 256 + c];
  const float a0f = p.in[17][(l * 2 + 0) * 256 + c], a0b = p.in[17][(l * 2 + 1) * 256 + c];
  float* RW = (float*)(p.ws + WS_RW); float* G = (float*)(p.ws + WS_G); float* BC = (float*)(p.ws + WS_BC);
#pragma unroll
  for (int tt = 0; tt < 16; ++tt) {
    const int tok = tg * 16 + tt, row = rowb + tok, t = t0 + tok;
    const u16* ur = U + (size_t)row * NU + c;
    float r0 = bf2f(ur[0]), k0 = bf2f(ur[256]), v0 = bf2f(ur[512]);
    float rm = 0.f, km = 0.f, vm = 0.f, rp = 0.f, kp = 0.f, vp = 0.f;
    if (t > 0) { rm = bf2f(ur[-NU]); km = bf2f(ur[256 - NU]); vm = bf2f(ur[512 - NU]); }
    if (t + 1 < L) { rp = bf2f(ur[NU]); kp = bf2f(ur[256 + NU]); vp = bf2f(ur[512 + NU]); }
    const float r = cr[0] * rm + cr[1] * r0 + cr[2] * rp;
    const float k = ck[0] * km + ck[1] * k0 + ck[2] * kp;
    const float v = cv[0] * vm + cv[1] * v0 + cv[2] * vp;
    const float kkr = k * kkw; const float ss = wave_sum(kkr * kkr); const float kk = kkr * rsqrtf(ss + 1e-12f);
    const float sgf = sigmoidf_(w0f + awf[tt]); const float decf = expf(-0.60653066f * sgf);
    const float sgb = sigmoidf_(w0b + awb[tt]); const float decb = expf(-0.60653066f * sgb);
    const float af_ = sigmoidf_(a0f + aaf[tt]), ab_ = sigmoidf_(a0b + aab[tt]);
    const float kdf = k * (1.f + (af_ - 1.f) * ka), kdb = k * (1.f + (ab_ - 1.f) * ka);
    const float bonus = wave_sum(r * (kdf + kdb) * rk);
    float* dst = RW + ((size_t)(row * 4 + h) * 9) * 64 + (c & 63);
    dst[0] = r; dst[64] = kk; dst[128] = v; dst[192] = decf; dst[256] = kk * af_; dst[320] = kdf; dst[384] = decb; dst[448] = kk * ab_; dst[512] = kdb;
    G[(size_t)row * 256 + c] = ag[tt];
    if ((c & 63) == 0) BC[row * 4 + h] = bonus;
  }
  __syncthreads();
}

DI void attn_prep_item(const Params& p, int l, int tile) {
  const int tid = otid();
  const int rowb = tile * 32; int s, t0, L, row0; seq_of(rowb, s, t0, L, row0);
  const bool lat = s >= 16;
  const u16* U = (const u16*)(p.ws + WS_U);
  u16* Q = (u16*)(p.ws + WS_Q);
  u16* Kd = lat ? (u16*)(p.ws + WS_KL) + ((size_t)(s - 16) * 2304 + 256) * 512 : (u16*)(p.ws + WS_KC) + (size_t)s * 256 * 512;
  u16* Vd = lat ? (u16*)(p.ws + WS_VL) + ((size_t)(s - 16) * 2304 + 256) * 512 : (u16*)(p.ws + WS_VC) + (size_t)s * 256 * 512;
  for (int uidx = tid; uidx < 2048; uidx += 512) {
    const int g = uidx & 1, pb = (uidx >> 1) & 1, hm = (uidx >> 2) & 7, which = (uidx >> 5) & 1, tok = uidx >> 6;
    const int row = rowb + tok, t = t0 + tok;
    const u16* src = U + (size_t)row * NU + (which ? 1664 : 1152) + hm * 64 + pb * 32 + g * 8;
    const uint4 va = *(const uint4*)src; const uint4 vb = *(const uint4*)(src + 16);
    const unsigned wa[4] = {va.x, va.y, va.z, va.w}, wb[4] = {vb.x, vb.y, vb.z, vb.w};
    float oa[8], ob[8];
#pragma unroll
    for (int j = 0; j < 8; ++j) {
      float xa = bf2f((u16)(wa[j >> 1] >> ((j & 1) * 16))), xb = bf2f((u16)(wb[j >> 1] >> ((j & 1) * 16)));
      if (lat) {
        const int pidx = pb == 0 ? (t >> 6) : (t & 63); const int i = g * 8 + j;
        const float inv = exp2f(-(float)(2 * i) * (13.287712379549449f / 32.f)); const float ang = (float)pidx * inv;
        const float cs = cosf(ang), sn = sinf(ang);
        oa[j] = xa * cs - xb * sn; ob[j] = xb * cs + xa * sn;
      } else { oa[j] = xa; ob[j] = xb; }
    }
    u16* dst = (which == 0) ? Q + (size_t)row * 512 + hm * 64 + pb * 32 + g * 8 : Kd + (size_t)t * 512 + hm * 64 + pb * 32 + g * 8;
    *(uint4*)dst = make_uint4(pack2(oa[0], oa[1]), pack2(oa[2], oa[3]), pack2(oa[4], oa[5]), pack2(oa[6], oa[7]));
    *(uint4*)(dst + 16) = make_uint4(pack2(ob[0], ob[1]), pack2(ob[2], ob[3]), pack2(ob[4], ob[5]), pack2(ob[6], ob[7]));
  }
  for (int uidx = tid; uidx < 2048; uidx += 512) {
    const int tok = uidx >> 6, ch = uidx & 63;
    *(uint4*)(Vd + (size_t)(t0 + tok) * 512 + ch * 8) = *(const uint4*)(U + (size_t)(rowb + tok) * NU + 2176 + ch * 8);
  }
}

DI void cache_item(const Params& p, int l, int it) {
  const int b = it >> 3, pc = it & 7;
  u16* KL = (u16*)(p.ws + WS_KL); u16* VL = (u16*)(p.ws + WS_VL);
  for (int idx = otid(); idx < 32 * 128; idx += 512) {
    const int r = idx >> 7, c4 = idx & 127, prow = pc * 32 + r;
    const size_t so = ((size_t)(b * 4 + l) * 256 + prow) * 512 + c4 * 4; const size_t d_o = ((size_t)b * 2304 + prow) * 512 + c4 * 4;
    float4 kv = *(const float4*)(p.in[3] + so); float4 vv = *(const float4*)(p.in[4] + so);
    *(uint2*)(KL + d_o) = make_uint2(pack2(kv.x, kv.y), pack2(kv.z, kv.w));
    *(uint2*)(VL + d_o) = make_uint2(pack2(vv.x, vv.y), pack2(vv.z, vv.w));
  }
}

DI void hy_prep_item(const Params& p, int l, int tile, float* lds) {
  const int tid = otid();
  const int rowb = tile * 64; int s, t0, L, row0; seq_of(rowb, s, t0, L, row0);
  const u16* U = (const u16*)(p.ws + WS_U); float* HYT = (float*)(p.ws + WS_HYT);
  for (int which = 0; which < 3; ++which) {
    const int c = tid & 255, tg = tid >> 8, col = which * 256 + c;
    const float w0 = p.in[30][(size_t)l * 3 * 768 + col], w1 = p.in[30][(size_t)l * 3 * 768 + 768 + col], w2 = p.in[30][(size_t)l * 3 * 768 + 1536 + col];
    const float bias = p.in[31][l * 768 + col];
    for (int tt = 0; tt < 32; ++tt) {
      const int tok = tg * 32 + tt, row = rowb + tok, t = t0 + tok;
      const u16* ur = U + (size_t)row * NU + 2688 + col;
      float um = t > 0 ? bf2f(ur[-NU]) : 0.f, u0 = bf2f(ur[0]), up = (t + 1 < L) ? bf2f(ur[NU]) : 0.f;
      lds[tok * 257 + c] = w0 * um + w1 * u0 + w2 * up + bias;
    }
    __syncthreads();
    const int cc = tid >> 1, half = tid & 1;
    float* dst = HYT + (size_t)(which * 256 + cc) * TT + rowb + half * 32;
#pragma unroll
    for (int i = 0; i < 32; i += 4) {
      float4 v = make_float4(lds[(half * 32 + i) * 257 + cc], lds[(half * 32 + i + 1) * 257 + cc], lds[(half * 32 + i + 2) * 257 + cc], lds[(half * 32 + i + 3) * 257 + cc]);
      *(float4*)(dst + i) = v;
    }
    __syncthreads();
  }
}

DI void scan_item(const Params& p, int l, int s, int h, int d, int rg, float* lds) {
  int L, row0; if (s < 16) { L = 256; row0 = s * 256; } else { L = 2048; row0 = 4096 + (s - 16) * 2048; }
  const float* RW = (const float*)(p.ws + WS_RW); float* YS = (float*)(p.ws + WS_YS) + (size_t)d * TT * 256;
  const int tid = otid(), lane = tid & 63, wid = tid >> 6, lane16 = lane & 15, rsub = lane >> 4;
  const int row = rg * 16 + (wid & 3) * 4 + rsub;
  float4 st = make_float4(0.f, 0.f, 0.f, 0.f);
  if (s >= 16 && wid < 4) st = *(const float4*)(p.in[2] + ((((size_t)(s - 16) * 4 + l) * 2 + d) * 4 + h) * 4096 + row * 64 + lane16 * 4);
  const int nch = L / 32;
  float4 pre0, pre1, pre2, pre3, pre4, pre5;
  auto ldpre = [&](int ch, int j) -> float4 {
    int f = tid + j * 512; int step = f / 96, within = f % 96; int slot6 = within >> 4, q = within & 15;
    int srcslot = slot6 < 3 ? slot6 : 3 + 3 * d + (slot6 - 3); int i = ch * 32 + step; int t = d ? L - 1 - i : i;
    return *(const float4*)(RW + ((size_t)((row0 + t) * 4 + h) * 9 + srcslot) * 64 + q * 4); };
#define PREFETCH(ch) { pre0 = ldpre(ch, 0); pre1 = ldpre(ch, 1); pre2 = ldpre(ch, 2); pre3 = ldpre(ch, 3); pre4 = ldpre(ch, 4); pre5 = ldpre(ch, 5); }
  PREFETCH(0);
  for (int ch = 0; ch < nch; ++ch) {
    *(float4*)(lds + (size_t)(tid + 0 * 512) * 4) = pre0; *(float4*)(lds + (size_t)(tid + 1 * 512) * 4) = pre1;
    *(float4*)(lds + (size_t)(tid + 2 * 512) * 4) = pre2; *(float4*)(lds + (size_t)(tid + 3 * 512) * 4) = pre3;
    *(float4*)(lds + (size_t)(tid + 4 * 512) * 4) = pre4; *(float4*)(lds + (size_t)(tid + 5 * 512) * 4) = pre5;
    __syncthreads();
    if (ch + 1 < nch) PREFETCH(ch + 1);
    if (wid < 4) {
#pragma unroll 4
      for (int step = 0; step < 32; ++step) {
        const float* base = lds + step * 384;
        const float4 r4 = *(const float4*)(base + lane16 * 4), kk4 = *(const float4*)(base + 64 + lane16 * 4);
        const float vrow = base[128 + row];
        const float4 w4 = *(const float4*)(base + 192 + lane16 * 4), b4 = *(const float4*)(base + 256 + lane16 * 4), kd4 = *(const float4*)(base + 320 + lane16 * 4);
        float sa = -(st.x * kk4.x + st.y * kk4.y + st.z * kk4.z + st.w * kk4.w);
        sa = allreduce16(sa);
        st.x = st.x * w4.x + (sa * b4.x + vrow * kd4.x);
        st.y = st.y * w4.y + (sa * b4.y + vrow * kd4.y);
        st.z = st.z * w4.z + (sa * b4.z + vrow * kd4.z);
        st.w = st.w * w4.w + (sa * b4.w + vrow * kd4.w);
        float y = st.x * r4.x + st.y * r4.y + st.z * r4.z + st.w * r4.w;
        y = allreduce16(y);
        if (lane16 == 0) { int i = ch * 32 + step; int t = d ? L - 1 - i : i; YS[(size_t)(row0 + t) * 256 + h * 64 + row] = y; }
      }
    }
    __syncthreads();
  }
#undef PREFETCH
  if (s < 16 && wid < 4) *(float4*)(p.out + OUT_STATE + ((((size_t)s * 4 + l) * 2 + d) * 4 + h) * 4096 + row * 64 + lane16 * 4) = st;
}

DI void attn_item(const Params& p, int l, int s, int h, int qt, unsigned char* smem, float lam, float lam_init) {
  u16* Ks = (u16*)smem; u16* Vs = Ks + 64 * 136; float* Ex = (float*)(smem + 2 * 17408);
  const bool lat = s >= 16; const int Lk = lat ? 2304 : 256;
  const u16* Kg = lat ? (const u16*)(p.ws + WS_KL) + (size_t)(s - 16) * 2304 * 512 : (const u16*)(p.ws + WS_KC) + (size_t)s * 256 * 512;
  const u16* Vg = lat ? (const u16*)(p.ws + WS_VL) + (size_t)(s - 16) * 2304 * 512 : (const u16*)(p.ws + WS_VC) + (size_t)s * 256 * 512;
  const int row0 = lat ? 4096 + (s - 16) * 2048 : s * 256; const int qrow0 = row0 + qt * 128;
  const u16* Q = (const u16*)(p.ws + WS_Q);
  const int tid = otid(), lane = tid & 63, wid = tid >> 6, m = wid & 1, qs = wid >> 1, r = lane & 31, hh = lane >> 5;
  bf16x8 qf[4];
#pragma unroll
  for (int ks = 0; ks < 4; ++ks) qf[ks] = *(const bf16x8*)(Q + (size_t)(qrow0 + qs * 32 + r) * 512 + h * 128 + m * 64 + ks * 16 + hh * 8);
  f32x16 o[4];
#pragma unroll
  for (int et = 0; et < 4; ++et)
#pragma unroll
    for (int i = 0; i < 16; ++i) o[et][i] = 0.f;
  float mrun = -1e30f, lsum = 0.f; const float cs = 0.125f * 1.4426950408889634f;
  for (int kt0 = 0; kt0 < Lk; kt0 += 64) {
    __syncthreads();
#pragma unroll
    for (int i = 0; i < 2; ++i) { int id = tid + i * 512; int key = id >> 4, ch = id & 15;
      *(uint4*)(Ks + key * 136 + ch * 8) = *(const uint4*)(Kg + (size_t)(kt0 + key) * 512 + h * 128 + ch * 8); }
#pragma unroll
    for (int i = 0; i < 2; ++i) { int id = tid + i * 512; int key = id & 63, e8 = id >> 6;
      const uint4 v = *(const uint4*)(Vg + (size_t)(kt0 + key) * 512 + h * 128 + e8 * 8);
      const unsigned w[4] = {v.x, v.y, v.z, v.w};
#pragma unroll
      for (int j = 0; j < 8; ++j) Vs[(e8 * 8 + j) * 68 + key] = (u16)(w[j >> 1] >> ((j & 1) * 16)); }
    __syncthreads();
    f32x16 st[2];
#pragma unroll
    for (int kt = 0; kt < 2; ++kt) {
#pragma unroll
      for (int i = 0; i < 16; ++i) st[kt][i] = 0.f;
#pragma unroll
      for (int ks = 0; ks < 4; ++ks) { const bf16x8 kf = *(const bf16x8*)(Ks + (kt * 32 + r) * 136 + m * 64 + ks * 16 + hh * 8);
        st[kt] = __builtin_amdgcn_mfma_f32_32x32x16_bf16(kf, qf[ks], st[kt], 0, 0, 0); }
    }
    float mx = st[0][0];
#pragma unroll
    for (int i = 0; i < 16; ++i) { mx = fmaxf(mx, st[0][i]); mx = fmaxf(mx, st[1][i]); }
    mx = fmaxf(mx, __shfl_xor(mx, 32));
    const float mnew = fmaxf(mrun, mx); const float alpha = exp2f((mrun - mnew) * cs); mrun = mnew;
    lsum *= alpha;
#pragma unroll
    for (int et = 0; et < 4; ++et)
#pragma unroll
      for (int i = 0; i < 16; ++i) o[et][i] *= alpha;
#pragma unroll
    for (int kt = 0; kt < 2; ++kt)
#pragma unroll
      for (int i = 0; i < 16; ++i) { float pv = exp2f((st[kt][i] - mnew) * cs); lsum += pv; st[kt][i] = pv; }
#pragma unroll
    for (int kt = 0; kt < 2; ++kt)
#pragma unroll
      for (int ss = 0; ss < 2; ++ss) {
        bf16x8 pf;
#pragma unroll
        for (int j = 0; j < 8; ++j) pf[j] = (short)f2bf(st[kt][8 * ss + j]);
#pragma unroll
        for (int et = 0; et < 4; ++et) {
          const u16* vp = Vs + (et * 32 + r) * 68 + kt * 32 + 16 * ss + 4 * hh;
          const s16x4 lo = *(const s16x4*)vp, hi = *(const s16x4*)(vp + 8);
          const bf16x8 vf = __builtin_shufflevector(lo, hi, 0, 1, 2, 3, 4, 5, 6, 7);
          o[et] = __builtin_amdgcn_mfma_f32_32x32x16_bf16(vf, pf, o[et], 0, 0, 0);
        }
      }
  }
  lsum += __shfl_xor(lsum, 32); const float inv = 1.f / lsum;
  float* ex = Ex + qs * (32 * 132);
  if (m == 1) {
#pragma unroll
    for (int et = 0; et < 4; ++et)
#pragma unroll
      for (int i = 0; i < 16; ++i) { int e = et * 32 + (i & 3) + 8 * (i >> 2) + 4 * hh; ex[r * 132 + e] = o[et][i] * inv; }
  }
  __syncthreads();
  if (m == 0) {
    float ssq = 0.f;
#pragma unroll
    for (int et = 0; et < 4; ++et)
#pragma unroll
      for (int i = 0; i < 16; ++i) { int e = et * 32 + (i & 3) + 8 * (i >> 2) + 4 * hh; float v = o[et][i] * inv - lam * ex[r * 132 + e]; o[et][i] = v; ssq += v * v; }
    ssq += __shfl_xor(ssq, 32);
    const float rs = rsqrtf(ssq * (1.f / 128.f) + 1e-6f) * (1.f - lam_init);
    const float* subln = p.in[29] + l * 128;
    u16* dstrow = (u16*)(p.ws + WS_MIXCAT) + (size_t)(qrow0 + qs * 32 + r) * 1024 + 256 + h * 128;
#pragma unroll
    for (int et = 0; et < 4; ++et)
#pragma unroll
      for (int g4 = 0; g4 < 4; ++g4) {
        const int e0 = et * 32 + 8 * g4 + 4 * hh; const float4 sl = *(const float4*)(subln + e0);
        *(uint2*)(dstrow + e0) = make_uint2(pack2(o[et][4 * g4] * rs * sl.x, o[et][4 * g4 + 1] * rs * sl.y), pack2(o[et][4 * g4 + 2] * rs * sl.z, o[et][4 * g4 + 3] * rs * sl.w));
      }
  }
}

DI void hy_conv(const float* g, const float* z, int L, int t0, float& a0, float& a1, float& a2, float& a3) {
  a0 = a1 = a2 = a3 = 0.f;
  const float* gp = g + L + t0 - 4;
  const int nb = L >> 2;
#pragma unroll 4
  for (int sb = 0; sb < nb; ++sb) {
    const float4 zz = *(const float4*)(z + sb * 4);
    const float4 ga = *(const float4*)(gp - 4 * sb), gb = *(const float4*)(gp - 4 * sb + 4);
    a0 += gb.x * zz.x + ga.w * zz.y + ga.z * zz.z + ga.y * zz.w;
    a1 += gb.y * zz.x + gb.x * zz.y + ga.w * zz.z + ga.z * zz.w;
    a2 += gb.z * zz.x + gb.y * zz.y + gb.x * zz.z + ga.w * zz.w;
    a3 += gb.w * zz.x + gb.z * zz.y + gb.y * zz.z + gb.x * zz.w;
  }
}

DI void hyena_item(const Params& p, int l, int s, int c0, float* lds) {
  const bool lat = s >= 16; const int L = lat ? 2048 : 256; const int row0 = lat ? 4096 + (s - 16) * 2048 : s * 256;
  const int TPC = L >> 2; const int tid = otid(), lane = tid & 63, wid = tid >> 6;
  const int ch = tid / TPC, tl = tid % TPC, t0 = tl * 4, c = c0 + ch;
  float* G = lds; float* Z = lds + 8192; float* red = lds + 8192 + 2048;
  const float* F = (const float*)(p.ws + WS_FILT) + (lat ? 262144 : 0);
  const float* HYT = (const float*)(p.ws + WS_HYT);
  float ssq[2];
#pragma unroll
  for (int o = 0; o < 2; ++o) {
    const float* src = F + (size_t)(o * 256 + c) * (2 * L); float* dst = G + (size_t)(ch * 2 + o) * (2 * L); float sacc = 0.f;
#pragma unroll
    for (int i = 0; i < 2; ++i) { int idx = (tl + i * TPC) * 4; float4 v = *(const float4*)(src + idx); *(float4*)(dst + idx) = v; sacc += v.x * v.x + v.y * v.y + v.z * v.z + v.w * v.w; }
    ssq[o] = wave_sum(sacc);
  }
  if (lane == 0) { red[wid * 2] = ssq[0]; red[wid * 2 + 1] = ssq[1]; }
  const float4 x1 = *(const float4*)(HYT + (size_t)(0 * 256 + c) * TT + row0 + t0);
  const float4 x2 = *(const float4*)(HYT + (size_t)(1 * 256 + c) * TT + row0 + t0);
  const float4 v4 = *(const float4*)(HYT + (size_t)(2 * 256 + c) * TT + row0 + t0);
  *(float4*)(Z + ch * L + t0) = v4;
  __syncthreads();
  const int wpc = TPC >> 6, w0 = ch * wpc; float sc0 = 0.f, sc1 = 0.f;
  for (int w = 0; w < wpc; ++w) { sc0 += red[(w0 + w) * 2]; sc1 += red[(w0 + w) * 2 + 1]; }
  sc0 = rsqrtf(sc0 + 1e-6f); sc1 = rsqrtf(sc1 + 1e-6f);
  const float bias0 = p.in[39][(l * 2 + 0) * 256 + c], bias1 = p.in[39][(l * 2 + 1) * 256 + c];
  float a0, a1, a2, a3;
  hy_conv(G + (size_t)(ch * 2 + 0) * (2 * L), Z + ch * L, L, t0, a0, a1, a2, a3);
  float4 z1;
  z1.x = x1.x * (sc0 * a0 + bias0 * v4.x); z1.y = x1.y * (sc0 * a1 + bias0 * v4.y); z1.z = x1.z * (sc0 * a2 + bias0 * v4.z); z1.w = x1.w * (sc0 * a3 + bias0 * v4.w);
  __syncthreads();
  *(float4*)(Z + ch * L + t0) = z1;
  __syncthreads();
  hy_conv(G + (size_t)(ch * 2 + 1) * (2 * L), Z + ch * L, L, t0, a0, a1, a2, a3);
  float4 yo;
  yo.x = x2.x * (sc1 * a0 + bias1 * z1.x); yo.y = x2.y * (sc1 * a1 + bias1 * z1.y); yo.z = x2.z * (sc1 * a2 + bias1 * z1.z); yo.w = x2.w * (sc1 * a3 + bias1 * z1.w);
  *(float4*)((float*)(p.ws + WS_YC) + (size_t)c * TT + row0 + t0) = yo;
  __syncthreads();
}

DI void fin_item(const Params& p, int l, int tile, float* lds) {
  const int tid = otid(), lane = tid & 63, wid = tid >> 6; const int rowb = tile * 64;
  const float* YS0 = (const float*)(p.ws + WS_YS); const float* YS1 = YS0 + (size_t)TT * 256;
  const float* RW = (const float*)(p.ws + WS_RW); const float* G = (const float*)(p.ws + WS_G); const float* BC = (const float*)(p.ws + WS_BC);
  u16* MC = (u16*)(p.ws + WS_MIXCAT);
  for (int q = 0; q < 32; ++q) {
    const int pair = wid * 32 + q, tok = pair >> 2, h = pair & 3, row = rowb + tok, c = h * 64 + lane;
    const float y = YS0[(size_t)row * 256 + c] + YS1[(size_t)row * 256 + c];
    const float mu = wave_sum(y) * (1.f / 64.f); const float dv = y - mu; const float var = wave_sum(dv * dv) * (1.f / 64.f);
    const float yn = dv * rsqrtf(var + 64e-5f) * p.in[23][l * 256 + c] + p.in[24][l * 256 + c];
    const float v = RW[((size_t)(row * 4 + h) * 9 + 2) * 64 + lane]; const float bc = BC[row * 4 + h]; const float g = G[(size_t)row * 256 + c];
    MC[(size_t)row * 1024 + c] = f2bf((yn + bc * v) * g);
  }
  const float* YC = (const float*)(p.ws + WS_YC);
  for (int idx = tid; idx < 16384; idx += 512) { int c = idx >> 6, tt = idx & 63; lds[c * 65 + tt] = YC[(size_t)c * TT + rowb + tt]; }
  __syncthreads();
  for (int idx = tid; idx < 16384; idx += 512) { int tt = idx >> 8, c = idx & 255; MC[(size_t)(rowb + tt) * 1024 + 768 + c] = f2bf(lds[c * 65 + tt]); }
  __syncthreads();
}

constexpr int NPH = 2 + 9 * 4;

DI void run_phase(const Params& p, int ph, unsigned char* smem) {
  float* lds = (float*)smem;
  const int nb = gridDim.x, bid = blockIdx.x;
  if (ph == 0) {
    for (int it = bid; it < 384 + AUX_ITEMS; it += nb) { if (it < 384) mod_item(p, it, lds); else aux_item(p, 0, it - 384, lds); }
    return;
  }
  if (ph == 1) { row_phase(p, 0, 0); return; }
  const int l = (ph - 2) / 9, k = (ph - 2) % 9;
  unsigned char* slot = p.ws + WS_W + (size_t)(l & 1) * W_SLOT;
  const u16* win = (const u16*)slot; const u16* wout = (const u16*)(slot + W_IN_B); const u16* wff1 = (const u16*)(slot + W_IN_B + W_OUT_B); const u16* wff2 = (const u16*)(slot + W_IN_B + W_OUT_B + W_FF_B);
  switch (k) {
    case 0: gemm_phase<0>(p, (const u16*)(p.ws + WS_H), win, 1024, 14, l, p.ws + WS_U, NU, smem); break;
    case 1:
      for (int it = bid; it < 992; it += nb) {
        if (it < 384) rwkv_prep_item(p, l, it, lds);
        else if (it < 768) attn_prep_item(p, l, it - 384);
        else if (it < 800) cache_item(p, l, it - 768);
        else hy_prep_item(p, l, it - 800, lds);
      }
      break;
    case 2: {
      __shared__ int s_item; __shared__ float s_lam;
      const float lam_init = 0.8f - 0.6f * expf(-0.3f * (float)l);
      const int tid2 = otid();
      if (tid2 < 64) {
        int ln = tid2; float a = p.in[25][l * 64 + ln] * p.in[26][l * 64 + ln]; float b = p.in[27][l * 64 + ln] * p.in[28][l * 64 + ln];
        a = wave_sum(a); b = wave_sum(b); if (ln == 0) s_lam = expf(a) - expf(b) + lam_init;
      }
      __syncthreads();
      const float lam = s_lam;
      unsigned* ctr = (unsigned*)(p.ws + WS_CTL) + l * 64;
      for (;;) {
        __syncthreads();
        if (threadIdx.x == 0) s_item = (int)atomicAdd(ctr, 1u);
        __syncthreads();
        int it = s_item;
        if (it >= 2560) break;
        if (it < 128) { scan_item(p, l, 16 + (it >> 5), (it >> 3) & 3, (it >> 2) & 1, it & 3, lds); }
        else if (it < 384) { int j = it - 128; attn_item(p, l, 16 + (j >> 6), (j >> 4) & 3, j & 15, smem, lam, lam_init); }
        else if (it < 1408) { int j = it - 384; hyena_item(p, l, 16 + (j >> 8), j & 255, lds); }
        else if (it < 1920) { int j = it - 1408; scan_item(p, l, j >> 5, (j >> 3) & 3, (j >> 2) & 1, j & 3, lds); }
        else if (it < 2048) { int j = it - 1920; attn_item(p, l, j >> 3, (j >> 1) & 3, j & 1, smem, lam, lam_init); }
        else { int j = it - 2048; hyena_item(p, l, j >> 5, (j & 31) * 8, lds); }
      }
    } break;
    case 3: for (int it = bid; it < 192; it += nb) fin_item(p, l, it, lds); break;
    case 4: gemm_phase<1>(p, (const u16*)(p.ws + WS_MIXCAT), wout, 1024, 4, l, p.ws + WS_F, 1024, smem); break;
    case 5:
      row_phase(p, l, 1);
      if (l < 3) for (int it = bid; it < AUX_ITEMS; it += nb) aux_item(p, l + 1, it, lds);
      break;
    case 6: gemm_phase<2>(p, (const u16*)(p.ws + WS_H), wff1, 1024, 16, l, p.ws + WS_A, 4096, smem); break;
    case 7: gemm_phase<1>(p, (const u16*)(p.ws + WS_A), wff2, 4096, 4, l, p.ws + WS_F, 1024, smem); break;
    case 8: row_phase(p, l, 2); break;
  }
}

__global__ void __launch_bounds__(512) mega(Params p, int ph_lo, int ph_hi) {
  extern __shared__ __attribute__((aligned(16))) unsigned char smem[];
  for (int ph = ph_lo; ph < ph_hi; ++ph) {
    if (ph > ph_lo) cg::this_grid().sync();
    run_phase(p, ph, smem);
  }
}

extern "C" void kernel_launch(void* const* d_in, const int* in_sizes, int n_in, void* d_out, int out_size, void* d_ws, size_t ws_size, hipStream_t stream) {
  static int grid = 0;
  if (!grid) {
    int dev = 0, cus = 0, per_cu = 0;
    hipGetDevice(&dev);
    hipDeviceGetAttribute(&cus, hipDeviceAttributeMultiprocessorCount, dev);
    hipFuncSetAttribute((const void*)mega, hipFuncAttributeMaxDynamicSharedMemorySize, (int)LDS_BYTES);
    hipOccupancyMaxActiveBlocksPerMultiprocessor(&per_cu, (const void*)mega, NT, LDS_BYTES);
    if (per_cu < 1) { fprintf(stderr, "occupancy query says %d blocks/CU\n", per_cu); per_cu = 1; }
    grid = cus;
  }
  if (n_in != 43 || ws_size < WS_END) { fprintf(stderr, "kernel_launch: bad n_in %d or ws %zu < %zu\n", n_in, ws_size, (size_t)WS_END); return; }
  Params p{};
  for (int i = 0; i < 43; ++i) p.in[i] = (const float*)d_in[i];
  p.out = (float*)d_out; p.ws = (unsigned char*)d_ws;
  hipMemsetAsync((unsigned char*)d_ws + WS_CTL, 0, 4096, stream);
#if ONE_LAUNCH
  int lo = 0, hi = NPH; void* args[] = {&p, &lo, &hi};
  hipError_t e = hipLaunchCooperativeKernel((const void*)mega, dim3(grid), dim3(NT), args, LDS_BYTES, stream);
  if (e != hipSuccess) fprintf(stderr, "cooperative launch failed: %s\n", hipGetErrorString(e));
#else
  for (int ph = 0; ph < NPH; ++ph) hipLaunchKernelGGL(mega, dim3(grid), dim3(NT), LDS_BYTES, stream, p, ph, ph + 1);
#endif
}
```

```cpp
#include <hip/hip_runtime.h>
#include <hip/hip_cooperative_groups.h>
#include <stdint.h>
#include <stdio.h>
namespace cg = cooperative_groups;

#ifndef ONE_LAUNCH
#define ONE_LAUNCH 1
#endif

#define DI __device__ __forceinline__
typedef unsigned short u16;
using bf16x8 = __attribute__((ext_vector_type(8))) short;
using s16x4  = __attribute__((ext_vector_type(4))) short;
using f32x4  = __attribute__((ext_vector_type(4))) float;
using f32x16 = __attribute__((ext_vector_type(16))) float;

constexpr int NT = 512;
constexpr int TT = 12288;
constexpr int NU = 3456;
constexpr size_t LDS_BYTES = 110592;

constexpr size_t WS_CTL = 0;
constexpr size_t WS_MOD = 32768;
constexpr size_t WS_W   = WS_MOD + 491520;
constexpr size_t W_IN_B = 3584ull * 1024 * 2, W_OUT_B = 1024ull * 1024 * 2, W_FF_B = 4096ull * 1024 * 2;
constexpr size_t W_SLOT = W_IN_B + W_OUT_B + 2 * W_FF_B;
constexpr size_t WS_H   = WS_W + 2 * W_SLOT;
constexpr size_t WS_U   = WS_H + (size_t)TT * 1024 * 2;
constexpr size_t WS_MIXCAT = WS_U + (size_t)TT * NU * 2;
constexpr size_t WS_KL  = WS_MIXCAT + (size_t)TT * 1024 * 2;
constexpr size_t WS_VL  = WS_KL + 4ull * 2304 * 512 * 2;
constexpr size_t WS_RW  = WS_VL + 4ull * 2304 * 512 * 2;
constexpr size_t WS_G   = WS_RW + (size_t)TT * 4 * 9 * 64 * 4;
constexpr size_t WS_BC  = WS_G + (size_t)TT * 256 * 4;
constexpr size_t WS_HYT = WS_BC + (size_t)TT * 4 * 4;
constexpr size_t WS_FILT = WS_HYT + 3ull * 256 * TT * 4;
constexpr size_t WS_END = WS_FILT + 2ull * 256 * (512 + 4096) * 4;
constexpr size_t WS_Q  = WS_H;
constexpr size_t WS_KC = WS_Q + (size_t)TT * 512 * 2;
constexpr size_t WS_VC = WS_KC + 16ull * 256 * 512 * 2;
constexpr size_t WS_YS = WS_U;
constexpr size_t WS_YC = WS_U + 2ull * TT * 256 * 4;
constexpr size_t WS_F  = WS_U;
constexpr size_t WS_A  = WS_RW;
static_assert(WS_VC + 16ull * 256 * 512 * 2 <= WS_U, "alias");
static_assert(WS_YC + 256ull * TT * 4 <= WS_MIXCAT, "alias");
static_assert((size_t)TT * 4096 * 2 <= (size_t)TT * 4 * 9 * 64 * 4, "alias");

constexpr size_t OUT_STATE = 12582912, OUT_CK = 14680064, OUT_CV = 23068672;

struct Params {
  const float* in[43];
  float* out;
  unsigned char* ws;
};

DI u16 f2bf(float x) { unsigned u = __float_as_uint(x); u += 0x7fffu + ((u >> 16) & 1u); return (u16)(u >> 16); }
DI float bf2f(u16 b) { return __uint_as_float(((unsigned)b) << 16); }
DI unsigned pack2(float a, float b) { return (unsigned)f2bf(a) | ((unsigned)f2bf(b) << 16); }
DI float wave_sum(float v) {
#pragma unroll
  for (int o = 32; o > 0; o >>= 1) v += __shfl_xor(v, o);
  return v;
}
template <int CTRL> DI float dppf(float x) {
  return __builtin_bit_cast(float, __builtin_amdgcn_update_dpp(0, __builtin_bit_cast(int, x), CTRL, 0xF, 0xF, true));
}
DI float allreduce16(float x) {
  x += dppf<0xB1>(x); x += dppf<0x4E>(x); x += dppf<0x124>(x); x += dppf<0x128>(x);
  return x;
}
DI void seq_of(int row, int& s, int& t, int& L, int& row0) {
  if (row < 4096) { s = row >> 8; t = row & 255; L = 256; row0 = s * 256; }
  else { int r = row - 4096; s = 16 + (r >> 11); t = r & 2047; L = 2048; row0 = 4096 + (r >> 11) * 2048; }
}
DI int otid() { int t = threadIdx.x; asm volatile("" : "+v"(t)); return t; }
DI float sigmoidf_(float x) { return 1.f / (1.f + expf(-x)); }


#define XB_TMO      128
#define XB_XCNT(j)  (256  + 64 * (j))
#define XB_XSUB(j)  (1280 + 64 * (j))
#define XB_XGEN(j)  (2304 + 64 * (j))
#define XB_TOP      3328
#define XB_TOPGEN   3392
#define XB_SPIN_CAP (1u << 22)
#define LAS __attribute__((address_space(3)))
DI unsigned xb_ld(unsigned* p)              { return __hip_atomic_load(p, __ATOMIC_RELAXED, __HIP_MEMORY_SCOPE_AGENT); }
DI unsigned xb_add(unsigned* p, unsigned v) { return __hip_atomic_fetch_add(p, v, __ATOMIC_RELAXED, __HIP_MEMORY_SCOPE_AGENT); }
DI unsigned xb_xcc_id() { return (unsigned)__builtin_amdgcn_s_getreg((3 << 11) | 20) & 0xFu; }
#define XB_SPIN(cond, bar) do { unsigned _sp = 0; while (cond) { __builtin_amdgcn_s_sleep(1); \
    if ((++_sp & 255u) == 0u) { if (xb_ld(&(bar)[XB_TMO])) break; if (_sp > XB_SPIN_CAP) { atomicAdd(&(bar)[XB_TMO], 1u); break; } } } } while (0)
struct XcdBarrier { unsigned* bar; unsigned x; volatile LAS unsigned* st; };
DI XcdBarrier xcd_barrier_post(unsigned* bar, volatile LAS unsigned* st) {
  XcdBarrier b; b.bar = bar; b.x = xb_xcc_id(); b.st = st;
  if (threadIdx.x == 0) (void)xb_add(&bar[XB_XCNT(b.x)], 1u);
  return b;
}
DI void xcd_barrier_complete(unsigned* bar, unsigned x, unsigned& nloc, unsigned& nx) {
  const unsigned G = gridDim.x * gridDim.y * gridDim.z;
  unsigned sum, cnt, mine, sp = 0u;
  for (;;) {
    sum = 0u; cnt = 0u; mine = 0u;
#pragma unroll
    for (unsigned j = 0; j < 16; ++j) { const unsigned c = xb_ld(&bar[XB_XCNT(j)]); sum += c; cnt += (c > 0u) ? 1u : 0u; mine = (j == x) ? c : mine; }
    if (sum == G) break;
    __builtin_amdgcn_s_sleep(1);
    if ((++sp & 255u) == 0u) { if (xb_ld(&bar[XB_TMO])) break; if (sp > XB_SPIN_CAP) { atomicAdd(&bar[XB_TMO], 1u); break; } }
  }
  nloc = mine > 0u ? mine : 1u; nx = cnt > 0u ? cnt : 1u;
}
DI void xcd_barrier(const XcdBarrier& b) {
  asm volatile("s_waitcnt vmcnt(0)" ::: "memory");
  __syncthreads();
  if (threadIdx.x == 0) {
    unsigned* bar = b.bar;
    __builtin_amdgcn_s_waitcnt(0);
    unsigned nloc = b.st[0], nx = b.st[1];
    if (nloc == 0u) { xcd_barrier_complete(bar, b.x, nloc, nx); b.st[0] = nloc; b.st[1] = nx; }
    const unsigned old = xb_add(&bar[XB_XSUB(b.x)], 1u);
    const unsigned gen = old / nloc;
    if (old + 1u == (gen + 1u) * nloc) {
      __builtin_amdgcn_fence(__ATOMIC_RELEASE, "agent");
      asm volatile("s_waitcnt vmcnt(0)" ::: "memory");
      const unsigned og = xb_add(&bar[XB_TOP], 1u);
      const unsigned tg = og / nx;
      if (og + 1u == (tg + 1u) * nx) xb_add(&bar[XB_TOPGEN], 1u);
      else XB_SPIN(xb_ld(&bar[XB_TOPGEN]) == tg, bar);
      __builtin_amdgcn_fence(__ATOMIC_ACQUIRE, "agent");
      xb_add(&bar[XB_XGEN(b.x)], 1u);
      asm volatile("s_waitcnt vmcnt(0)" ::: "memory");
    } else {
      XB_SPIN(xb_ld(&bar[XB_XGEN(b.x)]) == gen, bar);
      __builtin_amdgcn_fence(__ATOMIC_ACQUIRE, "agent");
      asm volatile("s_waitcnt vmcnt(0)" ::: "memory");
    }
  }
  __syncthreads();
}

DI void tr_tile(const float* __restrict__ W, int K, int N, u16* __restrict__ Wt, int k0, int n0, float* lds) {
  const int tid = otid();
#pragma unroll
  for (int i = 0; i < 8; ++i) { int idx = tid + i * 512; int kk = idx >> 6, nn = idx & 63; lds[kk * 65 + nn] = W[(size_t)(k0 + kk) * N + n0 + nn]; }
  __syncthreads();
  const int n = tid >> 3, kg = tid & 7;
  unsigned pk[4];
#pragma unroll
  for (int j = 0; j < 4; ++j) pk[j] = pack2(lds[(kg * 8 + 2 * j) * 65 + n], lds[(kg * 8 + 2 * j + 1) * 65 + n]);
  *(uint4*)(Wt + (size_t)(n0 + n) * K + k0 + kg * 8) = make_uint4(pk[0], pk[1], pk[2], pk[3]);
  __syncthreads();
}

DI void filt_item(const Params& p, int l, int it, float* lds) {
  const int Lsel = it >= 32; const int chunk = Lsel ? it - 32 : it; const int L = Lsel ? 2048 : 256;
  float* emb = lds; float* h1 = lds + 8 * 36; float* h2 = h1 + 512;
  const int tid = otid();
  const float* w1 = p.in[32] + l * 33 * 64; const float* b1 = p.in[33] + l * 64; const float* fr = p.in[34] + l * 64;
  const float* w2 = p.in[35] + l * 4096; const float* b2 = p.in[36] + l * 64; const float* w3 = p.in[37] + (size_t)l * 64 * 1024;
  const float* dec = p.in[38] + l * 256;
  if (tid < 8 * 33) {
    int ti = tid / 33, j = tid % 33; int i = chunk * 8 + ti; float v;
    float ang = (float)(2.0 * 3.14159265358979323846 / (double)L) * (float)i;
    if (j == 0) v = (float)i / (float)(L - 1);
    else if (j <= 16) { float band = 1e-4f + (float)(j - 1) * ((15.f - 1e-4f) / 15.f); v = cosf(band * ang); }
    else { float band = 1e-4f + (float)(j - 17) * ((15.f - 1e-4f) / 15.f); v = -sinf(band * ang); }
    emb[ti * 36 + j] = v;
  }
  __syncthreads();
  { int ti = tid >> 6, j = tid & 63; float a = b1[j]; for (int k = 0; k < 33; ++k) a += emb[ti * 36 + k] * w1[k * 64 + j]; h1[ti * 64 + j] = sinf(fr[j] * a); }
  __syncthreads();
  { int ti = tid >> 6, j = tid & 63; float a = b2[j]; for (int k = 0; k < 64; ++k) a += h1[ti * 64 + k] * w2[k * 64 + j]; h2[ti * 64 + j] = sinf(fr[j] * a); }
  __syncthreads();
  float* FILT = (float*)(p.ws + WS_FILT) + (Lsel ? 262144 : 0);
#pragma unroll
  for (int cc = 0; cc < 2; ++cc) {
    int col = tid + cc * 512; float acc[8];
#pragma unroll
    for (int ti = 0; ti < 8; ++ti) acc[ti] = 0.f;
    for (int k = 0; k < 64; ++k) { float w = w3[k * 1024 + col];
#pragma unroll
      for (int ti = 0; ti < 8; ++ti) acc[ti] += h2[ti * 64 + k] * w; }
    int order = col >> 9, dir = (col >> 8) & 1, c = col & 255; float dc = fabsf(dec[c]);
    float* g = FILT + (size_t)(order * 256 + c) * (2 * L);
#pragma unroll
    for (int ti = 0; ti < 8; ++ti) {
      int i = chunk * 8 + ti; float t = (float)i / (float)(L - 1); float val = acc[ti] * expf(-t * dc);
      if (dir == 0) g[L + i] = val; else { if (i == 0) g[0] = 0.f; else g[L - i] = val; }
    }
  }
  __syncthreads();
}

constexpr int AUX_ITEMS = 864 + 256 + 1024 + 1024 + 1 + 288;
DI void aux_item(const Params& p, int l, int it, float* lds) {
  unsigned char* slot = p.ws + WS_W + (size_t)(l & 1) * W_SLOT;
  u16* win = (u16*)slot; u16* wout = (u16*)(slot + W_IN_B); u16* wff1 = (u16*)(slot + W_IN_B + W_OUT_B); u16* wff2 = (u16*)(slot + W_IN_B + W_OUT_B + W_FF_B);
  if (it < 864) { int kt = it / 54, nt = it % 54; tr_tile(p.in[13] + (size_t)l * 1024 * NU, 1024, NU, win, kt * 64, nt * 64, lds); return; }
  it -= 864;
  if (it < 256) { int kt = it >> 4, nt = it & 15; tr_tile(p.in[40] + (size_t)l * 1024 * 1024, 1024, 1024, wout, kt * 64, nt * 64, lds); return; }
  it -= 256;
  if (it < 1024) { int kt = it >> 6, nt = it & 63; tr_tile(p.in[41] + (size_t)l * 1024 * 4096, 1024, 4096, wff1, kt * 64, nt * 64, lds); return; }
  it -= 1024;
  if (it < 1024) { int kt = it >> 4, nt = it & 15; tr_tile(p.in[42] + (size_t)l * 4096 * 1024, 4096, 1024, wff2, kt * 64, nt * 64, lds); return; }
  it -= 1024;
  if (it < 1) { uint4* z = (uint4*)(win + (size_t)NU * 1024); for (int i = otid(); i < 16384; i += 512) z[i] = make_uint4(0, 0, 0, 0); return; }
  it -= 1;
  filt_item(p, l, it, lds);
}

DI void mod_item(const Params& p, int it, float* lds) {
  const int l = it / 96, cgp = it % 96, tid = otid();
  float* sc = lds; float* red = lds + 5120;
  for (int i = tid; i < 5120; i += 512) { int j = i >> 10, k = i & 1023; float c = (j == 0) ? p.in[6][k] : p.in[5][(j - 1) * 1024 + k]; sc[i] = c / (1.f + expf(-c)); }
  __syncthreads();
  const int c = tid & 63, kg = tid >> 6; const float* w = p.in[7] + (size_t)l * 1024 * 6144 + cgp * 64 + c;
  float acc[5] = {0.f, 0.f, 0.f, 0.f, 0.f};
  for (int k = kg; k < 1024; k += 8) { float wv = w[(size_t)k * 6144];
#pragma unroll
    for (int j = 0; j < 5; ++j) acc[j] += sc[j * 1024 + k] * wv; }
#pragma unroll
  for (int j = 0; j < 5; ++j) red[(kg * 5 + j) * 64 + c] = acc[j];
  __syncthreads();
  if (tid < 320) { int j = tid >> 6, cc = tid & 63; float s = 0.f; for (int g = 0; g < 8; ++g) s += red[(g * 5 + j) * 64 + cc];
    s += p.in[8][l * 6144 + cgp * 64 + cc]; ((float*)(p.ws + WS_MOD))[(l * 5 + j) * 6144 + cgp * 64 + cc] = s; }
  __syncthreads();
}

DI void row_phase(const Params& p, int l, int mode) {
  const int tid = otid(), lane = tid & 63; const int gw = blockIdx.x * 8 + (tid >> 6), nw = gridDim.x * 8;
  float* x = p.out; const float* F = (const float*)(p.ws + WS_F); u16* H = (u16*)(p.ws + WS_H); const float* MOD = (const float*)(p.ws + WS_MOD);
  const float* gpost = nullptr; const float* gpre = nullptr; int gate_ch = 0, sc_ch = 0, sh_ch = 0, lm = l; bool do_h = true;
  if (mode == 0) { gpre = p.in[9] + l * 1024; sc_ch = 1; sh_ch = 0; lm = l; }
  else if (mode == 1) { gpost = p.in[10] + l * 1024; gate_ch = 2; gpre = p.in[11] + l * 1024; sc_ch = 4; sh_ch = 3; lm = l; }
  else { gpost = p.in[12] + l * 1024; gate_ch = 5; if (l < 3) { gpre = p.in[9] + (l + 1) * 1024; sc_ch = 1; sh_ch = 0; lm = l + 1; } else do_h = false; }
  for (int row = gw; row < TT; row += nw) {
    const int j = row < 4096 ? 0 : 1 + ((row - 4096) >> 11);
    const float* xs = (mode == 0) ? (row < 4096 ? p.in[0] + (size_t)row * 1024 : p.in[1] + (size_t)(row - 4096) * 1024) : x + (size_t)row * 1024;
    float4 xv[4];
#pragma unroll
    for (int i = 0; i < 4; ++i) xv[i] = *(const float4*)(xs + i * 256 + lane * 4);
    if (mode != 0) {
      float4 dv[4]; float ss = 0.f;
#pragma unroll
      for (int i = 0; i < 4; ++i) { dv[i] = *(const float4*)(F + (size_t)row * 1024 + i * 256 + lane * 4); ss += dv[i].x * dv[i].x + dv[i].y * dv[i].y + dv[i].z * dv[i].z + dv[i].w * dv[i].w; }
      ss = wave_sum(ss); const float rs = rsqrtf(ss * (1.f / 1024.f) + 1e-6f);
      const float* gt = MOD + (l * 5 + j) * 6144 + gate_ch * 1024;
#pragma unroll
      for (int i = 0; i < 4; ++i) { int col = i * 256 + lane * 4; float4 g4 = *(const float4*)(gt + col); float4 p4 = *(const float4*)(gpost + col);
        xv[i].x += g4.x * dv[i].x * rs * p4.x; xv[i].y += g4.y * dv[i].y * rs * p4.y; xv[i].z += g4.z * dv[i].z * rs * p4.z; xv[i].w += g4.w * dv[i].w * rs * p4.w; }
    }
#pragma unroll
    for (int i = 0; i < 4; ++i) *(float4*)(x + (size_t)row * 1024 + i * 256 + lane * 4) = xv[i];
    if (do_h) {
      float ss = 0.f;
#pragma unroll
      for (int i = 0; i < 4; ++i) ss += xv[i].x * xv[i].x + xv[i].y * xv[i].y + xv[i].z * xv[i].z + xv[i].w * xv[i].w;
      ss = wave_sum(ss); const float rs = rsqrtf(ss * (1.f / 1024.f) + 1e-6f);
      const float* sc = MOD + (lm * 5 + j) * 6144 + sc_ch * 1024; const float* sh = MOD + (lm * 5 + j) * 6144 + sh_ch * 1024;
#pragma unroll
      for (int i = 0; i < 4; ++i) { int col = i * 256 + lane * 4; float4 g4 = *(const float4*)(gpre + col); float4 s4 = *(const float4*)(sc + col); float4 h4 = *(const float4*)(sh + col);
        float a = xv[i].x * rs * g4.x * (1.f + s4.x) + h4.x, b = xv[i].y * rs * g4.y * (1.f + s4.y) + h4.y;
        float c = xv[i].z * rs * g4.z * (1.f + s4.z) + h4.z, d = xv[i].w * rs * g4.w * (1.f + s4.w) + h4.w;
        *(uint2*)(H + (size_t)row * 1024 + col) = make_uint2(pack2(a, b), pack2(c, d)); }
    }
  }
}

template <int EPI>
DI void gemm_phase(const Params& p, const u16* __restrict__ A, const u16* __restrict__ Wt, int K, int NTn, int l, void* Cout, int ldc, unsigned char* smem) {
  u16* As = (u16*)smem; u16* Bs = As + 2 * 128 * 72;
  const int tid = otid(), lane = tid & 63, wid = tid >> 6, wm = wid & 1, wn = wid >> 1, fr = lane & 15, fq = lane >> 4;
  const int ntiles = 96 * NTn, nk = K / 64;
  for (int tile = blockIdx.x; tile < ntiles; tile += gridDim.x) {
    const int mt = tile / NTn, nt = tile % NTn; const int m0 = mt * 128, n0 = nt * 256;
    f32x4 acc[4][4];
#pragma unroll
    for (int i = 0; i < 4; ++i)
#pragma unroll
      for (int j = 0; j < 4; ++j) acc[i][j] = f32x4{0.f, 0.f, 0.f, 0.f};
    uint4 ra[2], rb[4];
    const int lrow = tid >> 3, lkc = tid & 7;
    const u16* ag = A + (size_t)(m0 + lrow) * K + lkc * 8;
    const u16* bg = Wt + (size_t)(n0 + lrow) * K + lkc * 8;
#define GLOAD(kt) { _Pragma("unroll") for (int i = 0; i < 2; ++i) ra[i] = *(const uint4*)(ag + (size_t)i * 64 * K + (kt) * 64); \
                    _Pragma("unroll") for (int i = 0; i < 4; ++i) rb[i] = *(const uint4*)(bg + (size_t)i * 64 * K + (kt) * 64); }
#define SSTORE(buf) { _Pragma("unroll") for (int i = 0; i < 2; ++i) *(uint4*)(As + (buf) * 128 * 72 + (lrow + i * 64) * 72 + lkc * 8) = ra[i]; \
                      _Pragma("unroll") for (int i = 0; i < 4; ++i) *(uint4*)(Bs + (buf) * 256 * 72 + (lrow + i * 64) * 72 + lkc * 8) = rb[i]; }
    GLOAD(0); SSTORE(0); __syncthreads();
    for (int kt = 0; kt < nk; ++kt) {
      if (kt + 1 < nk) GLOAD(kt + 1);
      const u16* as = As + (kt & 1) * 128 * 72 + (wm * 64 + fr) * 72 + fq * 8;
      const u16* bs = Bs + (kt & 1) * 256 * 72 + (wn * 64 + fr) * 72 + fq * 8;
#pragma unroll
      for (int ks = 0; ks < 2; ++ks) {
        bf16x8 wf[4], af[4];
#pragma unroll
        for (int i = 0; i < 4; ++i) { wf[i] = *(const bf16x8*)(bs + i * 16 * 72 + ks * 32); af[i] = *(const bf16x8*)(as + i * 16 * 72 + ks * 32); }
#pragma unroll
        for (int i = 0; i < 4; ++i)
#pragma unroll
          for (int j = 0; j < 4; ++j) acc[i][j] = __builtin_amdgcn_mfma_f32_16x16x32_bf16(wf[i], af[j], acc[i][j], 0, 0, 0);
      }
      if (kt + 1 < nk) SSTORE((kt + 1) & 1);
      __syncthreads();
    }
#undef GLOAD
#undef SSTORE
#pragma unroll
    for (int i = 0; i < 4; ++i)
#pragma unroll
      for (int j = 0; j < 4; ++j) {
        const int row = m0 + wm * 64 + j * 16 + fr; const int col = n0 + wn * 64 + i * 16 + fq * 4; const f32x4 v = acc[i][j];
        if (EPI == 0) {
          if (col < NU) {
            *(uint2*)((u16*)Cout + (size_t)row * NU + col) = make_uint2(pack2(v[0], v[1]), pack2(v[2], v[3]));
            if (row < 4096 && col >= 1664 && col < 2688) {
              int b = row >> 8, t = row & 255;
              float* dst = (col < 2176) ? p.out + OUT_CK + ((size_t)((b * 4 + l) * 256 + t)) * 512 + (col - 1664)
                                        : p.out + OUT_CV + ((size_t)((b * 4 + l) * 256 + t)) * 512 + (col - 2176);
              *(float4*)dst = make_float4(v[0], v[1], v[2], v[3]);
            }
          }
        } else if (EPI == 1) {
          *(float4*)((float*)Cout + (size_t)row * ldc + col) = make_float4(v[0], v[1], v[2], v[3]);
        } else {
          float a = fmaxf(v[0], 0.f), b = fmaxf(v[1], 0.f), c = fmaxf(v[2], 0.f), d = fmaxf(v[3], 0.f);
          *(uint2*)((u16*)Cout + (size_t)row * ldc + col) = make_uint2(pack2(a * a, b * b), pack2(c * c, d * d));
        }
      }
  }
}

DI void rwkv_prep_item(const Params& p, int l, int tile, float* lds) {
  const int tid = otid();
  const int rowb = tile * 32; int s, t0, L, row0; seq_of(rowb, s, t0, L, row0);
  const u16* U = (const u16*)(p.ws + WS_U);
  float* tw = lds; float* ua = lds + 4096; float* sg = lds + 8192;
  for (int idx = tid; idx < 32 * 384; idx += 512) {
    int tok = idx / 384, c = idx % 384; float v = bf2f(U[(size_t)(rowb + tok) * NU + 768 + c]);
    if (c < 128) tw[tok * 128 + c] = tanhf(v); else if (c < 256) ua[tok * 128 + c - 128] = v; else sg[tok * 128 + c - 256] = sigmoidf_(v);
  }
  __syncthreads();
  const int c = tid & 255, tg = tid >> 8, h = c >> 6;
  float ag[16], awf[16], awb[16], aaf[16], aab[16];
#pragma unroll
  for (int i = 0; i < 16; ++i) { ag[i] = 0.f; awf[i] = 0.f; awb[i] = 0.f; aaf[i] = 0.f; aab[i] = 0.f; }
  const float* g2 = p.in[19] + (size_t)l * 128 * 256 + c; const float* w2 = p.in[16] + (size_t)l * 2 * 64 * 256 + c; const float* a2 = p.in[18] + (size_t)l * 2 * 64 * 256 + c;
  for (int k = 0; k < 128; k += 4) {
    float w0 = g2[(k) * 256], w1 = g2[(k + 1) * 256], w2_ = g2[(k + 2) * 256], w3 = g2[(k + 3) * 256];
#pragma unroll
    for (int tt = 0; tt < 16; ++tt) { float4 sv = *(const float4*)(sg + (tg * 16 + tt) * 128 + k); ag[tt] += sv.x * w0 + sv.y * w1 + sv.z * w2_ + sv.w * w3; }
  }
  for (int k = 0; k < 64; k += 4) {
    float wf[4], wb[4], af[4], ab[4];
#pragma unroll
    for (int q = 0; q < 4; ++q) { wf[q] = w2[(k + q) * 256]; wb[q] = w2[(64 + k + q) * 256]; af[q] = a2[(k + q) * 256]; ab[q] = a2[(64 + k + q) * 256]; }
#pragma unroll
    for (int tt = 0; tt < 16; ++tt) {
      const int tok = tg * 16 + tt;
      float4 t1 = *(const float4*)(tw + tok * 128 + k), t2 = *(const float4*)(tw + tok * 128 + 64 + k);
      float4 u1 = *(const float4*)(ua + tok * 128 + k), u2 = *(const float4*)(ua + tok * 128 + 64 + k);
      awf[tt] += t1.x * wf[0] + t1.y * wf[1] + t1.z * wf[2] + t1.w * wf[3];
      awb[tt] += t2.x * wb[0] + t2.y * wb[1] + t2.z * wb[2] + t2.w * wb[3];
      aaf[tt] += u1.x * af[0] + u1.y * af[1] + u1.z * af[2] + u1.w * af[3];
      aab[tt] += u2.x * ab[0] + u2.y * ab[1] + u2.z * ab[2] + u2.w * ab[3];
    }
  }
  const float* cw = p.in[14] + (size_t)l * 3 * 768;
  float cr[3], ck[3], cv[3];
#pragma unroll
  for (int q = 0; q < 3; ++q) { cr[q] = cw[q * 768 + c]; ck[q] = cw[q * 768 + 256 + c]; cv[q] = cw[q * 768 + 512 + c]; }
  const float kkw = p.in[20][l * 256 + c], ka = p.in[21][l * 256 + c], rk = p.in[22][l * 256 + c];
  const float w0f = p.in[15][(l * 2 + 0) * 256 + c], w0b = p.in[15][(l * 2 + 1) * 256 + c];
  const float a0f = p.in[17][(l * 2 + 0) * 256 + c], a0b = p.in[17][(l * 2 + 1) * 256 + c];
  float* RW = (float*)(p.ws + WS_RW); float* G = (float*)(p.ws + WS_G); float* BC = (float*)(p.ws + WS_BC);
#pragma unroll
  for (int tt = 0; tt < 16; ++tt) {
    const int tok = tg * 16 + tt, row = rowb + tok, t = t0 + tok;
    const u16* ur = U + (size_t)row * NU + c;
    float r0 = bf2f(ur[0]), k0 = bf2f(ur[256]), v0 = bf2f(ur[512]);
    float rm = 0.f, km = 0.f, vm = 0.f, rp = 0.f, kp = 0.f, vp = 0.f;
    if (t > 0) { rm = bf2f(ur[-NU]); km = bf2f(ur[256 - NU]); vm = bf2f(ur[512 - NU]); }
    if (t + 1 < L) { rp = bf2f(ur[NU]); kp = bf2f(ur[256 + NU]); vp = bf2f(ur[512 + NU]); }
    const float r = cr[0] * rm + cr[1] * r0 + cr[2] * rp;
    const float k = ck[0] * km + ck[1] * k0 + ck[2] * kp;
    const float v = cv[0] * vm + cv[1] * v0 + cv[2] * vp;
    const float kkr = k * kkw; const float ss = wave_sum(kkr * kkr); const float kk = kkr * rsqrtf(ss + 1e-12f);
    const float sgf = sigmoidf_(w0f + awf[tt]); const float decf = expf(-0.60653066f * sgf);
    const float sgb = sigmoidf_(w0b + awb[tt]); const float decb = expf(-0.60653066f * sgb);
    const float af_ = sigmoidf_(a0f + aaf[tt]), ab_ = sigmoidf_(a0b + aab[tt]);
    const float kdf = k * (1.f + (af_ - 1.f) * ka), kdb = k * (1.f + (ab_ - 1.f) * ka);
    const float bonus = wave_sum(r * (kdf + kdb) * rk);
    float* dst = RW + ((size_t)(row * 4 + h) * 9) * 64 + (c & 63);
    dst[0] = r; dst[64] = kk; dst[128] = v; dst[192] = decf; dst[256] = kk * af_; dst[320] = kdf; dst[384] = decb; dst[448] = kk * ab_; dst[512] = kdb;
    G[(size_t)row * 256 + c] = ag[tt];
    if ((c & 63) == 0) BC[row * 4 + h] = bonus;
  }
  __syncthreads();
}

DI void attn_prep_item(const Params& p, int l, int tile) {
  const int tid = otid();
  const int rowb = tile * 32; int s, t0, L, row0; seq_of(rowb, s, t0, L, row0);
  const bool lat = s >= 16;
  const u16* U = (const u16*)(p.ws + WS_U);
  u16* Q = (u16*)(p.ws + WS_Q);
  u16* Kd = lat ? (u16*)(p.ws + WS_KL) + ((size_t)(s - 16) * 2304 + 256) * 512 : (u16*)(p.ws + WS_KC) + (size_t)s * 256 * 512;
  u16* Vd = lat ? (u16*)(p.ws + WS_VL) + ((size_t)(s - 16) * 2304 + 256) * 512 : (u16*)(p.ws + WS_VC) + (size_t)s * 256 * 512;
  for (int uidx = tid; uidx < 2048; uidx += 512) {
    const int g = uidx & 1, pb = (uidx >> 1) & 1, hm = (uidx >> 2) & 7, which = (uidx >> 5) & 1, tok = uidx >> 6;
    const int row = rowb + tok, t = t0 + tok;
    const u16* src = U + (size_t)row * NU + (which ? 1664 : 1152) + hm * 64 + pb * 32 + g * 8;
    const uint4 va = *(const uint4*)src; const uint4 vb = *(const uint4*)(src + 16);
    const unsigned wa[4] = {va.x, va.y, va.z, va.w}, wb[4] = {vb.x, vb.y, vb.z, vb.w};
    float oa[8], ob[8];
#pragma unroll
    for (int j = 0; j < 8; ++j) {
      float xa = bf2f((u16)(wa[j >> 1] >> ((j & 1) * 16))), xb = bf2f((u16)(wb[j >> 1] >> ((j & 1) * 16)));
      if (lat) {
        const int pidx = pb == 0 ? (t >> 6) : (t & 63); const int i = g * 8 + j;
        const float inv = exp2f(-(float)(2 * i) * (13.287712379549449f / 32.f)); const float ang = (float)pidx * inv;
        const float cs = cosf(ang), sn = sinf(ang);
        oa[j] = xa * cs - xb * sn; ob[j] = xb * cs + xa * sn;
      } else { oa[j] = xa; ob[j] = xb; }
    }
    u16* dst = (which == 0) ? Q + (size_t)row * 512 + hm * 64 + pb * 32 + g * 8 : Kd + (size_t)t * 512 + hm * 64 + pb * 32 + g * 8;
    *(uint4*)dst = make_uint4(pack2(oa[0], oa[1]), pack2(oa[2], oa[3]), pack2(oa[4], oa[5]), pack2(oa[6], oa[7]));
    *(uint4*)(dst + 16) = make_uint4(pack2(ob[0], ob[1]), pack2(ob[2], ob[3]), pack2(ob[4], ob[5]), pack2(ob[6], ob[7]));
  }
  for (int uidx = tid; uidx < 2048; uidx += 512) {
    const int tok = uidx >> 6, ch = uidx & 63;
    *(uint4*)(Vd + (size_t)(t0 + tok) * 512 + ch * 8) = *(const uint4*)(U + (size_t)(rowb + tok) * NU + 2176 + ch * 8);
  }
}

DI void cache_item(const Params& p, int l, int it) {
  const int b = it >> 3, pc = it & 7;
  u16* KL = (u16*)(p.ws + WS_KL); u16* VL = (u16*)(p.ws + WS_VL);
  for (int idx = otid(); idx < 32 * 128; idx += 512) {
    const int r = idx >> 7, c4 = idx & 127, prow = pc * 32 + r;
    const size_t so = ((size_t)(b * 4 + l) * 256 + prow) * 512 + c4 * 4; const size_t d_o = ((size_t)b * 2304 + prow) * 512 + c4 * 4;
    float4 kv = *(const float4*)(p.in[3] + so); float4 vv = *(const float4*)(p.in[4] + so);
    *(uint2*)(KL + d_o) = make_uint2(pack2(kv.x, kv.y), pack2(kv.z, kv.w));
    *(uint2*)(VL + d_o) = make_uint2(pack2(vv.x, vv.y), pack2(vv.z, vv.w));
  }
}

DI void hy_prep_item(const Params& p, int l, int tile, float* lds) {
  const int tid = otid();
  const int rowb = tile * 64; int s, t0, L, row0; seq_of(rowb, s, t0, L, row0);
  const u16* U = (const u16*)(p.ws + WS_U); float* HYT = (float*)(p.ws + WS_HYT);
  for (int which = 0; which < 3; ++which) {
    const int c = tid & 255, tg = tid >> 8, col = which * 256 + c;
    const float w0 = p.in[30][(size_t)l * 3 * 768 + col], w1 = p.in[30][(size_t)l * 3 * 768 + 768 + col], w2 = p.in[30][(size_t)l * 3 * 768 + 1536 + col];
    const float bias = p.in[31][l * 768 + col];
    for (int tt = 0; tt < 32; ++tt) {
      const int tok = tg * 32 + tt, row = rowb + tok, t = t0 + tok;
      const u16* ur = U + (size_t)row * NU + 2688 + col;
      float um = t > 0 ? bf2f(ur[-NU]) : 0.f, u0 = bf2f(ur[0]), up = (t + 1 < L) ? bf2f(ur[NU]) : 0.f;
      lds[tok * 257 + c] = w0 * um + w1 * u0 + w2 * up + bias;
    }
    __syncthreads();
    const int cc = tid >> 1, half = tid & 1;
    float* dst = HYT + (size_t)(which * 256 + cc) * TT + rowb + half * 32;
#pragma unroll
    for (int i = 0; i < 32; i += 4) {
      float4 v = make_float4(lds[(half * 32 + i) * 257 + cc], lds[(half * 32 + i + 1) * 257 + cc], lds[(half * 32 + i + 2) * 257 + cc], lds[(half * 32 + i + 3) * 257 + cc]);
      *(float4*)(dst + i) = v;
    }
    __syncthreads();
  }
}

DI void scan_item(const Params& p, int l, int s, int h, int d, int rg, float* lds) {
  int L, row0; if (s < 16) { L = 256; row0 = s * 256; } else { L = 2048; row0 = 4096 + (s - 16) * 2048; }
  const float* RW = (const float*)(p.ws + WS_RW); float* YS = (float*)(p.ws + WS_YS) + (size_t)d * TT * 256;
  const int tid = otid(), lane = tid & 63, wid = tid >> 6, lane16 = lane & 15, rsub = lane >> 4;
  const int row = rg * 16 + (wid & 3) * 4 + rsub;
  float4 st = make_float4(0.f, 0.f, 0.f, 0.f);
  if (s >= 16 && wid < 4) st = *(const float4*)(p.in[2] + ((((size_t)(s - 16) * 4 + l) * 2 + d) * 4 + h) * 4096 + row * 64 + lane16 * 4);
  const int nch = L / 32;
  float4 pre0, pre1, pre2, pre3, pre4, pre5;
  auto ldpre = [&](int ch, int j) -> float4 {
    int f = tid + j * 512; int step = f / 96, within = f % 96; int slot6 = within >> 4, q = within & 15;
    int srcslot = slot6 < 3 ? slot6 : 3 + 3 * d + (slot6 - 3); int i = ch * 32 + step; int t = d ? L - 1 - i : i;
    return *(const float4*)(RW + ((size_t)((row0 + t) * 4 + h) * 9 + srcslot) * 64 + q * 4); };
#define PREFETCH(ch) { pre0 = ldpre(ch, 0); pre1 = ldpre(ch, 1); pre2 = ldpre(ch, 2); pre3 = ldpre(ch, 3); pre4 = ldpre(ch, 4); pre5 = ldpre(ch, 5); }
  PREFETCH(0);
  for (int ch = 0; ch < nch; ++ch) {
    *(float4*)(lds + (size_t)(tid + 0 * 512) * 4) = pre0; *(float4*)(lds + (size_t)(tid + 1 * 512) * 4) = pre1;
    *(float4*)(lds + (size_t)(tid + 2 * 512) * 4) = pre2; *(float4*)(lds + (size_t)(tid + 3 * 512) * 4) = pre3;
    *(float4*)(lds + (size_t)(tid + 4 * 512) * 4) = pre4; *(float4*)(lds + (size_t)(tid + 5 * 512) * 4) = pre5;
    __syncthreads();
    if (ch + 1 < nch) PREFETCH(ch + 1);
    if (wid < 4) {
#pragma unroll 4
      for (int step = 0; step < 32; ++step) {
        const float* base = lds + step * 384;
        const float4 r4 = *(const float4*)(base + lane16 * 4), kk4 = *(const float4*)(base + 64 + lane16 * 4);
        const float vrow = base[128 + row];
        const float4 w4 = *(const float4*)(base + 192 + lane16 * 4), b4 = *(const float4*)(base + 256 + lane16 * 4), kd4 = *(const float4*)(base + 320 + lane16 * 4);
        float sa = -(st.x * kk4.x + st.y * kk4.y + st.z * kk4.z + st.w * kk4.w);
        sa = allreduce16(sa);
        st.x = st.x * w4.x + (sa * b4.x + vrow * kd4.x);
        st.y = st.y * w4.y + (sa * b4.y + vrow * kd4.y);
        st.z = st.z * w4.z + (sa * b4.z + vrow * kd4.z);
        st.w = st.w * w4.w + (sa * b4.w + vrow * kd4.w);
        float y = st.x * r4.x + st.y * r4.y + st.z * r4.z + st.w * r4.w;
        y = allreduce16(y);
        if (lane16 == 0) { int i = ch * 32 + step; int t = d ? L - 1 - i : i; YS[(size_t)(row0 + t) * 256 + h * 64 + row] = y; }
      }
    }
    __syncthreads();
  }
#undef PREFETCH
  if (s < 16 && wid < 4) *(float4*)(p.out + OUT_STATE + ((((size_t)s * 4 + l) * 2 + d) * 4 + h) * 4096 + row * 64 + lane16 * 4) = st;
}

DI void attn_item(const Params& p, int l, int s, int h, int qt, unsigned char* smem, float lam, float lam_init) {
  u16* Ks = (u16*)smem; u16* Vs = Ks + 64 * 136; float* Ex = (float*)(smem + 2 * 17408);
  const bool lat = s >= 16; const int Lk = lat ? 2304 : 256;
  const u16* Kg = lat ? (const u16*)(p.ws + WS_KL) + (size_t)(s - 16) * 2304 * 512 : (const u16*)(p.ws + WS_KC) + (size_t)s * 256 * 512;
  const u16* Vg = lat ? (const u16*)(p.ws + WS_VL) + (size_t)(s - 16) * 2304 * 512 : (const u16*)(p.ws + WS_VC) + (size_t)s * 256 * 512;
  const int row0 = lat ? 4096 + (s - 16) * 2048 : s * 256; const int qrow0 = row0 + qt * 128;
  const u16* Q = (const u16*)(p.ws + WS_Q);
  const int tid = otid(), lane = tid & 63, wid = tid >> 6, m = wid & 1, qs = wid >> 1, r = lane & 31, hh = lane >> 5;
  bf16x8 qf[4];
#pragma unroll
  for (int ks = 0; ks < 4; ++ks) qf[ks] = *(const bf16x8*)(Q + (size_t)(qrow0 + qs * 32 + r) * 512 + h * 128 + m * 64 + ks * 16 + hh * 8);
  f32x16 o[4];
#pragma unroll
  for (int et = 0; et < 4; ++et)
#pragma unroll
    for (int i = 0; i < 16; ++i) o[et][i] = 0.f;
  float mrun = -1e30f, lsum = 0.f; const float cs = 0.125f * 1.4426950408889634f;
  for (int kt0 = 0; kt0 < Lk; kt0 += 64) {
    __syncthreads();
#pragma unroll
    for (int i = 0; i < 2; ++i) { int id = tid + i * 512; int key = id >> 4, ch = id & 15;
      *(uint4*)(Ks + key * 136 + ch * 8) = *(const uint4*)(Kg + (size_t)(kt0 + key) * 512 + h * 128 + ch * 8); }
#pragma unroll
    for (int i = 0; i < 2; ++i) { int id = tid + i * 512; int key = id & 63, e8 = id >> 6;
      const uint4 v = *(const uint4*)(Vg + (size_t)(kt0 + key) * 512 + h * 128 + e8 * 8);
      const unsigned w[4] = {v.x, v.y, v.z, v.w};
#pragma unroll
      for (int j = 0; j < 8; ++j) Vs[(e8 * 8 + j) * 68 + key] = (u16)(w[j >> 1] >> ((j & 1) * 16)); }
    __syncthreads();
    f32x16 st[2];
#pragma unroll
    for (int kt = 0; kt < 2; ++kt) {
#pragma unroll
      for (int i = 0; i < 16; ++i) st[kt][i] = 0.f;
#pragma unroll
      for (int ks = 0; ks < 4; ++ks) { const bf16x8 kf = *(const bf16x8*)(Ks + (kt * 32 + r) * 136 + m * 64 + ks * 16 + hh * 8);
        st[kt] = __builtin_amdgcn_mfma_f32_32x32x16_bf16(kf, qf[ks], st[kt], 0, 0, 0); }
    }
    float mx = st[0][0];
#pragma unroll
    for (int i = 0; i < 16; ++i) { mx = fmaxf(mx, st[0][i]); mx = fmaxf(mx, st[1][i]); }
    mx = fmaxf(mx, __shfl_xor(mx, 32));
    const float mnew = fmaxf(mrun, mx); const float alpha = exp2f((mrun - mnew) * cs); mrun = mnew;
    lsum *= alpha;
#pragma unroll
    for (int et = 0; et < 4; ++et)
#pragma unroll
      for (int i = 0; i < 16; ++i) o[et][i] *= alpha;
#pragma unroll
    for (int kt = 0; kt < 2; ++kt)
#pragma unroll
      for (int i = 0; i < 16; ++i) { float pv = exp2f((st[kt][i] - mnew) * cs); lsum += pv; st[kt][i] = pv; }
#pragma unroll
    for (int kt = 0; kt < 2; ++kt)
#pragma unroll
      for (int ss = 0; ss < 2; ++ss) {
        bf16x8 pf;
#pragma unroll
        for (int j = 0; j < 8; ++j) pf[j] = (short)f2bf(st[kt][8 * ss + j]);
#pragma unroll
        for (int et = 0; et < 4; ++et) {
          const u16* vp = Vs + (et * 32 + r) * 68 + kt * 32 + 16 * ss + 4 * hh;
          const s16x4 lo = *(const s16x4*)vp, hi = *(const s16x4*)(vp + 8);
          const bf16x8 vf = __builtin_shufflevector(lo, hi, 0, 1, 2, 3, 4, 5, 6, 7);
          o[et] = __builtin_amdgcn_mfma_f32_32x32x16_bf16(vf, pf, o[et], 0, 0, 0);
        }
      }
  }
  lsum += __shfl_xor(lsum, 32); const float inv = 1.f / lsum;
  float* ex = Ex + qs * (32 * 132);
  if (m == 1) {
#pragma unroll
    for (int et = 0; et < 4; ++et)
#pragma unroll
      for (int i = 0; i < 16; ++i) { int e = et * 32 + (i & 3) + 8 * (i >> 2) + 4 * hh; ex[r * 132 + e] = o[et][i] * inv; }
  }
  __syncthreads();
  if (m == 0) {
    float ssq = 0.f;
#pragma unroll
    for (int et = 0; et < 4; ++et)
#pragma unroll
      for (int i = 0; i < 16; ++i) { int e = et * 32 + (i & 3) + 8 * (i >> 2) + 4 * hh; float v = o[et][i] * inv - lam * ex[r * 132 + e]; o[et][i] = v; ssq += v * v; }
    ssq += __shfl_xor(ssq, 32);
    const float rs = rsqrtf(ssq * (1.f / 128.f) + 1e-6f) * (1.f - lam_init);
    const float* subln = p.in[29] + l * 128;
    u16* dstrow = (u16*)(p.ws + WS_MIXCAT) + (size_t)(qrow0 + qs * 32 + r) * 1024 + 256 + h * 128;
#pragma unroll
    for (int et = 0; et < 4; ++et)
#pragma unroll
      for (int g4 = 0; g4 < 4; ++g4) {
        const int e0 = et * 32 + 8 * g4 + 4 * hh; const float4 sl = *(const float4*)(subln + e0);
        *(uint2*)(dstrow + e0) = make_uint2(pack2(o[et][4 * g4] * rs * sl.x, o[et][4 * g4 + 1] * rs * sl.y), pack2(o[et][4 * g4 + 2] * rs * sl.z, o[et][4 * g4 + 3] * rs * sl.w));
      }
  }
}

DI void hy_conv(const float* g, const float* z, int L, int t0, float& a0, float& a1, float& a2, float& a3) {
  a0 = a1 = a2 = a3 = 0.f;
  const float* gp = g + L + t0 - 4;
  const int nb = L >> 2;
#pragma unroll 4
  for (int sb = 0; sb < nb; ++sb) {
    const float4 zz = *(const float4*)(z + sb * 4);
    const float4 ga = *(const float4*)(gp - 4 * sb), gb = *(const float4*)(gp - 4 * sb + 4);
    a0 += gb.x * zz.x + ga.w * zz.y + ga.z * zz.z + ga.y * zz.w;
    a1 += gb.y * zz.x + gb.x * zz.y + ga.w * zz.z + ga.z * zz.w;
    a2 += gb.z * zz.x + gb.y * zz.y + gb.x * zz.z + ga.w * zz.w;
    a3 += gb.w * zz.x + gb.z * zz.y + gb.y * zz.z + gb.x * zz.w;
  }
}

DI void hyena_item(const Params& p, int l, int s, int c0, float* lds) {
  const bool lat = s >= 16; const int L = lat ? 2048 : 256; const int row0 = lat ? 4096 + (s - 16) * 2048 : s * 256;
  const int TPC = L >> 2; const int tid = otid(), lane = tid & 63, wid = tid >> 6;
  const int ch = tid / TPC, tl = tid % TPC, t0 = tl * 4, c = c0 + ch;
  float* G = lds; float* Z = lds + 8192; float* red = lds + 8192 + 2048;
  const float* F = (const float*)(p.ws + WS_FILT) + (lat ? 262144 : 0);
  const float* HYT = (const float*)(p.ws + WS_HYT);
  float ssq[2];
#pragma unroll
  for (int o = 0; o < 2; ++o) {
    const float* src = F + (size_t)(o * 256 + c) * (2 * L); float* dst = G + (size_t)(ch * 2 + o) * (2 * L); float sacc = 0.f;
#pragma unroll
    for (int i = 0; i < 2; ++i) { int idx = (tl + i * TPC) * 4; float4 v = *(const float4*)(src + idx); *(float4*)(dst + idx) = v; sacc += v.x * v.x + v.y * v.y + v.z * v.z + v.w * v.w; }
    ssq[o] = wave_sum(sacc);
  }
  if (lane == 0) { red[wid * 2] = ssq[0]; red[wid * 2 + 1] = ssq[1]; }
  const float4 x1 = *(const float4*)(HYT + (size_t)(0 * 256 + c) * TT + row0 + t0);
  const float4 x2 = *(const float4*)(HYT + (size_t)(1 * 256 + c) * TT + row0 + t0);
  const float4 v4 = *(const float4*)(HYT + (size_t)(2 * 256 + c) * TT + row0 + t0);
  *(float4*)(Z + ch * L + t0) = v4;
  __syncthreads();
  const int wpc = TPC >> 6, w0 = ch * wpc; float sc0 = 0.f, sc1 = 0.f;
  for (int w = 0; w < wpc; ++w) { sc0 += red[(w0 + w) * 2]; sc1 += red[(w0 + w) * 2 + 1]; }
  sc0 = rsqrtf(sc0 + 1e-6f); sc1 = rsqrtf(sc1 + 1e-6f);
  const float bias0 = p.in[39][(l * 2 + 0) * 256 + c], bias1 = p.in[39][(l * 2 + 1) * 256 + c];
  float a0, a1, a2, a3;
  hy_conv(G + (size_t)(ch * 2 + 0) * (2 * L), Z + ch * L, L, t0, a0, a1, a2, a3);
  float4 z1;
  z1.x = x1.x * (sc0 * a0 + bias0 * v4.x); z1.y = x1.y * (sc0 * a1 + bias0 * v4.y); z1.z = x1.z * (sc0 * a2 + bias0 * v4.z); z1.w = x1.w * (sc0 * a3 + bias0 * v4.w);
  __syncthreads();
  *(float4*)(Z + ch * L + t0) = z1;
  __syncthreads();
  hy_conv(G + (size_t)(ch * 2 + 1) * (2 * L), Z + ch * L, L, t0, a0, a1, a2, a3);
  float4 yo;
  yo.x = x2.x * (sc1 * a0 + bias1 * z1.x); yo.y = x2.y * (sc1 * a1 + bias1 * z1.y); yo.z = x2.z * (sc1 * a2 + bias1 * z1.z); yo.w = x2.w * (sc1 * a3 + bias1 * z1.w);
  *(float4*)((float*)(p.ws + WS_YC) + (size_t)c * TT + row0 + t0) = yo;
  __syncthreads();
}

DI void fin_item(const Params& p, int l, int tile, float* lds) {
  const int tid = otid(), lane = tid & 63, wid = tid >> 6; const int rowb = tile * 64;
  const float* YS0 = (const float*)(p.ws + WS_YS); const float* YS1 = YS0 + (size_t)TT * 256;
  const float* RW = (const float*)(p.ws + WS_RW); const float* G = (const float*)(p.ws + WS_G); const float* BC = (const float*)(p.ws + WS_BC);
  u16* MC = (u16*)(p.ws + WS_MIXCAT);
  for (int q = 0; q < 32; ++q) {
    const int pair = wid * 32 + q, tok = pair >> 2, h = pair & 3, row = rowb + tok, c = h * 64 + lane;
    const float y = YS0[(size_t)row * 256 + c] + YS1[(size_t)row * 256 + c];
    const float mu = wave_sum(y) * (1.f / 64.f); const float dv = y - mu; const float var = wave_sum(dv * dv) * (1.f / 64.f);
    const float yn = dv * rsqrtf(var + 64e-5f) * p.in[23][l * 256 + c] + p.in[24][l * 256 + c];
    const float v = RW[((size_t)(row * 4 + h) * 9 + 2) * 64 + lane]; const float bc = BC[row * 4 + h]; const float g = G[(size_t)row * 256 + c];
    MC[(size_t)row * 1024 + c] = f2bf((yn + bc * v) * g);
  }
  const float* YC = (const float*)(p.ws + WS_YC);
  for (int idx = tid; idx < 16384; idx += 512) { int c = idx >> 6, tt = idx & 63; lds[c * 65 + tt] = YC[(size_t)c * TT + rowb + tt]; }
  __syncthreads();
  for (int idx = tid; idx < 16384; idx += 512) { int tt = idx >> 8, c = idx & 255; MC[(size_t)(rowb + tt) * 1024 + 768 + c] = f2bf(lds[c * 65 + tt]); }
  __syncthreads();
}

constexpr int NPH = 2 + 9 * 4;

DI void run_phase(const Params& p, int ph, unsigned char* smem) {
  float* lds = (float*)smem;
  const int nb = gridDim.x, bid = blockIdx.x;
  if (ph == 0) {
    for (int it = bid; it < 384 + AUX_ITEMS; it += nb) { if (it < 384) mod_item(p, it, lds); else aux_item(p, 0, it - 384, lds); }
    return;
  }
  if (ph == 1) { row_phase(p, 0, 0); return; }
  const int l = (ph - 2) / 9, k = (ph - 2) % 9;
  unsigned char* slot = p.ws + WS_W + (size_t)(l & 1) * W_SLOT;
  const u16* win = (const u16*)slot; const u16* wout = (const u16*)(slot + W_IN_B); const u16* wff1 = (const u16*)(slot + W_IN_B + W_OUT_B); const u16* wff2 = (const u16*)(slot + W_IN_B + W_OUT_B + W_FF_B);
  switch (k) {
    case 0: gemm_phase<0>(p, (const u16*)(p.ws + WS_H), win, 1024, 14, l, p.ws + WS_U, NU, smem); break;
    case 1:
      for (int it = bid; it < 992; it += nb) {
        if (it < 384) rwkv_prep_item(p, l, it, lds);
        else if (it < 768) attn_prep_item(p, l, it - 384);
        else if (it < 800) cache_item(p, l, it - 768);
        else hy_prep_item(p, l, it - 800, lds);
      }
      break;
    case 2: {
      __shared__ int s_item; __shared__ float s_lam;
      const float lam_init = 0.8f - 0.6f * expf(-0.3f * (float)l);
      const int tid2 = otid();
      if (tid2 < 64) {
        int ln = tid2; float a = p.in[25][l * 64 + ln] * p.in[26][l * 64 + ln]; float b = p.in[27][l * 64 + ln] * p.in[28][l * 64 + ln];
        a = wave_sum(a); b = wave_sum(b); if (ln == 0) s_lam = expf(a) - expf(b) + lam_init;
      }
      __syncthreads();
      const float lam = s_lam;
      unsigned* ctr = (unsigned*)(p.ws + WS_CTL + 16384) + l * 64;
      for (;;) {
        __syncthreads();
        if (threadIdx.x == 0) s_item = (int)atomicAdd(ctr, 1u);
        __syncthreads();
        int it = s_item;
        if (it >= 2560) break;
        if (it < 128) { scan_item(p, l, 16 + (it >> 5), (it >> 3) & 3, (it >> 2) & 1, it & 3, lds); }
        else if (it < 384) { int j = it - 128; attn_item(p, l, 16 + (j >> 6), (j >> 4) & 3, j & 15, smem, lam, lam_init); }
        else if (it < 1408) { int j = it - 384; hyena_item(p, l, 16 + (j >> 8), j & 255, lds); }
        else if (it < 1920) { int j = it - 1408; scan_item(p, l, j >> 5, (j >> 3) & 3, (j >> 2) & 1, j & 3, lds); }
        else if (it < 2048) { int j = it - 1920; attn_item(p, l, j >> 3, (j >> 1) & 3, j & 1, smem, lam, lam_init); }
        else { int j = it - 2048; hyena_item(p, l, j >> 5, (j & 31) * 8, lds); }
      }
    } break;
    case 3: for (int it = bid; it < 192; it += nb) fin_item(p, l, it, lds); break;
    case 4: gemm_phase<1>(p, (const u16*)(p.ws + WS_MIXCAT), wout, 1024, 4, l, p.ws + WS_F, 1024, smem); break;
    case 5:
      row_phase(p, l, 1);
      if (l < 3) for (int it = bid; it < AUX_ITEMS; it += nb) aux_item(p, l + 1, it, lds);
      break;
    case 6: gemm_phase<2>(p, (const u16*)(p.ws + WS_H), wff1, 1024, 16, l, p.ws + WS_A, 4096, smem); break;
    case 7: gemm_phase<1>(p, (const u16*)(p.ws + WS_A), wff2, 4096, 4, l, p.ws + WS_F, 1024, smem); break;
    case 8: row_phase(p, l, 2); break;
  }
}

__global__ void __launch_bounds__(512) mega(Params p, int ph_lo, int ph_hi) {
  extern __shared__ __attribute__((aligned(16))) unsigned char smem[];
  __shared__ uint4 xb_words;
  if (threadIdx.x == 0) xb_words = make_uint4(0u, 0u, 0u, 0u);
  __syncthreads();
  XcdBarrier xb = xcd_barrier_post((unsigned*)(p.ws + WS_CTL), (volatile LAS unsigned*)&xb_words);
  for (int ph = ph_lo; ph < ph_hi; ++ph) {
    if (ph > ph_lo) xcd_barrier(xb);
    run_phase(p, ph, smem);
  }
}

extern "C" void kernel_launch(void* const* d_in, const int* in_sizes, int n_in, void* d_out, int out_size, void* d_ws, size_t ws_size, hipStream_t stream) {
  static int grid = 0;
  if (!grid) {
    int dev = 0, cus = 0, per_cu = 0;
    hipGetDevice(&dev);
    hipDeviceGetAttribute(&cus, hipDeviceAttributeMultiprocessorCount, dev);
    hipFuncSetAttribute((const void*)mega, hipFuncAttributeMaxDynamicSharedMemorySize, (int)LDS_BYTES);
    hipOccupancyMaxActiveBlocksPerMultiprocessor(&per_cu, (const void*)mega, NT, LDS_BYTES);
    if (per_cu < 1) { fprintf(stderr, "occupancy query says %d blocks/CU\n", per_cu); per_cu = 1; }
    grid = cus;
  }
  if (n_in != 43 || ws_size < WS_END) { fprintf(stderr, "kernel_launch: bad n_in %d or ws %zu < %zu\n", n_in, ws_size, (size_t)WS_END); return; }
  Params p{};
  for (int i = 0; i < 43; ++i) p.in[i] = (const float*)d_in[i];
  p.out = (float*)d_out; p.ws = (unsigned char*)d_ws;
  (void)hipMemsetAsync((unsigned char*)d_ws + WS_CTL, 0, 32768, stream);
#if ONE_LAUNCH
  int lo = 0, hi = NPH; void* args[] = {&p, &lo, &hi};
  hipError_t e = hipLaunchCooperativeKernel((const void*)mega, dim3(grid), dim3(NT), args, LDS_BYTES, stream);
  if (e != hipSuccess) fprintf(stderr, "cooperative launch failed: %s\n", hipGetErrorString(e));
#else
  for (int ph = 0; ph < NPH; ++ph) hipLaunchKernelGGL(mega, dim3(grid), dim3(NT), LDS_BYTES, stream, p, ph, ph + 1);
#endif
}
```

```cpp
#include <hip/hip_runtime.h>
#include <hip/hip_cooperative_groups.h>
#include <stdint.h>
#include <stdio.h>
namespace cg = cooperative_groups;

#ifndef ONE_LAUNCH
#define ONE_LAUNCH 1
#endif

#ifndef PROBE_DUPK
#define PROBE_DUPK 0
#endif
#ifndef PROBE_MIXMASK
#define PROBE_MIXMASK 7
#endif
#define DI __device__ __forceinline__
typedef unsigned short u16;
using bf16x8 = __attribute__((ext_vector_type(8))) short;
using s16x4  = __attribute__((ext_vector_type(4))) short;
using f32x4  = __attribute__((ext_vector_type(4))) float;
using f32x16 = __attribute__((ext_vector_type(16))) float;

constexpr int NT = 512;
constexpr int TT = 12288;
constexpr int NU = 3456;
constexpr size_t LDS_BYTES = 110592;

constexpr size_t WS_CTL = 0;
constexpr size_t WS_MOD = 32768;
constexpr size_t WS_W   = WS_MOD + 491520;
constexpr size_t W_IN_B = 3584ull * 1024 * 2, W_OUT_B = 1024ull * 1024 * 2, W_FF_B = 4096ull * 1024 * 2;
constexpr size_t W_SLOT = W_IN_B + W_OUT_B + 2 * W_FF_B;
constexpr size_t WS_H   = WS_W + 2 * W_SLOT;
constexpr size_t WS_U   = WS_H + (size_t)TT * 1024 * 2;
constexpr size_t WS_MIXCAT = WS_U + (size_t)TT * NU * 2;
constexpr size_t WS_KL  = WS_MIXCAT + (size_t)TT * 1024 * 2;
constexpr size_t WS_VL  = WS_KL + 4ull * 2304 * 512 * 2;
constexpr size_t WS_RW  = WS_VL + 4ull * 2304 * 512 * 2;
constexpr size_t WS_G   = WS_RW + (size_t)TT * 4 * 9 * 64 * 4;
constexpr size_t WS_BC  = WS_G + (size_t)TT * 256 * 4;
constexpr size_t WS_HYT = WS_BC + (size_t)TT * 4 * 4;
constexpr size_t WS_FILT = WS_HYT + 3ull * 256 * TT * 4;
constexpr size_t WS_HSPEC = WS_FILT + 2ull * 256 * (512 + 4096) * 4;
constexpr size_t WS_END = WS_HSPEC + 2ull * 256 * (512 + 4096) * 8;
constexpr size_t WS_Q  = WS_H;
constexpr size_t WS_KC = WS_Q + (size_t)TT * 512 * 2;
constexpr size_t WS_VC = WS_KC + 16ull * 256 * 512 * 2;
constexpr size_t WS_YS = WS_U;
constexpr size_t WS_YC = WS_U + 2ull * TT * 256 * 4;
constexpr size_t WS_F  = WS_U;
constexpr size_t WS_A  = WS_RW;
static_assert(WS_VC + 16ull * 256 * 512 * 2 <= WS_U, "alias");
static_assert(WS_YC + 256ull * TT * 4 <= WS_MIXCAT, "alias");
static_assert((size_t)TT * 4096 * 2 <= (size_t)TT * 4 * 9 * 64 * 4, "alias");

constexpr size_t OUT_STATE = 12582912, OUT_CK = 14680064, OUT_CV = 23068672;

struct Params {
  const float* in[43];
  float* out;
  unsigned char* ws;
};

DI u16 f2bf(float x) { unsigned u = __float_as_uint(x); u += 0x7fffu + ((u >> 16) & 1u); return (u16)(u >> 16); }
DI float bf2f(u16 b) { return __uint_as_float(((unsigned)b) << 16); }
DI unsigned pack2(float a, float b) { return (unsigned)f2bf(a) | ((unsigned)f2bf(b) << 16); }
DI float wave_sum(float v) {
#pragma unroll
  for (int o = 32; o > 0; o >>= 1) v += __shfl_xor(v, o);
  return v;
}
template <int CTRL> DI float dppf(float x) {
  return __builtin_bit_cast(float, __builtin_amdgcn_update_dpp(0, __builtin_bit_cast(int, x), CTRL, 0xF, 0xF, true));
}
DI float allreduce16(float x) {
  x += dppf<0xB1>(x); x += dppf<0x4E>(x); x += dppf<0x124>(x); x += dppf<0x128>(x);
  return x;
}
DI void seq_of(int row, int& s, int& t, int& L, int& row0) {
  if (row < 4096) { s = row >> 8; t = row & 255; L = 256; row0 = s * 256; }
  else { int r = row - 4096; s = 16 + (r >> 11); t = r & 2047; L = 2048; row0 = 4096 + (r >> 11) * 2048; }
}
DI int otid() { int t = threadIdx.x; asm volatile("" : "+v"(t)); return t; }
DI float sigmoidf_(float x) { return 1.f / (1.f + expf(-x)); }


#define XB_TMO      128
#define XB_XCNT(j)  (256  + 64 * (j))
#define XB_XSUB(j)  (1280 + 64 * (j))
#define XB_XGEN(j)  (2304 + 64 * (j))
#define XB_TOP      3328
#define XB_TOPGEN   3392
#define XB_SPIN_CAP (1u << 22)
#define LAS __attribute__((address_space(3)))
DI unsigned xb_ld(unsigned* p)              { return __hip_atomic_load(p, __ATOMIC_RELAXED, __HIP_MEMORY_SCOPE_AGENT); }
DI unsigned xb_add(unsigned* p, unsigned v) { return __hip_atomic_fetch_add(p, v, __ATOMIC_RELAXED, __HIP_MEMORY_SCOPE_AGENT); }
DI unsigned xb_xcc_id() { return (unsigned)__builtin_amdgcn_s_getreg((3 << 11) | 20) & 0xFu; }
#define XB_SPIN(cond, bar) do { unsigned _sp = 0; while (cond) { __builtin_amdgcn_s_sleep(1); \
    if ((++_sp & 255u) == 0u) { if (xb_ld(&(bar)[XB_TMO])) break; if (_sp > XB_SPIN_CAP) { atomicAdd(&(bar)[XB_TMO], 1u); break; } } } } while (0)
struct XcdBarrier { unsigned* bar; unsigned x; volatile LAS unsigned* st; };
DI XcdBarrier xcd_barrier_post(unsigned* bar, volatile LAS unsigned* st) {
  XcdBarrier b; b.bar = bar; b.x = xb_xcc_id(); b.st = st;
  if (threadIdx.x == 0) (void)xb_add(&bar[XB_XCNT(b.x)], 1u);
  return b;
}
DI void xcd_barrier_complete(unsigned* bar, unsigned x, unsigned& nloc, unsigned& nx) {
  const unsigned G = gridDim.x * gridDim.y * gridDim.z;
  unsigned sum, cnt, mine, sp = 0u;
  for (;;) {
    sum = 0u; cnt = 0u; mine = 0u;
#pragma unroll
    for (unsigned j = 0; j < 16; ++j) { const unsigned c = xb_ld(&bar[XB_XCNT(j)]); sum += c; cnt += (c > 0u) ? 1u : 0u; mine = (j == x) ? c : mine; }
    if (sum == G) break;
    __builtin_amdgcn_s_sleep(1);
    if ((++sp & 255u) == 0u) { if (xb_ld(&bar[XB_TMO])) break; if (sp > XB_SPIN_CAP) { atomicAdd(&bar[XB_TMO], 1u); break; } }
  }
  nloc = mine > 0u ? mine : 1u; nx = cnt > 0u ? cnt : 1u;
}
DI void xcd_barrier(const XcdBarrier& b) {
  asm volatile("s_waitcnt vmcnt(0)" ::: "memory");
  __syncthreads();
  if (threadIdx.x == 0) {
    unsigned* bar = b.bar;
    __builtin_amdgcn_s_waitcnt(0);
    unsigned nloc = b.st[0], nx = b.st[1];
    if (nloc == 0u) { xcd_barrier_complete(bar, b.x, nloc, nx); b.st[0] = nloc; b.st[1] = nx; }
    const unsigned old = xb_add(&bar[XB_XSUB(b.x)], 1u);
    const unsigned gen = old / nloc;
    if (old + 1u == (gen + 1u) * nloc) {
      __builtin_amdgcn_fence(__ATOMIC_RELEASE, "agent");
      asm volatile("s_waitcnt vmcnt(0)" ::: "memory");
      const unsigned og = xb_add(&bar[XB_TOP], 1u);
      const unsigned tg = og / nx;
      if (og + 1u == (tg + 1u) * nx) xb_add(&bar[XB_TOPGEN], 1u);
      else XB_SPIN(xb_ld(&bar[XB_TOPGEN]) == tg, bar);
      __builtin_amdgcn_fence(__ATOMIC_ACQUIRE, "agent");
      xb_add(&bar[XB_XGEN(b.x)], 1u);
      asm volatile("s_waitcnt vmcnt(0)" ::: "memory");
    } else {
      XB_SPIN(xb_ld(&bar[XB_XGEN(b.x)]) == gen, bar);
      __builtin_amdgcn_fence(__ATOMIC_ACQUIRE, "agent");
      asm volatile("s_waitcnt vmcnt(0)" ::: "memory");
    }
  }
  __syncthreads();
}

DI void tr_tile(const float* __restrict__ W, int K, int N, u16* __restrict__ Wt, int k0, int n0, float* lds) {
  const int tid = otid();
#pragma unroll
  for (int i = 0; i < 8; ++i) { int idx = tid + i * 512; int kk = idx >> 6, nn = idx & 63; lds[kk * 65 + nn] = W[(size_t)(k0 + kk) * N + n0 + nn]; }
  __syncthreads();
  const int n = tid >> 3, kg = tid & 7;
  unsigned pk[4];
#pragma unroll
  for (int j = 0; j < 4; ++j) pk[j] = pack2(lds[(kg * 8 + 2 * j) * 65 + n], lds[(kg * 8 + 2 * j + 1) * 65 + n]);
  *(uint4*)(Wt + (size_t)(n0 + n) * K + k0 + kg * 8) = make_uint4(pk[0], pk[1], pk[2], pk[3]);
  __syncthreads();
}

DI void filt_item(const Params& p, int l, int it, float* lds) {
  const int Lsel = it >= 32; const int chunk = Lsel ? it - 32 : it; const int L = Lsel ? 2048 : 256;
  float* emb = lds; float* h1 = lds + 8 * 36; float* h2 = h1 + 512;
  const int tid = otid();
  const float* w1 = p.in[32] + l * 33 * 64; const float* b1 = p.in[33] + l * 64; const float* fr = p.in[34] + l * 64;
  const float* w2 = p.in[35] + l * 4096; const float* b2 = p.in[36] + l * 64; const float* w3 = p.in[37] + (size_t)l * 64 * 1024;
  const float* dec = p.in[38] + l * 256;
  if (tid < 8 * 33) {
    int ti = tid / 33, j = tid % 33; int i = chunk * 8 + ti; float v;
    float ang = (float)(2.0 * 3.14159265358979323846 / (double)L) * (float)i;
    if (j == 0) v = (float)i / (float)(L - 1);
    else if (j <= 16) { float band = 1e-4f + (float)(j - 1) * ((15.f - 1e-4f) / 15.f); v = cosf(band * ang); }
    else { float band = 1e-4f + (float)(j - 17) * ((15.f - 1e-4f) / 15.f); v = -sinf(band * ang); }
    emb[ti * 36 + j] = v;
  }
  __syncthreads();
  { int ti = tid >> 6, j = tid & 63; float a = b1[j]; for (int k = 0; k < 33; ++k) a += emb[ti * 36 + k] * w1[k * 64 + j]; h1[ti * 64 + j] = sinf(fr[j] * a); }
  __syncthreads();
  { int ti = tid >> 6, j = tid & 63; float a = b2[j]; for (int k = 0; k < 64; ++k) a += h1[ti * 64 + k] * w2[k * 64 + j]; h2[ti * 64 + j] = sinf(fr[j] * a); }
  __syncthreads();
  float* FILT = (float*)(p.ws + WS_FILT) + (Lsel ? 262144 : 0);
#pragma unroll
  for (int cc = 0; cc < 2; ++cc) {
    int col = tid + cc * 512; float acc[8];
#pragma unroll
    for (int ti = 0; ti < 8; ++ti) acc[ti] = 0.f;
    for (int k = 0; k < 64; ++k) { float w = w3[k * 1024 + col];
#pragma unroll
      for (int ti = 0; ti < 8; ++ti) acc[ti] += h2[ti * 64 + k] * w; }
    int order = col >> 9, dir = (col >> 8) & 1, c = col & 255; float dc = fabsf(dec[c]);
    float* g = FILT + (size_t)(order * 256 + c) * (2 * L);
#pragma unroll
    for (int ti = 0; ti < 8; ++ti) {
      int i = chunk * 8 + ti; float t = (float)i / (float)(L - 1); float val = acc[ti] * expf(-t * dc);
      if (dir == 0) g[L + i] = val; else { if (i == 0) g[0] = 0.f; else g[L - i] = val; }
    }
  }
  __syncthreads();
}

constexpr int AUX_ITEMS = 864 + 256 + 1024 + 1024 + 1 + 288;
DI void aux_item(const Params& p, int l, int it, float* lds) {
  unsigned char* slot = p.ws + WS_W + (size_t)(l & 1) * W_SLOT;
  u16* win = (u16*)slot; u16* wout = (u16*)(slot + W_IN_B); u16* wff1 = (u16*)(slot + W_IN_B + W_OUT_B); u16* wff2 = (u16*)(slot + W_IN_B + W_OUT_B + W_FF_B);
  if (it < 864) { int kt = it / 54, nt = it % 54; tr_tile(p.in[13] + (size_t)l * 1024 * NU, 1024, NU, win, kt * 64, nt * 64, lds); return; }
  it -= 864;
  if (it < 256) { int kt = it >> 4, nt = it & 15; tr_tile(p.in[40] + (size_t)l * 1024 * 1024, 1024, 1024, wout, kt * 64, nt * 64, lds); return; }
  it -= 256;
  if (it < 1024) { int kt = it >> 6, nt = it & 63; tr_tile(p.in[41] + (size_t)l * 1024 * 4096, 1024, 4096, wff1, kt * 64, nt * 64, lds); return; }
  it -= 1024;
  if (it < 1024) { int kt = it >> 4, nt = it & 15; tr_tile(p.in[42] + (size_t)l * 4096 * 1024, 4096, 1024, wff2, kt * 64, nt * 64, lds); return; }
  it -= 1024;
  if (it < 1) { uint4* z = (uint4*)(win + (size_t)NU * 1024); for (int i = otid(); i < 16384; i += 512) z[i] = make_uint4(0, 0, 0, 0); return; }
  it -= 1;
  filt_item(p, l, it, lds);
}

DI void mod_item(const Params& p, int it, float* lds) {
  const int l = it / 96, cgp = it % 96, tid = otid();
  float* sc = lds; float* red = lds + 5120;
  for (int i = tid; i < 5120; i += 512) { int j = i >> 10, k = i & 1023; float c = (j == 0) ? p.in[6][k] : p.in[5][(j - 1) * 1024 + k]; sc[i] = c / (1.f + expf(-c)); }
  __syncthreads();
  const int c = tid & 63, kg = tid >> 6; const float* w = p.in[7] + (size_t)l * 1024 * 6144 + cgp * 64 + c;
  float acc[5] = {0.f, 0.f, 0.f, 0.f, 0.f};
  for (int k = kg; k < 1024; k += 8) { float wv = w[(size_t)k * 6144];
#pragma unroll
    for (int j = 0; j < 5; ++j) acc[j] += sc[j * 1024 + k] * wv; }
#pragma unroll
  for (int j = 0; j < 5; ++j) red[(kg * 5 + j) * 64 + c] = acc[j];
  __syncthreads();
  if (tid < 320) { int j = tid >> 6, cc = tid & 63; float s = 0.f; for (int g = 0; g < 8; ++g) s += red[(g * 5 + j) * 64 + cc];
    s += p.in[8][l * 6144 + cgp * 64 + cc]; ((float*)(p.ws + WS_MOD))[(l * 5 + j) * 6144 + cgp * 64 + cc] = s; }
  __syncthreads();
}

DI void row_phase(const Params& p, int l, int mode) {
  const int tid = otid(), lane = tid & 63; const int gw = blockIdx.x * 8 + (tid >> 6), nw = gridDim.x * 8;
  float* x = p.out; const float* F = (const float*)(p.ws + WS_F); u16* H = (u16*)(p.ws + WS_H); const float* MOD = (const float*)(p.ws + WS_MOD);
  const float* gpost = nullptr; const float* gpre = nullptr; int gate_ch = 0, sc_ch = 0, sh_ch = 0, lm = l; bool do_h = true;
  if (mode == 0) { gpre = p.in[9] + l * 1024; sc_ch = 1; sh_ch = 0; lm = l; }
  else if (mode == 1) { gpost = p.in[10] + l * 1024; gate_ch = 2; gpre = p.in[11] + l * 1024; sc_ch = 4; sh_ch = 3; lm = l; }
  else { gpost = p.in[12] + l * 1024; gate_ch = 5; if (l < 3) { gpre = p.in[9] + (l + 1) * 1024; sc_ch = 1; sh_ch = 0; lm = l + 1; } else do_h = false; }
  for (int row = gw; row < TT; row += nw) {
    const int j = row < 4096 ? 0 : 1 + ((row - 4096) >> 11);
    const float* xs = (mode == 0) ? (row < 4096 ? p.in[0] + (size_t)row * 1024 : p.in[1] + (size_t)(row - 4096) * 1024) : x + (size_t)row * 1024;
    float4 xv[4];
#pragma unroll
    for (int i = 0; i < 4; ++i) xv[i] = *(const float4*)(xs + i * 256 + lane * 4);
    if (mode != 0) {
      float4 dv[4]; float ss = 0.f;
#pragma unroll
      for (int i = 0; i < 4; ++i) { dv[i] = *(const float4*)(F + (size_t)row * 1024 + i * 256 + lane * 4); ss += dv[i].x * dv[i].x + dv[i].y * dv[i].y + dv[i].z * dv[i].z + dv[i].w * dv[i].w; }
      ss = wave_sum(ss); const float rs = rsqrtf(ss * (1.f / 1024.f) + 1e-6f);
      const float* gt = MOD + (l * 5 + j) * 6144 + gate_ch * 1024;
#pragma unroll
      for (int i = 0; i < 4; ++i) { int col = i * 256 + lane * 4; float4 g4 = *(const float4*)(gt + col); float4 p4 = *(const float4*)(gpost + col);
        xv[i].x += g4.x * dv[i].x * rs * p4.x; xv[i].y += g4.y * dv[i].y * rs * p4.y; xv[i].z += g4.z * dv[i].z * rs * p4.z; xv[i].w += g4.w * dv[i].w * rs * p4.w; }
    }
#pragma unroll
    for (int i = 0; i < 4; ++i) *(float4*)(x + (size_t)row * 1024 + i * 256 + lane * 4) = xv[i];
    if (do_h) {
      float ss = 0.f;
#pragma unroll
      for (int i = 0; i < 4; ++i) ss += xv[i].x * xv[i].x + xv[i].y * xv[i].y + xv[i].z * xv[i].z + xv[i].w * xv[i].w;
      ss = wave_sum(ss); const float rs = rsqrtf(ss * (1.f / 1024.f) + 1e-6f);
      const float* sc = MOD + (lm * 5 + j) * 6144 + sc_ch * 1024; const float* sh = MOD + (lm * 5 + j) * 6144 + sh_ch * 1024;
#pragma unroll
      for (int i = 0; i < 4; ++i) { int col = i * 256 + lane * 4; float4 g4 = *(const float4*)(gpre + col); float4 s4 = *(const float4*)(sc + col); float4 h4 = *(const float4*)(sh + col);
        float a = xv[i].x * rs * g4.x * (1.f + s4.x) + h4.x, b = xv[i].y * rs * g4.y * (1.f + s4.y) + h4.y;
        float c = xv[i].z * rs * g4.z * (1.f + s4.z) + h4.z, d = xv[i].w * rs * g4.w * (1.f + s4.w) + h4.w;
        *(uint2*)(H + (size_t)row * 1024 + col) = make_uint2(pack2(a, b), pack2(c, d)); }
    }
  }
}

template <int EPI>
DI void gemm_phase(const Params& p, const u16* __restrict__ A, const u16* __restrict__ Wt, int K, int NTn, int l, void* Cout, int ldc, unsigned char* smem) {
  u16* As = (u16*)smem; u16* Bs = As + 2 * 128 * 72;
  const int tid = otid(), lane = tid & 63, wid = tid >> 6, wm = wid & 1, wn = wid >> 1, fr = lane & 15, fq = lane >> 4;
  const int ntiles = 96 * NTn, nk = K / 64;
  for (int tile = blockIdx.x; tile < ntiles; tile += gridDim.x) {
    const int mt = tile / NTn, nt = tile % NTn; const int m0 = mt * 128, n0 = nt * 256;
    f32x4 acc[4][4];
#pragma unroll
    for (int i = 0; i < 4; ++i)
#pragma unroll
      for (int j = 0; j < 4; ++j) acc[i][j] = f32x4{0.f, 0.f, 0.f, 0.f};
    uint4 ra[2], rb[4];
    const int lrow = tid >> 3, lkc = tid & 7;
    const u16* ag = A + (size_t)(m0 + lrow) * K + lkc * 8;
    const u16* bg = Wt + (size_t)(n0 + lrow) * K + lkc * 8;
#define GLOAD(kt) { _Pragma("unroll") for (int i = 0; i < 2; ++i) ra[i] = *(const uint4*)(ag + (size_t)i * 64 * K + (kt) * 64); \
                    _Pragma("unroll") for (int i = 0; i < 4; ++i) rb[i] = *(const uint4*)(bg + (size_t)i * 64 * K + (kt) * 64); }
#define SSTORE(buf) { _Pragma("unroll") for (int i = 0; i < 2; ++i) *(uint4*)(As + (buf) * 128 * 72 + (lrow + i * 64) * 72 + lkc * 8) = ra[i]; \
                      _Pragma("unroll") for (int i = 0; i < 4; ++i) *(uint4*)(Bs + (buf) * 256 * 72 + (lrow + i * 64) * 72 + lkc * 8) = rb[i]; }
    GLOAD(0); SSTORE(0); __syncthreads();
    for (int kt = 0; kt < nk; ++kt) {
      if (kt + 1 < nk) GLOAD(kt + 1);
      const u16* as = As + (kt & 1) * 128 * 72 + (wm * 64 + fr) * 72 + fq * 8;
      const u16* bs = Bs + (kt & 1) * 256 * 72 + (wn * 64 + fr) * 72 + fq * 8;
#pragma unroll
      for (int ks = 0; ks < 2; ++ks) {
        bf16x8 wf[4], af[4];
#pragma unroll
        for (int i = 0; i < 4; ++i) { wf[i] = *(const bf16x8*)(bs + i * 16 * 72 + ks * 32); af[i] = *(const bf16x8*)(as + i * 16 * 72 + ks * 32); }
#pragma unroll
        for (int i = 0; i < 4; ++i)
#pragma unroll
          for (int j = 0; j < 4; ++j) acc[i][j] = __builtin_amdgcn_mfma_f32_16x16x32_bf16(wf[i], af[j], acc[i][j], 0, 0, 0);
      }
      if (kt + 1 < nk) SSTORE((kt + 1) & 1);
      __syncthreads();
    }
#undef GLOAD
#undef SSTORE
#pragma unroll
    for (int i = 0; i < 4; ++i)
#pragma unroll
      for (int j = 0; j < 4; ++j) {
        const int row = m0 + wm * 64 + j * 16 + fr; const int col = n0 + wn * 64 + i * 16 + fq * 4; const f32x4 v = acc[i][j];
        if (EPI == 0) {
          if (col < NU) {
            *(uint2*)((u16*)Cout + (size_t)row * NU + col) = make_uint2(pack2(v[0], v[1]), pack2(v[2], v[3]));
            if (row < 4096 && col >= 1664 && col < 2688) {
              int b = row >> 8, t = row & 255;
              float* dst = (col < 2176) ? p.out + OUT_CK + ((size_t)((b * 4 + l) * 256 + t)) * 512 + (col - 1664)
                                        : p.out + OUT_CV + ((size_t)((b * 4 + l) * 256 + t)) * 512 + (col - 2176);
              *(float4*)dst = make_float4(v[0], v[1], v[2], v[3]);
            }
          }
        } else if (EPI == 1) {
          *(float4*)((float*)Cout + (size_t)row * ldc + col) = make_float4(v[0], v[1], v[2], v[3]);
        } else {
          float a = fmaxf(v[0], 0.f), b = fmaxf(v[1], 0.f), c = fmaxf(v[2], 0.f), d = fmaxf(v[3], 0.f);
          *(uint2*)((u16*)Cout + (size_t)row * ldc + col) = make_uint2(pack2(a * a, b * b), pack2(c * c, d * d));
        }
      }
  }
}

DI void rwkv_prep_item(const Params& p, int l, int tile, float* lds) {
  const int tid = otid();
  const int rowb = tile * 32; int s, t0, L, row0; seq_of(rowb, s, t0, L, row0);
  const u16* U = (const u16*)(p.ws + WS_U);
  float* tw = lds; float* ua = lds + 4096; float* sg = lds + 8192;
  for (int idx = tid; idx < 32 * 384; idx += 512) {
    int tok = idx / 384, c = idx % 384; float v = bf2f(U[(size_t)(rowb + tok) * NU + 768 + c]);
    if (c < 128) tw[tok * 128 + c] = tanhf(v); else if (c < 256) ua[tok * 128 + c - 128] = v; else sg[tok * 128 + c - 256] = sigmoidf_(v);
  }
  __syncthreads();
  const int c = tid & 255, tg = tid >> 8, h = c >> 6;
  float ag[16], awf[16], awb[16], aaf[16], aab[16];
#pragma unroll
  for (int i = 0; i < 16; ++i) { ag[i] = 0.f; awf[i] = 0.f; awb[i] = 0.f; aaf[i] = 0.f; aab[i] = 0.f; }
  const float* g2 = p.in[19] + (size_t)l * 128 * 256 + c; const float* w2 = p.in[16] + (size_t)l * 2 * 64 * 256 + c; const float* a2 = p.in[18] + (size_t)l * 2 * 64 * 256 + c;
  for (int k = 0; k < 128; k += 4) {
    float w0 = g2[(k) * 256], w1 = g2[(k + 1) * 256], w2_ = g2[(k + 2) * 256], w3 = g2[(k + 3) * 256];
#pragma unroll
    for (int tt = 0; tt < 16; ++tt) { float4 sv = *(const float4*)(sg + (tg * 16 + tt) * 128 + k); ag[tt] += sv.x * w0 + sv.y * w1 + sv.z * w2_ + sv.w * w3; }
  }
  for (int k = 0; k < 64; k += 4) {
    float wf[4], wb[4], af[4], ab[4];
#pragma unroll
    for (int q = 0; q < 4; ++q) { wf[q] = w2[(k + q) * 256]; wb[q] = w2[(64 + k + q) * 256]; af[q] = a2[(k + q) * 256]; ab[q] = a2[(64 + k + q) * 256]; }
#pragma unroll
    for (int tt = 0; tt < 16; ++tt) {
      const int tok = tg * 16 + tt;
      float4 t1 = *(const float4*)(tw + tok * 128 + k), t2 = *(const float4*)(tw + tok * 128 + 64 + k);
      float4 u1 = *(const float4*)(ua + tok * 128 + k), u2 = *(const float4*)(ua + tok * 128 + 64 + k);
      awf[tt] += t1.x * wf[0] + t1.y * wf[1] + t1.z * wf[2] + t1.w * wf[3];
      awb[tt] += t2.x * wb[0] + t2.y * wb[1] + t2.z * wb[2] + t2.w * wb[3];
      aaf[tt] += u1.x * af[0] + u1.y * af[1] + u1.z * af[2] + u1.w * af[3];
      aab[tt] += u2.x * ab[0] + u2.y * ab[1] + u2.z * ab[2] + u2.w * ab[3];
    }
  }
  const float* cw = p.in[14] + (size_t)l * 3 * 768;
  float cr[3], ck[3], cv[3];
#pragma unroll
  for (int q = 0; q < 3; ++q) { cr[q] = cw[q * 768 + c]; ck[q] = cw[q * 768 + 256 + c]; cv[q] = cw[q * 768 + 512 + c]; }
  const float kkw = p.in[20][l * 256 + c], ka = p.in[21][l * 256 + c], rk = p.in[22][l * 256 + c];
  const float w0f = p.in[15][(l * 2 + 0) * 256 + c], w0b = p.in[15][(l * 2 + 1) * 256 + c];
  const float a0f = p.in[17][(l * 2 + 0) * 256 + c], a0b = p.in[17][(l * 2 + 1) * 256 + c];
  float* RW = (float*)(p.ws + WS_RW); float* G = (float*)(p.ws + WS_G); float* BC = (float*)(p.ws + WS_BC);
#pragma unroll
  for (int tt = 0; tt < 16; ++tt) {
    const int tok = tg * 16 + tt, row = rowb + tok, t = t0 + tok;
    const u16* ur = U + (size_t)row * NU + c;
    float r0 = bf2f(ur[0]), k0 = bf2f(ur[256]), v0 = bf2f(ur[512]);
    float rm = 0.f, km = 0.f, vm = 0.f, rp = 0.f, kp = 0.f, vp = 0.f;
    if (t > 0) { rm = bf2f(ur[-NU]); km = bf2f(ur[256 - NU]); vm = bf2f(ur[512 - NU]); }
    if (t + 1 < L) { rp = bf2f(ur[NU]); kp = bf2f(ur[256 + NU]); vp = bf2f(ur[512 + NU]); }
    const float r = cr[0] * rm + cr[1] * r0 + cr[2] * rp;
    const float k = ck[0] * km + ck[1] * k0 + ck[2] * kp;
    const float v = cv[0] * vm + cv[1] * v0 + cv[2] * vp;
    const float kkr = k * kkw; const float ss = wave_sum(kkr * kkr); const float kk = kkr * rsqrtf(ss + 1e-12f);
    const float sgf = sigmoidf_(w0f + awf[tt]); const float decf = expf(-0.60653066f * sgf);
    const float sgb = sigmoidf_(w0b + awb[tt]); const float decb = expf(-0.60653066f * sgb);
    const float af_ = sigmoidf_(a0f + aaf[tt]), ab_ = sigmoidf_(a0b + aab[tt]);
    const float kdf = k * (1.f + (af_ - 1.f) * ka), kdb = k * (1.f + (ab_ - 1.f) * ka);
    const float bonus = wave_sum(r * (kdf + kdb) * rk);
    float* dst = RW + ((size_t)(row * 4 + h) * 9) * 64 + (c & 63);
    dst[0] = r; dst[64] = kk; dst[128] = v; dst[192] = decf; dst[256] = kk * af_; dst[320] = kdf; dst[384] = decb; dst[448] = kk * ab_; dst[512] = kdb;
    G[(size_t)row * 256 + c] = ag[tt];
    if ((c & 63) == 0) BC[row * 4 + h] = bonus;
  }
  __syncthreads();
}

DI void attn_prep_item(const Params& p, int l, int tile) {
  const int tid = otid();
  const int rowb = tile * 32; int s, t0, L, row0; seq_of(rowb, s, t0, L, row0);
  const bool lat = s >= 16;
  const u16* U = (const u16*)(p.ws + WS_U);
  u16* Q = (u16*)(p.ws + WS_Q);
  u16* Kd = lat ? (u16*)(p.ws + WS_KL) + ((size_t)(s - 16) * 2304 + 256) * 512 : (u16*)(p.ws + WS_KC) + (size_t)s * 256 * 512;
  u16* Vd = lat ? (u16*)(p.ws + WS_VL) + ((size_t)(s - 16) * 2304 + 256) * 512 : (u16*)(p.ws + WS_VC) + (size_t)s * 256 * 512;
  for (int uidx = tid; uidx < 2048; uidx += 512) {
    const int g = uidx & 1, pb = (uidx >> 1) & 1, hm = (uidx >> 2) & 7, which = (uidx >> 5) & 1, tok = uidx >> 6;
    const int row = rowb + tok, t = t0 + tok;
    const u16* src = U + (size_t)row * NU + (which ? 1664 : 1152) + hm * 64 + pb * 32 + g * 8;
    const uint4 va = *(const uint4*)src; const uint4 vb = *(const uint4*)(src + 16);
    const unsigned wa[4] = {va.x, va.y, va.z, va.w}, wb[4] = {vb.x, vb.y, vb.z, vb.w};
    float oa[8], ob[8];
#pragma unroll
    for (int j = 0; j < 8; ++j) {
      float xa = bf2f((u16)(wa[j >> 1] >> ((j & 1) * 16))), xb = bf2f((u16)(wb[j >> 1] >> ((j & 1) * 16)));
      if (lat) {
        const int pidx = pb == 0 ? (t >> 6) : (t & 63); const int i = g * 8 + j;
        const float inv = exp2f(-(float)(2 * i) * (13.287712379549449f / 32.f)); const float ang = (float)pidx * inv;
        const float cs = cosf(ang), sn = sinf(ang);
        oa[j] = xa * cs - xb * sn; ob[j] = xb * cs + xa * sn;
      } else { oa[j] = xa; ob[j] = xb; }
    }
    u16* dst = (which == 0) ? Q + (size_t)row * 512 + hm * 64 + pb * 32 + g * 8 : Kd + (size_t)t * 512 + hm * 64 + pb * 32 + g * 8;
    *(uint4*)dst = make_uint4(pack2(oa[0], oa[1]), pack2(oa[2], oa[3]), pack2(oa[4], oa[5]), pack2(oa[6], oa[7]));
    *(uint4*)(dst + 16) = make_uint4(pack2(ob[0], ob[1]), pack2(ob[2], ob[3]), pack2(ob[4], ob[5]), pack2(ob[6], ob[7]));
  }
  for (int uidx = tid; uidx < 2048; uidx += 512) {
    const int tok = uidx >> 6, ch = uidx & 63;
    *(uint4*)(Vd + (size_t)(t0 + tok) * 512 + ch * 8) = *(const uint4*)(U + (size_t)(rowb + tok) * NU + 2176 + ch * 8);
  }
}

DI void cache_item(const Params& p, int l, int it) {
  const int b = it >> 3, pc = it & 7;
  u16* KL = (u16*)(p.ws + WS_KL); u16* VL = (u16*)(p.ws + WS_VL);
  for (int idx = otid(); idx < 32 * 128; idx += 512) {
    const int r = idx >> 7, c4 = idx & 127, prow = pc * 32 + r;
    const size_t so = ((size_t)(b * 4 + l) * 256 + prow) * 512 + c4 * 4; const size_t d_o = ((size_t)b * 2304 + prow) * 512 + c4 * 4;
    float4 kv = *(const float4*)(p.in[3] + so); float4 vv = *(const float4*)(p.in[4] + so);
    *(uint2*)(KL + d_o) = make_uint2(pack2(kv.x, kv.y), pack2(kv.z, kv.w));
    *(uint2*)(VL + d_o) = make_uint2(pack2(vv.x, vv.y), pack2(vv.z, vv.w));
  }
}

DI void hy_prep_item(const Params& p, int l, int tile, float* lds) {
  const int tid = otid();
  const int rowb = tile * 64; int s, t0, L, row0; seq_of(rowb, s, t0, L, row0);
  const u16* U = (const u16*)(p.ws + WS_U); float* HYT = (float*)(p.ws + WS_HYT);
  for (int which = 0; which < 3; ++which) {
    const int c = tid & 255, tg = tid >> 8, col = which * 256 + c;
    const float w0 = p.in[30][(size_t)l * 3 * 768 + col], w1 = p.in[30][(size_t)l * 3 * 768 + 768 + col], w2 = p.in[30][(size_t)l * 3 * 768 + 1536 + col];
    const float bias = p.in[31][l * 768 + col];
    for (int tt = 0; tt < 32; ++tt) {
      const int tok = tg * 32 + tt, row = rowb + tok, t = t0 + tok;
      const u16* ur = U + (size_t)row * NU + 2688 + col;
      float um = t > 0 ? bf2f(ur[-NU]) : 0.f, u0 = bf2f(ur[0]), up = (t + 1 < L) ? bf2f(ur[NU]) : 0.f;
      lds[tok * 257 + c] = w0 * um + w1 * u0 + w2 * up + bias;
    }
    __syncthreads();
    const int cc = tid >> 1, half = tid & 1;
    float* dst = HYT + (size_t)(which * 256 + cc) * TT + rowb + half * 32;
#pragma unroll
    for (int i = 0; i < 32; i += 4) {
      float4 v = make_float4(lds[(half * 32 + i) * 257 + cc], lds[(half * 32 + i + 1) * 257 + cc], lds[(half * 32 + i + 2) * 257 + cc], lds[(half * 32 + i + 3) * 257 + cc]);
      *(float4*)(dst + i) = v;
    }
    __syncthreads();
  }
}

DI void scan_item(const Params& p, int l, int s, int h, int d, int rg, float* lds) {
  int L, row0; if (s < 16) { L = 256; row0 = s * 256; } else { L = 2048; row0 = 4096 + (s - 16) * 2048; }
  const float* RW = (const float*)(p.ws + WS_RW); float* YS = (float*)(p.ws + WS_YS) + (size_t)d * TT * 256;
  const int tid = otid(), lane = tid & 63, wid = tid >> 6, lane16 = lane & 15, rsub = lane >> 4;
  const int row = rg * 16 + (wid & 3) * 4 + rsub;
  float4 st = make_float4(0.f, 0.f, 0.f, 0.f);
  if (s >= 16 && wid < 4) st = *(const float4*)(p.in[2] + ((((size_t)(s - 16) * 4 + l) * 2 + d) * 4 + h) * 4096 + row * 64 + lane16 * 4);
  const int nch = L / 32;
  float4 pre0, pre1, pre2, pre3, pre4, pre5;
  auto ldpre = [&](int ch, int j) -> float4 {
    int f = tid + j * 512; int step = f / 96, within = f % 96; int slot6 = within >> 4, q = within & 15;
    int srcslot = slot6 < 3 ? slot6 : 3 + 3 * d + (slot6 - 3); int i = ch * 32 + step; int t = d ? L - 1 - i : i;
    return *(const float4*)(RW + ((size_t)((row0 + t) * 4 + h) * 9 + srcslot) * 64 + q * 4); };
#define PREFETCH(ch) { pre0 = ldpre(ch, 0); pre1 = ldpre(ch, 1); pre2 = ldpre(ch, 2); pre3 = ldpre(ch, 3); pre4 = ldpre(ch, 4); pre5 = ldpre(ch, 5); }
  PREFETCH(0);
  for (int ch = 0; ch < nch; ++ch) {
    *(float4*)(lds + (size_t)(tid + 0 * 512) * 4) = pre0; *(float4*)(lds + (size_t)(tid + 1 * 512) * 4) = pre1;
    *(float4*)(lds + (size_t)(tid + 2 * 512) * 4) = pre2; *(float4*)(lds + (size_t)(tid + 3 * 512) * 4) = pre3;
    *(float4*)(lds + (size_t)(tid + 4 * 512) * 4) = pre4; *(float4*)(lds + (size_t)(tid + 5 * 512) * 4) = pre5;
    __syncthreads();
    if (ch + 1 < nch) PREFETCH(ch + 1);
    if (wid < 4) {
#pragma unroll 4
      for (int step = 0; step < 32; ++step) {
        const float* base = lds + step * 384;
        const float4 r4 = *(const float4*)(base + lane16 * 4), kk4 = *(const float4*)(base + 64 + lane16 * 4);
        const float vrow = base[128 + row];
        const float4 w4 = *(const float4*)(base + 192 + lane16 * 4), b4 = *(const float4*)(base + 256 + lane16 * 4), kd4 = *(const float4*)(base + 320 + lane16 * 4);
        float sa = -(st.x * kk4.x + st.y * kk4.y + st.z * kk4.z + st.w * kk4.w);
        sa = allreduce16(sa);
        st.x = st.x * w4.x + (sa * b4.x + vrow * kd4.x);
        st.y = st.y * w4.y + (sa * b4.y + vrow * kd4.y);
        st.z = st.z * w4.z + (sa * b4.z + vrow * kd4.z);
        st.w = st.w * w4.w + (sa * b4.w + vrow * kd4.w);
        float y = st.x * r4.x + st.y * r4.y + st.z * r4.z + st.w * r4.w;
        y = allreduce16(y);
        if (lane16 == 0) { int i = ch * 32 + step; int t = d ? L - 1 - i : i; YS[(size_t)(row0 + t) * 256 + h * 64 + row] = y; }
      }
    }
    __syncthreads();
  }
#undef PREFETCH
  if (s < 16 && wid < 4) *(float4*)(p.out + OUT_STATE + ((((size_t)s * 4 + l) * 2 + d) * 4 + h) * 4096 + row * 64 + lane16 * 4) = st;
}

DI void attn_item(const Params& p, int l, int s, int h, int qt, unsigned char* smem, float lam, float lam_init) {
  u16* Ks = (u16*)smem; u16* Vs = Ks + 64 * 136; float* Ex = (float*)(smem + 2 * 17408);
  const bool lat = s >= 16; const int Lk = lat ? 2304 : 256;
  const u16* Kg = lat ? (const u16*)(p.ws + WS_KL) + (size_t)(s - 16) * 2304 * 512 : (const u16*)(p.ws + WS_KC) + (size_t)s * 256 * 512;
  const u16* Vg = lat ? (const u16*)(p.ws + WS_VL) + (size_t)(s - 16) * 2304 * 512 : (const u16*)(p.ws + WS_VC) + (size_t)s * 256 * 512;
  const int row0 = lat ? 4096 + (s - 16) * 2048 : s * 256; const int qrow0 = row0 + qt * 128;
  const u16* Q = (const u16*)(p.ws + WS_Q);
  const int tid = otid(), lane = tid & 63, wid = tid >> 6, m = wid & 1, qs = wid >> 1, r = lane & 31, hh = lane >> 5;
  bf16x8 qf[4];
#pragma unroll
  for (int ks = 0; ks < 4; ++ks) qf[ks] = *(const bf16x8*)(Q + (size_t)(qrow0 + qs * 32 + r) * 512 + h * 128 + m * 64 + ks * 16 + hh * 8);
  f32x16 o[4];
#pragma unroll
  for (int et = 0; et < 4; ++et)
#pragma unroll
    for (int i = 0; i < 16; ++i) o[et][i] = 0.f;
  float mrun = -1e30f, lsum = 0.f; const float cs = 0.125f * 1.4426950408889634f;
  for (int kt0 = 0; kt0 < Lk; kt0 += 64) {
    __syncthreads();
#pragma unroll
    for (int i = 0; i < 2; ++i) { int id = tid + i * 512; int key = id >> 4, ch = id & 15;
      *(uint4*)(Ks + key * 136 + ch * 8) = *(const uint4*)(Kg + (size_t)(kt0 + key) * 512 + h * 128 + ch * 8); }
#pragma unroll
    for (int i = 0; i < 2; ++i) { int id = tid + i * 512; int key = id & 63, e8 = id >> 6;
      const uint4 v = *(const uint4*)(Vg + (size_t)(kt0 + key) * 512 + h * 128 + e8 * 8);
      const unsigned w[4] = {v.x, v.y, v.z, v.w};
#pragma unroll
      for (int j = 0; j < 8; ++j) Vs[(e8 * 8 + j) * 68 + key] = (u16)(w[j >> 1] >> ((j & 1) * 16)); }
    __syncthreads();
    f32x16 st[2];
#pragma unroll
    for (int kt = 0; kt < 2; ++kt) {
#pragma unroll
      for (int i = 0; i < 16; ++i) st[kt][i] = 0.f;
#pragma unroll
      for (int ks = 0; ks < 4; ++ks) { const bf16x8 kf = *(const bf16x8*)(Ks + (kt * 32 + r) * 136 + m * 64 + ks * 16 + hh * 8);
        st[kt] = __builtin_amdgcn_mfma_f32_32x32x16_bf16(kf, qf[ks], st[kt], 0, 0, 0); }
    }
    float mx = st[0][0];
#pragma unroll
    for (int i = 0; i < 16; ++i) { mx = fmaxf(mx, st[0][i]); mx = fmaxf(mx, st[1][i]); }
    mx = fmaxf(mx, __shfl_xor(mx, 32));
    const float mnew = fmaxf(mrun, mx); const float alpha = exp2f((mrun - mnew) * cs); mrun = mnew;
    lsum *= alpha;
#pragma unroll
    for (int et = 0; et < 4; ++et)
#pragma unroll
      for (int i = 0; i < 16; ++i) o[et][i] *= alpha;
#pragma unroll
    for (int kt = 0; kt < 2; ++kt)
#pragma unroll
      for (int i = 0; i < 16; ++i) { float pv = exp2f((st[kt][i] - mnew) * cs); lsum += pv; st[kt][i] = pv; }
#pragma unroll
    for (int kt = 0; kt < 2; ++kt)
#pragma unroll
      for (int ss = 0; ss < 2; ++ss) {
        bf16x8 pf;
#pragma unroll
        for (int j = 0; j < 8; ++j) pf[j] = (short)f2bf(st[kt][8 * ss + j]);
#pragma unroll
        for (int et = 0; et < 4; ++et) {
          const u16* vp = Vs + (et * 32 + r) * 68 + kt * 32 + 16 * ss + 4 * hh;
          const s16x4 lo = *(const s16x4*)vp, hi = *(const s16x4*)(vp + 8);
          const bf16x8 vf = __builtin_shufflevector(lo, hi, 0, 1, 2, 3, 4, 5, 6, 7);
          o[et] = __builtin_amdgcn_mfma_f32_32x32x16_bf16(vf, pf, o[et], 0, 0, 0);
        }
      }
  }
  lsum += __shfl_xor(lsum, 32); const float inv = 1.f / lsum;
  float* ex = Ex + qs * (32 * 132);
  if (m == 1) {
#pragma unroll
    for (int et = 0; et < 4; ++et)
#pragma unroll
      for (int i = 0; i < 16; ++i) { int e = et * 32 + (i & 3) + 8 * (i >> 2) + 4 * hh; ex[r * 132 + e] = o[et][i] * inv; }
  }
  __syncthreads();
  if (m == 0) {
    float ssq = 0.f;
#pragma unroll
    for (int et = 0; et < 4; ++et)
#pragma unroll
      for (int i = 0; i < 16; ++i) { int e = et * 32 + (i & 3) + 8 * (i >> 2) + 4 * hh; float v = o[et][i] * inv - lam * ex[r * 132 + e]; o[et][i] = v; ssq += v * v; }
    ssq += __shfl_xor(ssq, 32);
    const float rs = rsqrtf(ssq * (1.f / 128.f) + 1e-6f) * (1.f - lam_init);
    const float* subln = p.in[29] + l * 128;
    u16* dstrow = (u16*)(p.ws + WS_MIXCAT) + (size_t)(qrow0 + qs * 32 + r) * 1024 + 256 + h * 128;
#pragma unroll
    for (int et = 0; et < 4; ++et)
#pragma unroll
      for (int g4 = 0; g4 < 4; ++g4) {
        const int e0 = et * 32 + 8 * g4 + 4 * hh; const float4 sl = *(const float4*)(subln + e0);
        *(uint2*)(dstrow + e0) = make_uint2(pack2(o[et][4 * g4] * rs * sl.x, o[et][4 * g4 + 1] * rs * sl.y), pack2(o[et][4 * g4 + 2] * rs * sl.z, o[et][4 * g4 + 3] * rs * sl.w));
      }
  }
}

DI void hy_conv(const float* g, const float* z, int L, int t0, float& a0, float& a1, float& a2, float& a3) {
  a0 = a1 = a2 = a3 = 0.f;
  const float* gp = g + L + t0 - 4;
  const int nb = L >> 2;
#pragma unroll 4
  for (int sb = 0; sb < nb; ++sb) {
    const float4 zz = *(const float4*)(z + sb * 4);
    const float4 ga = *(const float4*)(gp - 4 * sb), gb = *(const float4*)(gp - 4 * sb + 4);
    a0 += gb.x * zz.x + ga.w * zz.y + ga.z * zz.z + ga.y * zz.w;
    a1 += gb.y * zz.x + gb.x * zz.y + ga.w * zz.z + ga.z * zz.w;
    a2 += gb.z * zz.x + gb.y * zz.y + gb.x * zz.z + ga.w * zz.w;
    a3 += gb.w * zz.x + gb.z * zz.y + gb.y * zz.z + gb.x * zz.w;
  }
}

DI void hyena_item(const Params& p, int l, int s, int c0, float* lds) {
  const bool lat = s >= 16; const int L = lat ? 2048 : 256; const int row0 = lat ? 4096 + (s - 16) * 2048 : s * 256;
  const int TPC = L >> 2; const int tid = otid(), lane = tid & 63, wid = tid >> 6;
  const int ch = tid / TPC, tl = tid % TPC, t0 = tl * 4, c = c0 + ch;
  float* G = lds; float* Z = lds + 8192; float* red = lds + 8192 + 2048;
  const float* F = (const float*)(p.ws + WS_FILT) + (lat ? 262144 : 0);
  const float* HYT = (const float*)(p.ws + WS_HYT);
  float ssq[2];
#pragma unroll
  for (int o = 0; o < 2; ++o) {
    const float* src = F + (size_t)(o * 256 + c) * (2 * L); float* dst = G + (size_t)(ch * 2 + o) * (2 * L); float sacc = 0.f;
#pragma unroll
    for (int i = 0; i < 2; ++i) { int idx = (tl + i * TPC) * 4; float4 v = *(const float4*)(src + idx); *(float4*)(dst + idx) = v; sacc += v.x * v.x + v.y * v.y + v.z * v.z + v.w * v.w; }
    ssq[o] = wave_sum(sacc);
  }
  if (lane == 0) { red[wid * 2] = ssq[0]; red[wid * 2 + 1] = ssq[1]; }
  const float4 x1 = *(const float4*)(HYT + (size_t)(0 * 256 + c) * TT + row0 + t0);
  const float4 x2 = *(const float4*)(HYT + (size_t)(1 * 256 + c) * TT + row0 + t0);
  const float4 v4 = *(const float4*)(HYT + (size_t)(2 * 256 + c) * TT + row0 + t0);
  *(float4*)(Z + ch * L + t0) = v4;
  __syncthreads();
  const int wpc = TPC >> 6, w0 = ch * wpc; float sc0 = 0.f, sc1 = 0.f;
  for (int w = 0; w < wpc; ++w) { sc0 += red[(w0 + w) * 2]; sc1 += red[(w0 + w) * 2 + 1]; }
  sc0 = rsqrtf(sc0 + 1e-6f); sc1 = rsqrtf(sc1 + 1e-6f);
  const float bias0 = p.in[39][(l * 2 + 0) * 256 + c], bias1 = p.in[39][(l * 2 + 1) * 256 + c];
  float a0, a1, a2, a3;
  hy_conv(G + (size_t)(ch * 2 + 0) * (2 * L), Z + ch * L, L, t0, a0, a1, a2, a3);
  float4 z1;
  z1.x = x1.x * (sc0 * a0 + bias0 * v4.x); z1.y = x1.y * (sc0 * a1 + bias0 * v4.y); z1.z = x1.z * (sc0 * a2 + bias0 * v4.z); z1.w = x1.w * (sc0 * a3 + bias0 * v4.w);
  __syncthreads();
  *(float4*)(Z + ch * L + t0) = z1;
  __syncthreads();
  hy_conv(G + (size_t)(ch * 2 + 1) * (2 * L), Z + ch * L, L, t0, a0, a1, a2, a3);
  float4 yo;
  yo.x = x2.x * (sc1 * a0 + bias1 * z1.x); yo.y = x2.y * (sc1 * a1 + bias1 * z1.y); yo.z = x2.z * (sc1 * a2 + bias1 * z1.z); yo.w = x2.w * (sc1 * a3 + bias1 * z1.w);
  *(float4*)((float*)(p.ws + WS_YC) + (size_t)c * TT + row0 + t0) = yo;
  __syncthreads();
}


DI float2 cmul(float2 a, float2 b) { return make_float2(a.x * b.x - a.y * b.y, a.x * b.y + a.y * b.x); }
#define BF2(a, b) { float2 t_ = a; a.x = t_.x + b.x; a.y = t_.y + b.y; b.x = t_.x - b.x; b.y = t_.y - b.y; }
#define MNI(a) { float t_ = a.x; a.x = a.y; a.y = -t_; }
DI void fft_fwd(float2 (&v)[8], int j, int TPF, int npass, float2* lds) {
  int Ns = 1;
  for (int ps = 0; ps < npass; ++ps) {
    const int k = j & (Ns - 1);
    if (ps > 0) {
      const float a2 = -2.f * (float)k / (float)(Ns * 8);
      const float2 w1 = make_float2(cospif(a2), sinpif(a2));
      float2 w = w1; v[1] = cmul(v[1], w);
      w = cmul(w, w1); v[2] = cmul(v[2], w);
      w = cmul(w, w1); v[3] = cmul(v[3], w);
      w = cmul(w, w1); v[4] = cmul(v[4], w);
      w = cmul(w, w1); v[5] = cmul(v[5], w);
      w = cmul(w, w1); v[6] = cmul(v[6], w);
      w = cmul(w, w1); v[7] = cmul(v[7], w);
    }
    BF2(v[0], v[4]); BF2(v[1], v[5]); BF2(v[2], v[6]); BF2(v[3], v[7]);
    v[5] = cmul(v[5], make_float2(0.70710678118654752f, -0.70710678118654752f)); MNI(v[6]); v[7] = cmul(v[7], make_float2(-0.70710678118654752f, -0.70710678118654752f));
    BF2(v[0], v[2]); BF2(v[1], v[3]); BF2(v[4], v[6]); BF2(v[5], v[7]);
    MNI(v[3]); MNI(v[7]);
    BF2(v[0], v[1]); BF2(v[2], v[3]); BF2(v[4], v[5]); BF2(v[6], v[7]);
    { float2 t1 = v[1], t3 = v[3]; v[1] = v[4]; v[3] = v[6]; v[4] = t1; v[6] = t3; }
    if (ps == npass - 1) break;
    __syncthreads();
    const int base = (j - k) * 8 + k;
#pragma unroll
    for (int r = 0; r < 8; ++r) { const int idx = base + r * Ns; lds[idx + (idx >> 3)] = v[r]; }
    __syncthreads();
#pragma unroll
    for (int r = 0; r < 8; ++r) { const int idx = j + r * TPF; v[r] = lds[idx + (idx >> 3)]; }
    Ns *= 8;
  }
}

DI void hspec_item(const Params& p, int lat, int item, float* ldsf) {
  const int tid = otid(), lane = tid & 63, wid = tid >> 6;
  const int TPF = lat ? 512 : 64, npass = lat ? 4 : 3, L = lat ? 2048 : 256, N = 2 * L;
  const int unit = lat ? 0 : wid; const int j = tid & (TPF - 1);
  const int c = lat ? item : item * 8 + unit;
  float2* lds = (float2*)ldsf + unit * (N + (N >> 3));
  float* red = ldsf + 9216;
  const float* F = (const float*)(p.ws + WS_FILT) + (lat ? 262144 : 0);
  const float* g0 = F + (size_t)c * N; const float* g1 = F + (size_t)(256 + c) * N;
  float2 v[8]; float s0 = 0.f, s1 = 0.f;
#pragma unroll
  for (int r = 0; r < 8; ++r) { const int n = j + r * TPF; const int gi = (n + L) & (N - 1); const float a = g0[gi], b = g1[gi]; v[r] = make_float2(a, b); s0 += a * a; s1 += b * b; }
  s0 = wave_sum(s0); s1 = wave_sum(s1);
  if (lane == 0) { red[wid * 2] = s0; red[wid * 2 + 1] = s1; }
  __syncthreads();
  if (lat) { s0 = 0.f; s1 = 0.f; for (int w = 0; w < 8; ++w) { s0 += red[w * 2]; s1 += red[w * 2 + 1]; } }
  const float sc0 = rsqrtf(s0 + 1e-6f), sc1 = rsqrtf(s1 + 1e-6f);
#pragma unroll
  for (int r = 0; r < 8; ++r) { v[r].x *= sc0; v[r].y *= sc1; }
  fft_fwd(v, j, TPF, npass, lds);
  __syncthreads();
#pragma unroll
  for (int r = 0; r < 8; ++r) { const int idx = j + r * TPF; lds[idx + (idx >> 3)] = v[r]; }
  __syncthreads();
  const float hn = 0.5f / (float)N;
  float2* HS = (float2*)(p.ws + WS_HSPEC) + (lat ? 0 : 2 * 256 * 4096);
  float2* H0 = HS + (size_t)c * N; float2* H1 = HS + (size_t)(256 + c) * N;
#pragma unroll
  for (int r = 0; r < 8; ++r) {
    const int k = j + r * TPF; const int km = (N - k) & (N - 1); const float2 wm = lds[km + (km >> 3)];
    const float2 sm = make_float2(v[r].x + wm.x, v[r].y - wm.y); const float2 df = make_float2(v[r].x - wm.x, v[r].y + wm.y);
    H0[k] = make_float2(sm.x * hn, sm.y * hn); H1[k] = make_float2(df.y * hn, -df.x * hn);
  }
  __syncthreads();
}

DI void hyena_fft_item(const Params& p, int l, int lat, int item, float* ldsf) {
  const int tid = otid(), wid = tid >> 6;
  const int TPF = lat ? 512 : 64, npass = lat ? 4 : 3, L = lat ? 2048 : 256, N = 2 * L;
  const int unit = lat ? 0 : wid; const int j = tid & (TPF - 1);
  int c, rowa, rowb;
  if (lat) { const int bp = item >> 8; c = item & 255; rowa = 4096 + (2 * bp) * 2048; rowb = rowa + 2048; }
  else { const int gidx = item * 8 + unit; const int pair = gidx >> 8; c = gidx & 255; rowa = (2 * pair) * 256; rowb = rowa + 256; }
  float2* lds = (float2*)ldsf + unit * (N + (N >> 3));
  const float2* HS = (const float2*)(p.ws + WS_HSPEC) + (lat ? 0 : 2 * 256 * 4096);
  const float* HYT = (const float*)(p.ws + WS_HYT);
  float2 v[8], z[4];
#pragma unroll
  for (int r = 0; r < 4; ++r) { const int t = j + r * TPF; z[r] = make_float2(HYT[(size_t)(512 + c) * TT + rowa + t], HYT[(size_t)(512 + c) * TT + rowb + t]); v[r] = z[r]; v[4 + r] = make_float2(0.f, 0.f); }
  for (int order = 0; order < 2; ++order) {
    const float2* H = HS + (size_t)(order * 256 + c) * N;
    const float* xq = HYT + (size_t)(order * 256 + c) * TT;
    float2 h[8];
#pragma unroll
    for (int r = 0; r < 8; ++r) h[r] = H[j + r * TPF];
    float xa[4], xb[4];
#pragma unroll
    for (int r = 0; r < 4; ++r) { xa[r] = xq[rowa + j + r * TPF]; xb[r] = xq[rowb + j + r * TPF]; }
    fft_fwd(v, j, TPF, npass, lds);
#pragma unroll
    for (int r = 0; r < 8; ++r) { const float2 y = cmul(v[r], h[r]); v[r] = make_float2(y.x, -y.y); }
    fft_fwd(v, j, TPF, npass, lds);
    const float bias = p.in[39][(l * 2 + order) * 256 + c];
#pragma unroll
    for (int r = 0; r < 4; ++r) {
      const float ya = v[r].x, yb = -v[r].y;
      z[r] = make_float2(xa[r] * (ya + bias * z[r].x), xb[r] * (yb + bias * z[r].y));
      v[r] = z[r]; v[4 + r] = make_float2(0.f, 0.f);
    }
  }
  float* YC = (float*)(p.ws + WS_YC) + (size_t)c * TT;
#pragma unroll
  for (int r = 0; r < 4; ++r) { const int t = j + r * TPF; YC[rowa + t] = z[r].x; YC[rowb + t] = z[r].y; }
  __syncthreads();
}

DI void fin_item(const Params& p, int l, int tile, float* lds) {
  const int tid = otid(), lane = tid & 63, wid = tid >> 6; const int rowb = tile * 64;
  const float* YS0 = (const float*)(p.ws + WS_YS); const float* YS1 = YS0 + (size_t)TT * 256;
  const float* RW = (const float*)(p.ws + WS_RW); const float* G = (const float*)(p.ws + WS_G); const float* BC = (const float*)(p.ws + WS_BC);
  u16* MC = (u16*)(p.ws + WS_MIXCAT);
  for (int q = 0; q < 32; ++q) {
    const int pair = wid * 32 + q, tok = pair >> 2, h = pair & 3, row = rowb + tok, c = h * 64 + lane;
    const float y = YS0[(size_t)row * 256 + c] + YS1[(size_t)row * 256 + c];
    const float mu = wave_sum(y) * (1.f / 64.f); const float dv = y - mu; const float var = wave_sum(dv * dv) * (1.f / 64.f);
    const float yn = dv * rsqrtf(var + 64e-5f) * p.in[23][l * 256 + c] + p.in[24][l * 256 + c];
    const float v = RW[((size_t)(row * 4 + h) * 9 + 2) * 64 + lane]; const float bc = BC[row * 4 + h]; const float g = G[(size_t)row * 256 + c];
    MC[(size_t)row * 1024 + c] = f2bf((yn + bc * v) * g);
  }
  const float* YC = (const float*)(p.ws + WS_YC);
  for (int idx = tid; idx < 16384; idx += 512) { int c = idx >> 6, tt = idx & 63; lds[c * 65 + tt] = YC[(size_t)c * TT + rowb + tt]; }
  __syncthreads();
  for (int idx = tid; idx < 16384; idx += 512) { int tt = idx >> 8, c = idx & 255; MC[(size_t)(rowb + tt) * 1024 + 768 + c] = f2bf(lds[c * 65 + tt]); }
  __syncthreads();
}

constexpr int NPH = 2 + 9 * 4;

DI void run_phase(const Params& p, int ph, unsigned char* smem) {
  float* lds = (float*)smem;
  const int nb = gridDim.x, bid = blockIdx.x;
  if (ph == 0) {
    for (int it = bid; it < 384 + AUX_ITEMS; it += nb) { if (it < 384) mod_item(p, it, lds); else aux_item(p, 0, it - 384, lds); }
    return;
  }
  if (ph == 1) { row_phase(p, 0, 0); return; }
  const int l = (ph - 2) / 9, k = (ph - 2) % 9;
  unsigned char* slot = p.ws + WS_W + (size_t)(l & 1) * W_SLOT;
  const u16* win = (const u16*)slot; const u16* wout = (const u16*)(slot + W_IN_B); const u16* wff1 = (const u16*)(slot + W_IN_B + W_OUT_B); const u16* wff2 = (const u16*)(slot + W_IN_B + W_OUT_B + W_FF_B);
  const int nrep = (k != 2 && k != 5 && k != 8 && ((PROBE_DUPK >> k) & 1)) ? 2 : 1;
  for (int rep = 0; rep < nrep; ++rep)
  switch (k) {
    case 0: gemm_phase<0>(p, (const u16*)(p.ws + WS_H), win, 1024, 14, l, p.ws + WS_U, NU, smem); break;
    case 1:
      for (int it = bid; it < 992 + 288; it += nb) {
        if (it < 384) rwkv_prep_item(p, l, it, lds);
        else if (it < 768) attn_prep_item(p, l, it - 384);
        else if (it < 800) cache_item(p, l, it - 768);
        else if (it < 992) hy_prep_item(p, l, it - 800, lds);
        else if (it < 1248) hspec_item(p, 1, it - 992, lds);
        else hspec_item(p, 0, it - 1248, lds);
      }
      break;
    case 2: {
      __shared__ int s_item; __shared__ float s_lam;
      const float lam_init = 0.8f - 0.6f * expf(-0.3f * (float)l);
      const int tid2 = otid();
      if (tid2 < 64) {
        int ln = tid2; float a = p.in[25][l * 64 + ln] * p.in[26][l * 64 + ln]; float b = p.in[27][l * 64 + ln] * p.in[28][l * 64 + ln];
        a = wave_sum(a); b = wave_sum(b); if (ln == 0) s_lam = expf(a) - expf(b) + lam_init;
      }
      __syncthreads();
      const float lam = s_lam;
      const int npass = ((PROBE_DUPK >> 2) & 1) ? 2 : 1;
      for (int pass = 0; pass < npass; ++pass) {
      unsigned* ctr = (unsigned*)(p.ws + WS_CTL + 16384) + l * 64 + pass * 16;
      const int mask = pass == 0 ? 7 : PROBE_MIXMASK;
      for (;;) {
        __syncthreads();
        if (threadIdx.x == 0) s_item = (int)atomicAdd(ctr, 1u);
        __syncthreads();
        int it = s_item;
        if (it >= 1792) break;
        if (it < 128) { if (mask & 1) scan_item(p, l, 16 + (it >> 5), (it >> 3) & 3, (it >> 2) & 1, it & 3, lds); }
        else if (it < 384) { int j = it - 128; if (mask & 2) attn_item(p, l, 16 + (j >> 6), (j >> 4) & 3, j & 15, smem, lam, lam_init); }
        else if (it < 896) { int j = it - 384; if (mask & 4) hyena_fft_item(p, l, 1, j, lds); }
        else if (it < 1408) { int j = it - 896; if (mask & 1) scan_item(p, l, j >> 5, (j >> 3) & 3, (j >> 2) & 1, j & 3, lds); }
        else if (it < 1536) { int j = it - 1408; if (mask & 2) attn_item(p, l, j >> 3, (j >> 1) & 3, j & 1, smem, lam, lam_init); }
        else { int j = it - 1536; if (mask & 4) hyena_fft_item(p, l, 0, j, lds); }
      }
      }
    } break;
    case 3: for (int it = bid; it < 192; it += nb) fin_item(p, l, it, lds); break;
    case 4: gemm_phase<1>(p, (const u16*)(p.ws + WS_MIXCAT), wout, 1024, 4, l, p.ws + WS_F, 1024, smem); break;
    case 5:
      row_phase(p, l, 1);
      if (l < 3) for (int it = bid; it < AUX_ITEMS; it += nb) aux_item(p, l + 1, it, lds);
      break;
    case 6: gemm_phase<2>(p, (const u16*)(p.ws + WS_H), wff1, 1024, 16, l, p.ws + WS_A, 4096, smem); break;
    case 7: gemm_phase<1>(p, (const u16*)(p.ws + WS_A), wff2, 4096, 4, l, p.ws + WS_F, 1024, smem); break;
    case 8: row_phase(p, l, 2); break;
  }
}

__global__ void __launch_bounds__(512) mega(Params p, int ph_lo, int ph_hi) {
  extern __shared__ __attribute__((aligned(16))) unsigned char smem[];
  __shared__ uint4 xb_words;
  if (threadIdx.x == 0) xb_words = make_uint4(0u, 0u, 0u, 0u);
  __syncthreads();
  XcdBarrier xb = xcd_barrier_post((unsigned*)(p.ws + WS_CTL), (volatile LAS unsigned*)&xb_words);
  for (int ph = ph_lo; ph < ph_hi; ++ph) {
    if (ph > ph_lo) xcd_barrier(xb);
    run_phase(p, ph, smem);
  }
}

extern "C" void kernel_launch(void* const* d_in, const int* in_sizes, int n_in, void* d_out, int out_size, void* d_ws, size_t ws_size, hipStream_t stream) {
  static int grid = 0;
  if (!grid) {
    int dev = 0, cus = 0, per_cu = 0;
    hipGetDevice(&dev);
    hipDeviceGetAttribute(&cus, hipDeviceAttributeMultiprocessorCount, dev);
    hipFuncSetAttribute((const void*)mega, hipFuncAttributeMaxDynamicSharedMemorySize, (int)LDS_BYTES);
    hipOccupancyMaxActiveBlocksPerMultiprocessor(&per_cu, (const void*)mega, NT, LDS_BYTES);
    if (per_cu < 1) { fprintf(stderr, "occupancy query says %d blocks/CU\n", per_cu); per_cu = 1; }
    grid = cus;
  }
  if (n_in != 43 || ws_size < WS_END) { fprintf(stderr, "kernel_launch: bad n_in %d or ws %zu < %zu\n", n_in, ws_size, (size_t)WS_END); return; }
  Params p{};
  for (int i = 0; i < 43; ++i) p.in[i] = (const float*)d_in[i];
  p.out = (float*)d_out; p.ws = (unsigned char*)d_ws;
  (void)hipMemsetAsync((unsigned char*)d_ws + WS_CTL, 0, 32768, stream);
#if ONE_LAUNCH
  int lo = 0, hi = NPH; void* args[] = {&p, &lo, &hi};
  hipError_t e = hipLaunchCooperativeKernel((const void*)mega, dim3(grid), dim3(NT), args, LDS_BYTES, stream);
  if (e != hipSuccess) fprintf(stderr, "cooperative launch failed: %s\n", hipGetErrorString(e));
#else
  for (int ph = 0; ph < NPH; ++ph) hipLaunchKernelGGL(mega, dim3(grid), dim3(NT), LDS_BYTES, stream, p, ph, ph + 1);
#endif
}
```

```cpp
#include <hip/hip_runtime.h>
#include <hip/hip_cooperative_groups.h>
#include <stdint.h>
#include <stdio.h>
namespace cg = cooperative_groups;

#ifndef ONE_LAUNCH
#define ONE_LAUNCH 1
#endif

#ifndef PROBE_DUPK
#define PROBE_DUPK 0
#endif
#ifndef PROBE_MIXMASK
#define PROBE_MIXMASK 7
#endif
#define DI __device__ __forceinline__
typedef unsigned short u16;
using bf16x8 = __attribute__((ext_vector_type(8))) short;
using s16x4  = __attribute__((ext_vector_type(4))) short;
using f32x4  = __attribute__((ext_vector_type(4))) float;
using f32x16 = __attribute__((ext_vector_type(16))) float;

constexpr int NT = 512;
constexpr int TT = 12288;
constexpr int NU = 3456;
constexpr size_t LDS_BYTES = 110592;

constexpr size_t WS_CTL = 0;
constexpr size_t WS_MOD = 32768;
constexpr size_t WS_W   = WS_MOD + 491520;
constexpr size_t W_IN_B = 3584ull * 1024 * 2, W_OUT_B = 1024ull * 1024 * 2, W_FF_B = 4096ull * 1024 * 2;
constexpr size_t W_SLOT = W_IN_B + W_OUT_B + 2 * W_FF_B;
constexpr size_t WS_H   = WS_W + 2 * W_SLOT;
constexpr size_t WS_U   = WS_H + (size_t)TT * 1024 * 2;
constexpr size_t WS_MIXCAT = WS_U + (size_t)TT * NU * 2;
constexpr size_t WS_KL  = WS_MIXCAT + (size_t)TT * 1024 * 2;
constexpr size_t WS_VL  = WS_KL + 4ull * 2304 * 512 * 2;
constexpr size_t WS_RW  = WS_VL + 4ull * 2304 * 512 * 2;
constexpr size_t WS_G   = WS_RW + (size_t)TT * 4 * 9 * 64 * 4;
constexpr size_t WS_BC  = WS_G + (size_t)TT * 256 * 4;
constexpr size_t WS_HYT = WS_BC + (size_t)TT * 4 * 4;
constexpr size_t WS_FILT = WS_HYT + 3ull * 256 * TT * 4;
constexpr size_t WS_HSPEC = WS_FILT + 2ull * 256 * (512 + 4096) * 4;
constexpr size_t WS_END = WS_HSPEC + 2ull * 256 * (512 + 4096) * 8;
constexpr size_t WS_Q  = WS_H;
constexpr size_t WS_KC = WS_Q + (size_t)TT * 512 * 2;
constexpr size_t WS_VC = WS_KC + 16ull * 256 * 512 * 2;
constexpr size_t WS_YS = WS_U;
constexpr size_t WS_YC = WS_U + 2ull * TT * 256 * 4;
constexpr size_t WS_F  = WS_U;
constexpr size_t WS_A  = WS_RW;
static_assert(WS_VC + 16ull * 256 * 512 * 2 <= WS_U, "alias");
static_assert(WS_YC + 256ull * TT * 4 <= WS_MIXCAT, "alias");
static_assert((size_t)TT * 4096 * 2 <= (size_t)TT * 4 * 9 * 64 * 4, "alias");

constexpr size_t OUT_STATE = 12582912, OUT_CK = 14680064, OUT_CV = 23068672;

struct Params {
  const float* in[43];
  float* out;
  unsigned char* ws;
};

DI u16 f2bf(float x) { unsigned u = __float_as_uint(x); u += 0x7fffu + ((u >> 16) & 1u); return (u16)(u >> 16); }
DI float bf2f(u16 b) { return __uint_as_float(((unsigned)b) << 16); }
DI unsigned pack2(float a, float b) { return (unsigned)f2bf(a) | ((unsigned)f2bf(b) << 16); }
DI float wave_sum(float v) {
#pragma unroll
  for (int o = 32; o > 0; o >>= 1) v += __shfl_xor(v, o);
  return v;
}
template <int CTRL> DI float dppf(float x) {
  return __builtin_bit_cast(float, __builtin_amdgcn_update_dpp(0, __builtin_bit_cast(int, x), CTRL, 0xF, 0xF, true));
}
DI float allreduce16(float x) {
  x += dppf<0xB1>(x); x += dppf<0x4E>(x); x += dppf<0x124>(x); x += dppf<0x128>(x);
  return x;
}
DI void seq_of(int row, int& s, int& t, int& L, int& row0) {
  if (row < 4096) { s = row >> 8; t = row & 255; L = 256; row0 = s * 256; }
  else { int r = row - 4096; s = 16 + (r >> 11); t = r & 2047; L = 2048; row0 = 4096 + (r >> 11) * 2048; }
}
DI int otid() { int t = threadIdx.x; asm volatile("" : "+v"(t)); return t; }
DI float sigmoidf_(float x) { return 1.f / (1.f + expf(-x)); }


#define XB_TMO      128
#define XB_XCNT(j)  (256  + 64 * (j))
#define XB_XSUB(j)  (1280 + 64 * (j))
#define XB_XGEN(j)  (2304 + 64 * (j))
#define XB_TOP      3328
#define XB_TOPGEN   3392
#define XB_SPIN_CAP (1u << 22)
#define LAS __attribute__((address_space(3)))
DI unsigned xb_ld(unsigned* p)              { return __hip_atomic_load(p, __ATOMIC_RELAXED, __HIP_MEMORY_SCOPE_AGENT); }
DI unsigned xb_add(unsigned* p, unsigned v) { return __hip_atomic_fetch_add(p, v, __ATOMIC_RELAXED, __HIP_MEMORY_SCOPE_AGENT); }
DI unsigned xb_xcc_id() { return (unsigned)__builtin_amdgcn_s_getreg((3 << 11) | 20) & 0xFu; }
#define XB_SPIN(cond, bar) do { unsigned _sp = 0; while (cond) { __builtin_amdgcn_s_sleep(1); \
    if ((++_sp & 255u) == 0u) { if (xb_ld(&(bar)[XB_TMO])) break; if (_sp > XB_SPIN_CAP) { atomicAdd(&(bar)[XB_TMO], 1u); break; } } } } while (0)
struct XcdBarrier { unsigned* bar; unsigned x; volatile LAS unsigned* st; };
DI XcdBarrier xcd_barrier_post(unsigned* bar, volatile LAS unsigned* st) {
  XcdBarrier b; b.bar = bar; b.x = xb_xcc_id(); b.st = st;
  if (threadIdx.x == 0) (void)xb_add(&bar[XB_XCNT(b.x)], 1u);
  return b;
}
DI void xcd_barrier_complete(unsigned* bar, unsigned x, unsigned& nloc, unsigned& nx) {
  const unsigned G = gridDim.x * gridDim.y * gridDim.z;
  unsigned sum, cnt, mine, sp = 0u;
  for (;;) {
    sum = 0u; cnt = 0u; mine = 0u;
#pragma unroll
    for (unsigned j = 0; j < 16; ++j) { const unsigned c = xb_ld(&bar[XB_XCNT(j)]); sum += c; cnt += (c > 0u) ? 1u : 0u; mine = (j == x) ? c : mine; }
    if (sum == G) break;
    __builtin_amdgcn_s_sleep(1);
    if ((++sp & 255u) == 0u) { if (xb_ld(&bar[XB_TMO])) break; if (sp > XB_SPIN_CAP) { atomicAdd(&bar[XB_TMO], 1u); break; } }
  }
  nloc = mine > 0u ? mine : 1u; nx = cnt > 0u ? cnt : 1u;
}
DI void xcd_barrier(const XcdBarrier& b) {
  asm volatile("s_waitcnt vmcnt(0)" ::: "memory");
  __syncthreads();
  if (threadIdx.x == 0) {
    unsigned* bar = b.bar;
    __builtin_amdgcn_s_waitcnt(0);
    unsigned nloc = b.st[0], nx = b.st[1];
    if (nloc == 0u) { xcd_barrier_complete(bar, b.x, nloc, nx); b.st[0] = nloc; b.st[1] = nx; }
    const unsigned old = xb_add(&bar[XB_XSUB(b.x)], 1u);
    const unsigned gen = old / nloc;
    if (old + 1u == (gen + 1u) * nloc) {
      __builtin_amdgcn_fence(__ATOMIC_RELEASE, "agent");
      asm volatile("s_waitcnt vmcnt(0)" ::: "memory");
      const unsigned og = xb_add(&bar[XB_TOP], 1u);
      const unsigned tg = og / nx;
      if (og + 1u == (tg + 1u) * nx) xb_add(&bar[XB_TOPGEN], 1u);
      else XB_SPIN(xb_ld(&bar[XB_TOPGEN]) == tg, bar);
      __builtin_amdgcn_fence(__ATOMIC_ACQUIRE, "agent");
      xb_add(&bar[XB_XGEN(b.x)], 1u);
      asm volatile("s_waitcnt vmcnt(0)" ::: "memory");
    } else {
      XB_SPIN(xb_ld(&bar[XB_XGEN(b.x)]) == gen, bar);
      __builtin_amdgcn_fence(__ATOMIC_ACQUIRE, "agent");
      asm volatile("s_waitcnt vmcnt(0)" ::: "memory");
    }
  }
  __syncthreads();
}

DI void tr_tile(const float* __restrict__ W, int K, int N, u16* __restrict__ Wt, int k0, int n0, float* lds) {
  const int tid = otid();
#pragma unroll
  for (int i = 0; i < 8; ++i) { int idx = tid + i * 512; int kk = idx >> 6, nn = idx & 63; lds[kk * 65 + nn] = W[(size_t)(k0 + kk) * N + n0 + nn]; }
  __syncthreads();
  const int n = tid >> 3, kg = tid & 7;
  unsigned pk[4];
#pragma unroll
  for (int j = 0; j < 4; ++j) pk[j] = pack2(lds[(kg * 8 + 2 * j) * 65 + n], lds[(kg * 8 + 2 * j + 1) * 65 + n]);
  *(uint4*)(Wt + (size_t)(n0 + n) * K + k0 + kg * 8) = make_uint4(pk[0], pk[1], pk[2], pk[3]);
  __syncthreads();
}

DI void filt_item(const Params& p, int l, int it, float* lds) {
  const int Lsel = it >= 32; const int chunk = Lsel ? it - 32 : it; const int L = Lsel ? 2048 : 256;
  float* emb = lds; float* h1 = lds + 8 * 36; float* h2 = h1 + 512;
  const int tid = otid();
  const float* w1 = p.in[32] + l * 33 * 64; const float* b1 = p.in[33] + l * 64; const float* fr = p.in[34] + l * 64;
  const float* w2 = p.in[35] + l * 4096; const float* b2 = p.in[36] + l * 64; const float* w3 = p.in[37] + (size_t)l * 64 * 1024;
  const float* dec = p.in[38] + l * 256;
  if (tid < 8 * 33) {
    int ti = tid / 33, j = tid % 33; int i = chunk * 8 + ti; float v;
    float ang = (float)(2.0 * 3.14159265358979323846 / (double)L) * (float)i;
    if (j == 0) v = (float)i / (float)(L - 1);
    else if (j <= 16) { float band = 1e-4f + (float)(j - 1) * ((15.f - 1e-4f) / 15.f); v = cosf(band * ang); }
    else { float band = 1e-4f + (float)(j - 17) * ((15.f - 1e-4f) / 15.f); v = -sinf(band * ang); }
    emb[ti * 36 + j] = v;
  }
  __syncthreads();
  { int ti = tid >> 6, j = tid & 63; float a = b1[j]; for (int k = 0; k < 33; ++k) a += emb[ti * 36 + k] * w1[k * 64 + j]; h1[ti * 64 + j] = sinf(fr[j] * a); }
  __syncthreads();
  { int ti = tid >> 6, j = tid & 63; float a = b2[j]; for (int k = 0; k < 64; ++k) a += h1[ti * 64 + k] * w2[k * 64 + j]; h2[ti * 64 + j] = sinf(fr[j] * a); }
  __syncthreads();
  float* FILT = (float*)(p.ws + WS_FILT) + (Lsel ? 262144 : 0);
#pragma unroll
  for (int cc = 0; cc < 2; ++cc) {
    int col = tid + cc * 512; float acc[8];
#pragma unroll
    for (int ti = 0; ti < 8; ++ti) acc[ti] = 0.f;
    for (int k = 0; k < 64; ++k) { float w = w3[k * 1024 + col];
#pragma unroll
      for (int ti = 0; ti < 8; ++ti) acc[ti] += h2[ti * 64 + k] * w; }
    int order = col >> 9, dir = (col >> 8) & 1, c = col & 255; float dc = fabsf(dec[c]);
    float* g = FILT + (size_t)(order * 256 + c) * (2 * L);
#pragma unroll
    for (int ti = 0; ti < 8; ++ti) {
      int i = chunk * 8 + ti; float t = (float)i / (float)(L - 1); float val = acc[ti] * expf(-t * dc);
      if (dir == 0) g[L + i] = val; else { if (i == 0) g[0] = 0.f; else g[L - i] = val; }
    }
  }
  __syncthreads();
}

constexpr int AUX_ITEMS = 864 + 256 + 1024 + 1024 + 1 + 288;
DI void aux_item(const Params& p, int l, int it, float* lds) {
  unsigned char* slot = p.ws + WS_W + (size_t)(l & 1) * W_SLOT;
  u16* win = (u16*)slot; u16* wout = (u16*)(slot + W_IN_B); u16* wff1 = (u16*)(slot + W_IN_B + W_OUT_B); u16* wff2 = (u16*)(slot + W_IN_B + W_OUT_B + W_FF_B);
  if (it < 864) { int kt = it / 54, nt = it % 54; tr_tile(p.in[13] + (size_t)l * 1024 * NU, 1024, NU, win, kt * 64, nt * 64, lds); return; }
  it -= 864;
  if (it < 256) { int kt = it >> 4, nt = it & 15; tr_tile(p.in[40] + (size_t)l * 1024 * 1024, 1024, 1024, wout, kt * 64, nt * 64, lds); return; }
  it -= 256;
  if (it < 1024) { int kt = it >> 6, nt = it & 63; tr_tile(p.in[41] + (size_t)l * 1024 * 4096, 1024, 4096, wff1, kt * 64, nt * 64, lds); return; }
  it -= 1024;
  if (it < 1024) { int kt = it >> 4, nt = it & 15; tr_tile(p.in[42] + (size_t)l * 4096 * 1024, 4096, 1024, wff2, kt * 64, nt * 64, lds); return; }
  it -= 1024;
  if (it < 1) { uint4* z = (uint4*)(win + (size_t)NU * 1024); for (int i = otid(); i < 16384; i += 512) z[i] = make_uint4(0, 0, 0, 0); return; }
  it -= 1;
  filt_item(p, l, it, lds);
}

DI void mod_item(const Params& p, int it, float* lds) {
  const int l = it / 96, cgp = it % 96, tid = otid();
  float* sc = lds; float* red = lds + 5120;
  for (int i = tid; i < 5120; i += 512) { int j = i >> 10, k = i & 1023; float c = (j == 0) ? p.in[6][k] : p.in[5][(j - 1) * 1024 + k]; sc[i] = c / (1.f + expf(-c)); }
  __syncthreads();
  const int c = tid & 63, kg = tid >> 6; const float* w = p.in[7] + (size_t)l * 1024 * 6144 + cgp * 64 + c;
  float acc[5] = {0.f, 0.f, 0.f, 0.f, 0.f};
  for (int k = kg; k < 1024; k += 8) { float wv = w[(size_t)k * 6144];
#pragma unroll
    for (int j = 0; j < 5; ++j) acc[j] += sc[j * 1024 + k] * wv; }
#pragma unroll
  for (int j = 0; j < 5; ++j) red[(kg * 5 + j) * 64 + c] = acc[j];
  __syncthreads();
  if (tid < 320) { int j = tid >> 6, cc = tid & 63; float s = 0.f; for (int g = 0; g < 8; ++g) s += red[(g * 5 + j) * 64 + cc];
    s += p.in[8][l * 6144 + cgp * 64 + cc]; ((float*)(p.ws + WS_MOD))[(l * 5 + j) * 6144 + cgp * 64 + cc] = s; }
  __syncthreads();
}

DI void row_phase(const Params& p, int l, int mode) {
  const int tid = otid(), lane = tid & 63; const int gw = blockIdx.x * 8 + (tid >> 6), nw = gridDim.x * 8;
  float* x = p.out; const float* F = (const float*)(p.ws + WS_F); u16* H = (u16*)(p.ws + WS_H); const float* MOD = (const float*)(p.ws + WS_MOD);
  const float* gpost = nullptr; const float* gpre = nullptr; int gate_ch = 0, sc_ch = 0, sh_ch = 0, lm = l; bool do_h = true;
  if (mode == 0) { gpre = p.in[9] + l * 1024; sc_ch = 1; sh_ch = 0; lm = l; }
  else if (mode == 1) { gpost = p.in[10] + l * 1024; gate_ch = 2; gpre = p.in[11] + l * 1024; sc_ch = 4; sh_ch = 3; lm = l; }
  else { gpost = p.in[12] + l * 1024; gate_ch = 5; if (l < 3) { gpre = p.in[9] + (l + 1) * 1024; sc_ch = 1; sh_ch = 0; lm = l + 1; } else do_h = false; }
  for (int row = gw; row < TT; row += nw) {
    const int j = row < 4096 ? 0 : 1 + ((row - 4096) >> 11);
    const float* xs = (mode == 0) ? (row < 4096 ? p.in[0] + (size_t)row * 1024 : p.in[1] + (size_t)(row - 4096) * 1024) : x + (size_t)row * 1024;
    float4 xv[4];
#pragma unroll
    for (int i = 0; i < 4; ++i) xv[i] = *(const float4*)(xs + i * 256 + lane * 4);
    if (mode != 0) {
      float4 dv[4]; float ss = 0.f;
#pragma unroll
      for (int i = 0; i < 4; ++i) { dv[i] = *(const float4*)(F + (size_t)row * 1024 + i * 256 + lane * 4); ss += dv[i].x * dv[i].x + dv[i].y * dv[i].y + dv[i].z * dv[i].z + dv[i].w * dv[i].w; }
      ss = wave_sum(ss); const float rs = rsqrtf(ss * (1.f / 1024.f) + 1e-6f);
      const float* gt = MOD + (l * 5 + j) * 6144 + gate_ch * 1024;
#pragma unroll
      for (int i = 0; i < 4; ++i) { int col = i * 256 + lane * 4; float4 g4 = *(const float4*)(gt + col); float4 p4 = *(const float4*)(gpost + col);
        xv[i].x += g4.x * dv[i].x * rs * p4.x; xv[i].y += g4.y * dv[i].y * rs * p4.y; xv[i].z += g4.z * dv[i].z * rs * p4.z; xv[i].w += g4.w * dv[i].w * rs * p4.w; }
    }
#pragma unroll
    for (int i = 0; i < 4; ++i) *(float4*)(x + (size_t)row * 1024 + i * 256 + lane * 4) = xv[i];
    if (do_h) {
      float ss = 0.f;
#pragma unroll
      for (int i = 0; i < 4; ++i) ss += xv[i].x * xv[i].x + xv[i].y * xv[i].y + xv[i].z * xv[i].z + xv[i].w * xv[i].w;
      ss = wave_sum(ss); const float rs = rsqrtf(ss * (1.f / 1024.f) + 1e-6f);
      const float* sc = MOD + (lm * 5 + j) * 6144 + sc_ch * 1024; const float* sh = MOD + (lm * 5 + j) * 6144 + sh_ch * 1024;
#pragma unroll
      for (int i = 0; i < 4; ++i) { int col = i * 256 + lane * 4; float4 g4 = *(const float4*)(gpre + col); float4 s4 = *(const float4*)(sc + col); float4 h4 = *(const float4*)(sh + col);
        float a = xv[i].x * rs * g4.x * (1.f + s4.x) + h4.x, b = xv[i].y * rs * g4.y * (1.f + s4.y) + h4.y;
        float c = xv[i].z * rs * g4.z * (1.f + s4.z) + h4.z, d = xv[i].w * rs * g4.w * (1.f + s4.w) + h4.w;
        *(uint2*)(H + (size_t)row * 1024 + col) = make_uint2(pack2(a, b), pack2(c, d)); }
    }
  }
}

template <int EPI>
DI void gemm_phase(const Params& p, const u16* __restrict__ A, const u16* __restrict__ Wt, int K, int NTn, int l, void* Cout, int ldc, unsigned char* smem) {
  u16* As = (u16*)smem; u16* Bs = As + 2 * 128 * 72;
  const int tid = otid(), lane = tid & 63, wid = tid >> 6, wm = wid & 1, wn = wid >> 1, fr = lane & 15, fq = lane >> 4;
  const int ntiles = 96 * NTn, nk = K / 64;
  for (int tile = blockIdx.x; tile < ntiles; tile += gridDim.x) {
    const int mt = tile / NTn, nt = tile % NTn; const int m0 = mt * 128, n0 = nt * 256;
    f32x4 acc[4][4];
#pragma unroll
    for (int i = 0; i < 4; ++i)
#pragma unroll
      for (int j = 0; j < 4; ++j) acc[i][j] = f32x4{0.f, 0.f, 0.f, 0.f};
    uint4 pa0, pa1, pb0, pb1, pb2, pb3, qa0, qa1, qb0, qb1, qb2, qb3;
    const int lrow = tid >> 3, lkc = tid & 7;
    const u16* ag = A + (size_t)(m0 + lrow) * K + lkc * 8;
    const u16* bg = Wt + (size_t)(n0 + lrow) * K + lkc * 8;
#define GLOAD(P, kt) { P##a0 = *(const uint4*)(ag + (kt) * 64); P##a1 = *(const uint4*)(ag + (size_t)64 * K + (kt) * 64); \
      P##b0 = *(const uint4*)(bg + (kt) * 64); P##b1 = *(const uint4*)(bg + (size_t)64 * K + (kt) * 64); \
      P##b2 = *(const uint4*)(bg + (size_t)128 * K + (kt) * 64); P##b3 = *(const uint4*)(bg + (size_t)192 * K + (kt) * 64); }
#define SSTORE(P, buf) { u16* sa_ = As + (buf) * 128 * 72 + lrow * 72 + lkc * 8; u16* sb_ = Bs + (buf) * 256 * 72 + lrow * 72 + lkc * 8; \
      *(uint4*)sa_ = P##a0; *(uint4*)(sa_ + 64 * 72) = P##a1; *(uint4*)sb_ = P##b0; *(uint4*)(sb_ + 64 * 72) = P##b1; *(uint4*)(sb_ + 128 * 72) = P##b2; *(uint4*)(sb_ + 192 * 72) = P##b3; }
#define COMPUTE(buf) { const u16* as = As + (buf) * 128 * 72 + (wm * 64 + fr) * 72 + fq * 8; const u16* bs = Bs + (buf) * 256 * 72 + (wn * 64 + fr) * 72 + fq * 8; \
      _Pragma("unroll") for (int ks = 0; ks < 2; ++ks) { bf16x8 wf[4], af[4]; \
        _Pragma("unroll") for (int i = 0; i < 4; ++i) { wf[i] = *(const bf16x8*)(bs + i * 16 * 72 + ks * 32); af[i] = *(const bf16x8*)(as + i * 16 * 72 + ks * 32); } \
        _Pragma("unroll") for (int i = 0; i < 4; ++i) _Pragma("unroll") for (int j = 0; j < 4; ++j) acc[i][j] = __builtin_amdgcn_mfma_f32_16x16x32_bf16(wf[i], af[j], acc[i][j], 0, 0, 0); } }
    GLOAD(p, 0); SSTORE(p, 0);
    GLOAD(p, 1); GLOAD(q, 2);
    __syncthreads();
    for (int kt = 0; kt < nk; kt += 2) {
      SSTORE(p, 1);
      if (kt + 3 < nk) GLOAD(p, kt + 3);
      COMPUTE(0);
      __syncthreads();
      if (kt + 2 < nk) SSTORE(q, 0);
      if (kt + 4 < nk) GLOAD(q, kt + 4);
      COMPUTE(1);
      __syncthreads();
    }
#undef GLOAD
#undef SSTORE
#undef COMPUTE
#pragma unroll
    for (int i = 0; i < 4; ++i)
#pragma unroll
      for (int j = 0; j < 4; ++j) {
        const int row = m0 + wm * 64 + j * 16 + fr; const int col = n0 + wn * 64 + i * 16 + fq * 4; const f32x4 v = acc[i][j];
        if (EPI == 0) {
          if (col < NU) {
            *(uint2*)((u16*)Cout + (size_t)row * NU + col) = make_uint2(pack2(v[0], v[1]), pack2(v[2], v[3]));
            if (row < 4096 && col >= 1664 && col < 2688) {
              int b = row >> 8, t = row & 255;
              float* dst = (col < 2176) ? p.out + OUT_CK + ((size_t)((b * 4 + l) * 256 + t)) * 512 + (col - 1664)
                                        : p.out + OUT_CV + ((size_t)((b * 4 + l) * 256 + t)) * 512 + (col - 2176);
              *(float4*)dst = make_float4(v[0], v[1], v[2], v[3]);
            }
          }
        } else if (EPI == 1) {
          *(float4*)((float*)Cout + (size_t)row * ldc + col) = make_float4(v[0], v[1], v[2], v[3]);
        } else {
          float a = fmaxf(v[0], 0.f), b = fmaxf(v[1], 0.f), c = fmaxf(v[2], 0.f), d = fmaxf(v[3], 0.f);
          *(uint2*)((u16*)Cout + (size_t)row * ldc + col) = make_uint2(pack2(a * a, b * b), pack2(c * c, d * d));
        }
      }
  }
}

DI void rwkv_prep_item(const Params& p, int l, int tile, float* lds) {
  const int tid = otid();
  const int rowb = tile * 32; int s, t0, L, row0; seq_of(rowb, s, t0, L, row0);
  const u16* U = (const u16*)(p.ws + WS_U);
  float* tw = lds; float* ua = lds + 4096; float* sg = lds + 8192;
  for (int idx = tid; idx < 32 * 384; idx += 512) {
    int tok = idx / 384, c = idx % 384; float v = bf2f(U[(size_t)(rowb + tok) * NU + 768 + c]);
    if (c < 128) tw[tok * 128 + c] = tanhf(v); else if (c < 256) ua[tok * 128 + c - 128] = v; else sg[tok * 128 + c - 256] = sigmoidf_(v);
  }
  __syncthreads();
  const int c = tid & 255, tg = tid >> 8, h = c >> 6;
  float ag[16], awf[16], awb[16], aaf[16], aab[16];
#pragma unroll
  for (int i = 0; i < 16; ++i) { ag[i] = 0.f; awf[i] = 0.f; awb[i] = 0.f; aaf[i] = 0.f; aab[i] = 0.f; }
  const float* g2 = p.in[19] + (size_t)l * 128 * 256 + c; const float* w2 = p.in[16] + (size_t)l * 2 * 64 * 256 + c; const float* a2 = p.in[18] + (size_t)l * 2 * 64 * 256 + c;
  for (int k = 0; k < 128; k += 4) {
    float w0 = g2[(k) * 256], w1 = g2[(k + 1) * 256], w2_ = g2[(k + 2) * 256], w3 = g2[(k + 3) * 256];
#pragma unroll
    for (int tt = 0; tt < 16; ++tt) { float4 sv = *(const float4*)(sg + (tg * 16 + tt) * 128 + k); ag[tt] += sv.x * w0 + sv.y * w1 + sv.z * w2_ + sv.w * w3; }
  }
  for (int k = 0; k < 64; k += 4) {
    float wf[4], wb[4], af[4], ab[4];
#pragma unroll
    for (int q = 0; q < 4; ++q) { wf[q] = w2[(k + q) * 256]; wb[q] = w2[(64 + k + q) * 256]; af[q] = a2[(k + q) * 256]; ab[q] = a2[(64 + k + q) * 256]; }
#pragma unroll
    for (int tt = 0; tt < 16; ++tt) {
      const int tok = tg * 16 + tt;
      float4 t1 = *(const float4*)(tw + tok * 128 + k), t2 = *(const float4*)(tw + tok * 128 + 64 + k);
      float4 u1 = *(const float4*)(ua + tok * 128 + k), u2 = *(const float4*)(ua + tok * 128 + 64 + k);
      awf[tt] += t1.x * wf[0] + t1.y * wf[1] + t1.z * wf[2] + t1.w * wf[3];
      awb[tt] += t2.x * wb[0] + t2.y * wb[1] + t2.z * wb[2] + t2.w * wb[3];
      aaf[tt] += u1.x * af[0] + u1.y * af[1] + u1.z * af[2] + u1.w * af[3];
      aab[tt] += u2.x * ab[0] + u2.y * ab[1] + u2.z * ab[2] + u2.w * ab[3];
    }
  }
  const float* cw = p.in[14] + (size_t)l * 3 * 768;
  float cr[3], ck[3], cv[3];
#pragma unroll
  for (int q = 0; q < 3; ++q) { cr[q] = cw[q * 768 + c]; ck[q] = cw[q * 768 + 256 + c]; cv[q] = cw[q * 768 + 512 + c]; }
  const float kkw = p.in[20][l * 256 + c], ka = p.in[21][l * 256 + c], rk = p.in[22][l * 256 + c];
  const float w0f = p.in[15][(l * 2 + 0) * 256 + c], w0b = p.in[15][(l * 2 + 1) * 256 + c];
  const float a0f = p.in[17][(l * 2 + 0) * 256 + c], a0b = p.in[17][(l * 2 + 1) * 256 + c];
  float* RW = (float*)(p.ws + WS_RW); float* G = (float*)(p.ws + WS_G); float* BC = (float*)(p.ws + WS_BC);
#pragma unroll
  for (int tt = 0; tt < 16; ++tt) {
    const int tok = tg * 16 + tt, row = rowb + tok, t = t0 + tok;
    const u16* ur = U + (size_t)row * NU + c;
    float r0 = bf2f(ur[0]), k0 = bf2f(ur[256]), v0 = bf2f(ur[512]);
    float rm = 0.f, km = 0.f, vm = 0.f, rp = 0.f, kp = 0.f, vp = 0.f;
    if (t > 0) { rm = bf2f(ur[-NU]); km = bf2f(ur[256 - NU]); vm = bf2f(ur[512 - NU]); }
    if (t + 1 < L) { rp = bf2f(ur[NU]); kp = bf2f(ur[256 + NU]); vp = bf2f(ur[512 + NU]); }
    const float r = cr[0] * rm + cr[1] * r0 + cr[2] * rp;
    const float k = ck[0] * km + ck[1] * k0 + ck[2] * kp;
    const float v = cv[0] * vm + cv[1] * v0 + cv[2] * vp;
    const float kkr = k * kkw; const float ss = wave_sum(kkr * kkr); const float kk = kkr * rsqrtf(ss + 1e-12f);
    const float sgf = sigmoidf_(w0f + awf[tt]); const float decf = expf(-0.60653066f * sgf);
    const float sgb = sigmoidf_(w0b + awb[tt]); const float decb = expf(-0.60653066f * sgb);
    const float af_ = sigmoidf_(a0f + aaf[tt]), ab_ = sigmoidf_(a0b + aab[tt]);
    const float kdf = k * (1.f + (af_ - 1.f) * ka), kdb = k * (1.f + (ab_ - 1.f) * ka);
    const float bonus = wave_sum(r * (kdf + kdb) * rk);
    float* dst = RW + ((size_t)(row * 4 + h) * 9) * 64 + (c & 63);
    dst[0] = r; dst[64] = kk; dst[128] = v; dst[192] = decf; dst[256] = kk * af_; dst[320] = kdf; dst[384] = decb; dst[448] = kk * ab_; dst[512] = kdb;
    G[(size_t)row * 256 + c] = ag[tt];
    if ((c & 63) == 0) BC[row * 4 + h] = bonus;
  }
  __syncthreads();
}

DI void attn_prep_item(const Params& p, int l, int tile) {
  const int tid = otid();
  const int rowb = tile * 32; int s, t0, L, row0; seq_of(rowb, s, t0, L, row0);
  const bool lat = s >= 16;
  const u16* U = (const u16*)(p.ws + WS_U);
  u16* Q = (u16*)(p.ws + WS_Q);
  u16* Kd = lat ? (u16*)(p.ws + WS_KL) + ((size_t)(s - 16) * 2304 + 256) * 512 : (u16*)(p.ws + WS_KC) + (size_t)s * 256 * 512;
  u16* Vd = lat ? (u16*)(p.ws + WS_VL) + ((size_t)(s - 16) * 2304 + 256) * 512 : (u16*)(p.ws + WS_VC) + (size_t)s * 256 * 512;
  for (int uidx = tid; uidx < 2048; uidx += 512) {
    const int g = uidx & 1, pb = (uidx >> 1) & 1, hm = (uidx >> 2) & 7, which = (uidx >> 5) & 1, tok = uidx >> 6;
    const int row = rowb + tok, t = t0 + tok;
    const u16* src = U + (size_t)row * NU + (which ? 1664 : 1152) + hm * 64 + pb * 32 + g * 8;
    const uint4 va = *(const uint4*)src; const uint4 vb = *(const uint4*)(src + 16);
    const unsigned wa[4] = {va.x, va.y, va.z, va.w}, wb[4] = {vb.x, vb.y, vb.z, vb.w};
    float oa[8], ob[8];
#pragma unroll
    for (int j = 0; j < 8; ++j) {
      float xa = bf2f((u16)(wa[j >> 1] >> ((j & 1) * 16))), xb = bf2f((u16)(wb[j >> 1] >> ((j & 1) * 16)));
      if (lat) {
        const int pidx = pb == 0 ? (t >> 6) : (t & 63); const int i = g * 8 + j;
        const float inv = exp2f(-(float)(2 * i) * (13.287712379549449f / 32.f)); const float ang = (float)pidx * inv;
        const float cs = cosf(ang), sn = sinf(ang);
        oa[j] = xa * cs - xb * sn; ob[j] = xb * cs + xa * sn;
      } else { oa[j] = xa; ob[j] = xb; }
    }
    u16* dst = (which == 0) ? Q + (size_t)row * 512 + hm * 64 + pb * 32 + g * 8 : Kd + (size_t)t * 512 + hm * 64 + pb * 32 + g * 8;
    *(uint4*)dst = make_uint4(pack2(oa[0], oa[1]), pack2(oa[2], oa[3]), pack2(oa[4], oa[5]), pack2(oa[6], oa[7]));
    *(uint4*)(dst + 16) = make_uint4(pack2(ob[0], ob[1]), pack2(ob[2], ob[3]), pack2(ob[4], ob[5]), pack2(ob[6], ob[7]));
  }
  for (int uidx = tid; uidx < 2048; uidx += 512) {
    const int tok = uidx >> 6, ch = uidx & 63;
    *(uint4*)(Vd + (size_t)(t0 + tok) * 512 + ch * 8) = *(const uint4*)(U + (size_t)(rowb + tok) * NU + 2176 + ch * 8);
  }
}

DI void cache_item(const Params& p, int l, int it) {
  const int b = it >> 3, pc = it & 7;
  u16* KL = (u16*)(p.ws + WS_KL); u16* VL = (u16*)(p.ws + WS_VL);
  for (int idx = otid(); idx < 32 * 128; idx += 512) {
    const int r = idx >> 7, c4 = idx & 127, prow = pc * 32 + r;
    const size_t so = ((size_t)(b * 4 + l) * 256 + prow) * 512 + c4 * 4; const size_t d_o = ((size_t)b * 2304 + prow) * 512 + c4 * 4;
    float4 kv = *(const float4*)(p.in[3] + so); float4 vv = *(const float4*)(p.in[4] + so);
    *(uint2*)(KL + d_o) = make_uint2(pack2(kv.x, kv.y), pack2(kv.z, kv.w));
    *(uint2*)(VL + d_o) = make_uint2(pack2(vv.x, vv.y), pack2(vv.z, vv.w));
  }
}

DI void hy_prep_item(const Params& p, int l, int tile, float* lds) {
  const int tid = otid();
  const int rowb = tile * 64; int s, t0, L, row0; seq_of(rowb, s, t0, L, row0);
  const u16* U = (const u16*)(p.ws + WS_U); float* HYT = (float*)(p.ws + WS_HYT);
  for (int which = 0; which < 3; ++which) {
    const int c = tid & 255, tg = tid >> 8, col = which * 256 + c;
    const float w0 = p.in[30][(size_t)l * 3 * 768 + col], w1 = p.in[30][(size_t)l * 3 * 768 + 768 + col], w2 = p.in[30][(size_t)l * 3 * 768 + 1536 + col];
    const float bias = p.in[31][l * 768 + col];
    for (int tt = 0; tt < 32; ++tt) {
      const int tok = tg * 32 + tt, row = rowb + tok, t = t0 + tok;
      const u16* ur = U + (size_t)row * NU + 2688 + col;
      float um = t > 0 ? bf2f(ur[-NU]) : 0.f, u0 = bf2f(ur[0]), up = (t + 1 < L) ? bf2f(ur[NU]) : 0.f;
      lds[tok * 257 + c] = w0 * um + w1 * u0 + w2 * up + bias;
    }
    __syncthreads();
    const int cc = tid >> 1, half = tid & 1;
    float* dst = HYT + (size_t)(which * 256 + cc) * TT + rowb + half * 32;
#pragma unroll
    for (int i = 0; i < 32; i += 4) {
      float4 v = make_float4(lds[(half * 32 + i) * 257 + cc], lds[(half * 32 + i + 1) * 257 + cc], lds[(half * 32 + i + 2) * 257 + cc], lds[(half * 32 + i + 3) * 257 + cc]);
      *(float4*)(dst + i) = v;
    }
    __syncthreads();
  }
}

DI void scan_item(const Params& p, int l, int s, int h, int d, int rg, float* lds) {
  int L, row0; if (s < 16) { L = 256; row0 = s * 256; } else { L = 2048; row0 = 4096 + (s - 16) * 2048; }
  const float* RW = (const float*)(p.ws + WS_RW); float* YS = (float*)(p.ws + WS_YS) + (size_t)d * TT * 256;
  const int tid = otid(), lane = tid & 63, wid = tid >> 6, lane16 = lane & 15, rsub = lane >> 4;
  const int row = rg * 16 + (wid & 3) * 4 + rsub;
  float4 st = make_float4(0.f, 0.f, 0.f, 0.f);
  if (s >= 16 && wid < 4) st = *(const float4*)(p.in[2] + ((((size_t)(s - 16) * 4 + l) * 2 + d) * 4 + h) * 4096 + row * 64 + lane16 * 4);
  const int nch = L / 32;
  float4 pre0, pre1, pre2, pre3, pre4, pre5;
  auto ldpre = [&](int ch, int j) -> float4 {
    int f = tid + j * 512; int step = f / 96, within = f % 96; int slot6 = within >> 4, q = within & 15;
    int srcslot = slot6 < 3 ? slot6 : 3 + 3 * d + (slot6 - 3); int i = ch * 32 + step; int t = d ? L - 1 - i : i;
    return *(const float4*)(RW + ((size_t)((row0 + t) * 4 + h) * 9 + srcslot) * 64 + q * 4); };
#define PREFETCH(ch) { pre0 = ldpre(ch, 0); pre1 = ldpre(ch, 1); pre2 = ldpre(ch, 2); pre3 = ldpre(ch, 3); pre4 = ldpre(ch, 4); pre5 = ldpre(ch, 5); }
  PREFETCH(0);
  for (int ch = 0; ch < nch; ++ch) {
    *(float4*)(lds + (size_t)(tid + 0 * 512) * 4) = pre0; *(float4*)(lds + (size_t)(tid + 1 * 512) * 4) = pre1;
    *(float4*)(lds + (size_t)(tid + 2 * 512) * 4) = pre2; *(float4*)(lds + (size_t)(tid + 3 * 512) * 4) = pre3;
    *(float4*)(lds + (size_t)(tid + 4 * 512) * 4) = pre4; *(float4*)(lds + (size_t)(tid + 5 * 512) * 4) = pre5;
    __syncthreads();
    if (ch + 1 < nch) PREFETCH(ch + 1);
    if (wid < 4) {
#pragma unroll 4
      for (int step = 0; step < 32; ++step) {
        const float* base = lds + step * 384;
        const float4 r4 = *(const float4*)(base + lane16 * 4), kk4 = *(const float4*)(base + 64 + lane16 * 4);
        const float vrow = base[128 + row];
        const float4 w4 = *(const float4*)(base + 192 + lane16 * 4), b4 = *(const float4*)(base + 256 + lane16 * 4), kd4 = *(const float4*)(base + 320 + lane16 * 4);
        float sa = -(st.x * kk4.x + st.y * kk4.y + st.z * kk4.z + st.w * kk4.w);
        sa = allreduce16(sa);
        st.x = st.x * w4.x + (sa * b4.x + vrow * kd4.x);
        st.y = st.y * w4.y + (sa * b4.y + vrow * kd4.y);
        st.z = st.z * w4.z + (sa * b4.z + vrow * kd4.z);
        st.w = st.w * w4.w + (sa * b4.w + vrow * kd4.w);
        float y = st.x * r4.x + st.y * r4.y + st.z * r4.z + st.w * r4.w;
        y = allreduce16(y);
        if (lane16 == 0) { int i = ch * 32 + step; int t = d ? L - 1 - i : i; YS[(size_t)(row0 + t) * 256 + h * 64 + row] = y; }
      }
    }
    __syncthreads();
  }
#undef PREFETCH
  if (s < 16 && wid < 4) *(float4*)(p.out + OUT_STATE + ((((size_t)s * 4 + l) * 2 + d) * 4 + h) * 4096 + row * 64 + lane16 * 4) = st;
}

DI void attn_item(const Params& p, int l, int s, int h, int qt, unsigned char* smem, float lam, float lam_init) {
  u16* Ks = (u16*)smem; u16* Vs = Ks + 64 * 136; float* Ex = (float*)(smem + 2 * 17408);
  const bool lat = s >= 16; const int Lk = lat ? 2304 : 256;
  const u16* Kg = lat ? (const u16*)(p.ws + WS_KL) + (size_t)(s - 16) * 2304 * 512 : (const u16*)(p.ws + WS_KC) + (size_t)s * 256 * 512;
  const u16* Vg = lat ? (const u16*)(p.ws + WS_VL) + (size_t)(s - 16) * 2304 * 512 : (const u16*)(p.ws + WS_VC) + (size_t)s * 256 * 512;
  const int row0 = lat ? 4096 + (s - 16) * 2048 : s * 256; const int qrow0 = row0 + qt * 128;
  const u16* Q = (const u16*)(p.ws + WS_Q);
  const int tid = otid(), lane = tid & 63, wid = tid >> 6, m = wid & 1, qs = wid >> 1, r = lane & 31, hh = lane >> 5;
  bf16x8 qf[4];
#pragma unroll
  for (int ks = 0; ks < 4; ++ks) qf[ks] = *(const bf16x8*)(Q + (size_t)(qrow0 + qs * 32 + r) * 512 + h * 128 + m * 64 + ks * 16 + hh * 8);
  f32x16 o[4];
#pragma unroll
  for (int et = 0; et < 4; ++et)
#pragma unroll
    for (int i = 0; i < 16; ++i) o[et][i] = 0.f;
  float mrun = -1e30f, lsum = 0.f; const float cs = 0.125f * 1.4426950408889634f;
  for (int kt0 = 0; kt0 < Lk; kt0 += 64) {
    __syncthreads();
#pragma unroll
    for (int i = 0; i < 2; ++i) { int id = tid + i * 512; int key = id >> 4, ch = id & 15;
      *(uint4*)(Ks + key * 136 + ch * 8) = *(const uint4*)(Kg + (size_t)(kt0 + key) * 512 + h * 128 + ch * 8); }
#pragma unroll
    for (int i = 0; i < 2; ++i) { int id = tid + i * 512; int key = id & 63, e8 = id >> 6;
      const uint4 v = *(const uint4*)(Vg + (size_t)(kt0 + key) * 512 + h * 128 + e8 * 8);
      const unsigned w[4] = {v.x, v.y, v.z, v.w};
#pragma unroll
      for (int j = 0; j < 8; ++j) Vs[(e8 * 8 + j) * 68 + key] = (u16)(w[j >> 1] >> ((j & 1) * 16)); }
    __syncthreads();
    f32x16 st[2];
#pragma unroll
    for (int kt = 0; kt < 2; ++kt) {
#pragma unroll
      for (int i = 0; i < 16; ++i) st[kt][i] = 0.f;
#pragma unroll
      for (int ks = 0; ks < 4; ++ks) { const bf16x8 kf = *(const bf16x8*)(Ks + (kt * 32 + r) * 136 + m * 64 + ks * 16 + hh * 8);
        st[kt] = __builtin_amdgcn_mfma_f32_32x32x16_bf16(kf, qf[ks], st[kt], 0, 0, 0); }
    }
    float mx = st[0][0];
#pragma unroll
    for (int i = 0; i < 16; ++i) { mx = fmaxf(mx, st[0][i]); mx = fmaxf(mx, st[1][i]); }
    mx = fmaxf(mx, __shfl_xor(mx, 32));
    const float mnew = fmaxf(mrun, mx); const float alpha = exp2f((mrun - mnew) * cs); mrun = mnew;
    lsum *= alpha;
#pragma unroll
    for (int et = 0; et < 4; ++et)
#pragma unroll
      for (int i = 0; i < 16; ++i) o[et][i] *= alpha;
#pragma unroll
    for (int kt = 0; kt < 2; ++kt)
#pragma unroll
      for (int i = 0; i < 16; ++i) { float pv = exp2f((st[kt][i] - mnew) * cs); lsum += pv; st[kt][i] = pv; }
#pragma unroll
    for (int kt = 0; kt < 2; ++kt)
#pragma unroll
      for (int ss = 0; ss < 2; ++ss) {
        bf16x8 pf;
#pragma unroll
        for (int j = 0; j < 8; ++j) pf[j] = (short)f2bf(st[kt][8 * ss + j]);
#pragma unroll
        for (int et = 0; et < 4; ++et) {
          const u16* vp = Vs + (et * 32 + r) * 68 + kt * 32 + 16 * ss + 4 * hh;
          const s16x4 lo = *(const s16x4*)vp, hi = *(const s16x4*)(vp + 8);
          const bf16x8 vf = __builtin_shufflevector(lo, hi, 0, 1, 2, 3, 4, 5, 6, 7);
          o[et] = __builtin_amdgcn_mfma_f32_32x32x16_bf16(vf, pf, o[et], 0, 0, 0);
        }
      }
  }
  lsum += __shfl_xor(lsum, 32); const float inv = 1.f / lsum;
  float* ex = Ex + qs * (32 * 132);
  if (m == 1) {
#pragma unroll
    for (int et = 0; et < 4; ++et)
#pragma unroll
      for (int i = 0; i < 16; ++i) { int e = et * 32 + (i & 3) + 8 * (i >> 2) + 4 * hh; ex[r * 132 + e] = o[et][i] * inv; }
  }
  __syncthreads();
  if (m == 0) {
    float ssq = 0.f;
#pragma unroll
    for (int et = 0; et < 4; ++et)
#pragma unroll
      for (int i = 0; i < 16; ++i) { int e = et * 32 + (i & 3) + 8 * (i >> 2) + 4 * hh; float v = o[et][i] * inv - lam * ex[r * 132 + e]; o[et][i] = v; ssq += v * v; }
    ssq += __shfl_xor(ssq, 32);
    const float rs = rsqrtf(ssq * (1.f / 128.f) + 1e-6f) * (1.f - lam_init);
    const float* subln = p.in[29] + l * 128;
    u16* dstrow = (u16*)(p.ws + WS_MIXCAT) + (size_t)(qrow0 + qs * 32 + r) * 1024 + 256 + h * 128;
#pragma unroll
    for (int et = 0; et < 4; ++et)
#pragma unroll
      for (int g4 = 0; g4 < 4; ++g4) {
        const int e0 = et * 32 + 8 * g4 + 4 * hh; const float4 sl = *(const float4*)(subln + e0);
        *(uint2*)(dstrow + e0) = make_uint2(pack2(o[et][4 * g4] * rs * sl.x, o[et][4 * g4 + 1] * rs * sl.y), pack2(o[et][4 * g4 + 2] * rs * sl.z, o[et][4 * g4 + 3] * rs * sl.w));
      }
  }
}

DI void hy_conv(const float* g, const float* z, int L, int t0, float& a0, float& a1, float& a2, float& a3) {
  a0 = a1 = a2 = a3 = 0.f;
  const float* gp = g + L + t0 - 4;
  const int nb = L >> 2;
#pragma unroll 4
  for (int sb = 0; sb < nb; ++sb) {
    const float4 zz = *(const float4*)(z + sb * 4);
    const float4 ga = *(const float4*)(gp - 4 * sb), gb = *(const float4*)(gp - 4 * sb + 4);
    a0 += gb.x * zz.x + ga.w * zz.y + ga.z * zz.z + ga.y * zz.w;
    a1 += gb.y * zz.x + gb.x * zz.y + ga.w * zz.z + ga.z * zz.w;
    a2 += gb.z * zz.x + gb.y * zz.y + gb.x * zz.z + ga.w * zz.w;
    a3 += gb.w * zz.x + gb.z * zz.y + gb.y * zz.z + gb.x * zz.w;
  }
}

DI void hyena_item(const Params& p, int l, int s, int c0, float* lds) {
  const bool lat = s >= 16; const int L = lat ? 2048 : 256; const int row0 = lat ? 4096 + (s - 16) * 2048 : s * 256;
  const int TPC = L >> 2; const int tid = otid(), lane = tid & 63, wid = tid >> 6;
  const int ch = tid / TPC, tl = tid % TPC, t0 = tl * 4, c = c0 + ch;
  float* G = lds; float* Z = lds + 8192; float* red = lds + 8192 + 2048;
  const float* F = (const float*)(p.ws + WS_FILT) + (lat ? 262144 : 0);
  const float* HYT = (const float*)(p.ws + WS_HYT);
  float ssq[2];
#pragma unroll
  for (int o = 0; o < 2; ++o) {
    const float* src = F + (size_t)(o * 256 + c) * (2 * L); float* dst = G + (size_t)(ch * 2 + o) * (2 * L); float sacc = 0.f;
#pragma unroll
    for (int i = 0; i < 2; ++i) { int idx = (tl + i * TPC) * 4; float4 v = *(const float4*)(src + idx); *(float4*)(dst + idx) = v; sacc += v.x * v.x + v.y * v.y + v.z * v.z + v.w * v.w; }
    ssq[o] = wave_sum(sacc);
  }
  if (lane == 0) { red[wid * 2] = ssq[0]; red[wid * 2 + 1] = ssq[1]; }
  const float4 x1 = *(const float4*)(HYT + (size_t)(0 * 256 + c) * TT + row0 + t0);
  const float4 x2 = *(const float4*)(HYT + (size_t)(1 * 256 + c) * TT + row0 + t0);
  const float4 v4 = *(const float4*)(HYT + (size_t)(2 * 256 + c) * TT + row0 + t0);
  *(float4*)(Z + ch * L + t0) = v4;
  __syncthreads();
  const int wpc = TPC >> 6, w0 = ch * wpc; float sc0 = 0.f, sc1 = 0.f;
  for (int w = 0; w < wpc; ++w) { sc0 += red[(w0 + w) * 2]; sc1 += red[(w0 + w) * 2 + 1]; }
  sc0 = rsqrtf(sc0 + 1e-6f); sc1 = rsqrtf(sc1 + 1e-6f);
  const float bias0 = p.in[39][(l * 2 + 0) * 256 + c], bias1 = p.in[39][(l * 2 + 1) * 256 + c];
  float a0, a1, a2, a3;
  hy_conv(G + (size_t)(ch * 2 + 0) * (2 * L), Z + ch * L, L, t0, a0, a1, a2, a3);
  float4 z1;
  z1.x = x1.x * (sc0 * a0 + bias0 * v4.x); z1.y = x1.y * (sc0 * a1 + bias0 * v4.y); z1.z = x1.z * (sc0 * a2 + bias0 * v4.z); z1.w = x1.w * (sc0 * a3 + bias0 * v4.w);
  __syncthreads();
  *(float4*)(Z + ch * L + t0) = z1;
  __syncthreads();
  hy_conv(G + (size_t)(ch * 2 + 1) * (2 * L), Z + ch * L, L, t0, a0, a1, a2, a3);
  float4 yo;
  yo.x = x2.x * (sc1 * a0 + bias1 * z1.x); yo.y = x2.y * (sc1 * a1 + bias1 * z1.y); yo.z = x2.z * (sc1 * a2 + bias1 * z1.z); yo.w = x2.w * (sc1 * a3 + bias1 * z1.w);
  *(float4*)((float*)(p.ws + WS_YC) + (size_t)c * TT + row0 + t0) = yo;
  __syncthreads();
}


DI float2 cmul(float2 a, float2 b) { return make_float2(a.x * b.x - a.y * b.y, a.x * b.y + a.y * b.x); }
#define BF2(a, b) { float2 t_ = a; a.x = t_.x + b.x; a.y = t_.y + b.y; b.x = t_.x - b.x; b.y = t_.y - b.y; }
#define MNI(a) { float t_ = a.x; a.x = a.y; a.y = -t_; }
DI void fft_fwd(float2 (&v)[8], int j, int TPF, int npass, float2* lds) {
  int Ns = 1;
  for (int ps = 0; ps < npass; ++ps) {
    const int k = j & (Ns - 1);
    if (ps > 0) {
      const float a2 = -2.f * (float)k / (float)(Ns * 8);
      const float2 w1 = make_float2(cospif(a2), sinpif(a2));
      float2 w = w1; v[1] = cmul(v[1], w);
      w = cmul(w, w1); v[2] = cmul(v[2], w);
      w = cmul(w, w1); v[3] = cmul(v[3], w);
      w = cmul(w, w1); v[4] = cmul(v[4], w);
      w = cmul(w, w1); v[5] = cmul(v[5], w);
      w = cmul(w, w1); v[6] = cmul(v[6], w);
      w = cmul(w, w1); v[7] = cmul(v[7], w);
    }
    BF2(v[0], v[4]); BF2(v[1], v[5]); BF2(v[2], v[6]); BF2(v[3], v[7]);
    v[5] = cmul(v[5], make_float2(0.70710678118654752f, -0.70710678118654752f)); MNI(v[6]); v[7] = cmul(v[7], make_float2(-0.70710678118654752f, -0.70710678118654752f));
    BF2(v[0], v[2]); BF2(v[1], v[3]); BF2(v[4], v[6]); BF2(v[5], v[7]);
    MNI(v[3]); MNI(v[7]);
    BF2(v[0], v[1]); BF2(v[2], v[3]); BF2(v[4], v[5]); BF2(v[6], v[7]);
    { float2 t1 = v[1], t3 = v[3]; v[1] = v[4]; v[3] = v[6]; v[4] = t1; v[6] = t3; }
    if (ps == npass - 1) break;
    __syncthreads();
    const int base = (j - k) * 8 + k;
#pragma unroll
    for (int r = 0; r < 8; ++r) { const int idx = base + r * Ns; lds[idx + (idx >> 3)] = v[r]; }
    __syncthreads();
#pragma unroll
    for (int r = 0; r < 8; ++r) { const int idx = j + r * TPF; v[r] = lds[idx + (idx >> 3)]; }
    Ns *= 8;
  }
}

DI void hspec_item(const Params& p, int lat, int item, float* ldsf) {
  const int tid = otid(), lane = tid & 63, wid = tid >> 6;
  const int TPF = lat ? 512 : 64, npass = lat ? 4 : 3, L = lat ? 2048 : 256, N = 2 * L;
  const int unit = lat ? 0 : wid; const int j = tid & (TPF - 1);
  const int c = lat ? item : item * 8 + unit;
  float2* lds = (float2*)ldsf + unit * (N + (N >> 3));
  float* red = ldsf + 9216;
  const float* F = (const float*)(p.ws + WS_FILT) + (lat ? 262144 : 0);
  const float* g0 = F + (size_t)c * N; const float* g1 = F + (size_t)(256 + c) * N;
  float2 v[8]; float s0 = 0.f, s1 = 0.f;
#pragma unroll
  for (int r = 0; r < 8; ++r) { const int n = j + r * TPF; const int gi = (n + L) & (N - 1); const float a = g0[gi], b = g1[gi]; v[r] = make_float2(a, b); s0 += a * a; s1 += b * b; }
  s0 = wave_sum(s0); s1 = wave_sum(s1);
  if (lane == 0) { red[wid * 2] = s0; red[wid * 2 + 1] = s1; }
  __syncthreads();
  if (lat) { s0 = 0.f; s1 = 0.f; for (int w = 0; w < 8; ++w) { s0 += red[w * 2]; s1 += red[w * 2 + 1]; } }
  const float sc0 = rsqrtf(s0 + 1e-6f), sc1 = rsqrtf(s1 + 1e-6f);
#pragma unroll
  for (int r = 0; r < 8; ++r) { v[r].x *= sc0; v[r].y *= sc1; }
  fft_fwd(v, j, TPF, npass, lds);
  __syncthreads();
#pragma unroll
  for (int r = 0; r < 8; ++r) { const int idx = j + r * TPF; lds[idx + (idx >> 3)] = v[r]; }
  __syncthreads();
  const float hn = 0.5f / (float)N;
  float2* HS = (float2*)(p.ws + WS_HSPEC) + (lat ? 0 : 2 * 256 * 4096);
  float2* H0 = HS + (size_t)c * N; float2* H1 = HS + (size_t)(256 + c) * N;
#pragma unroll
  for (int r = 0; r < 8; ++r) {
    const int k = j + r * TPF; const int km = (N - k) & (N - 1); const float2 wm = lds[km + (km >> 3)];
    const float2 sm = make_float2(v[r].x + wm.x, v[r].y - wm.y); const float2 df = make_float2(v[r].x - wm.x, v[r].y + wm.y);
    H0[k] = make_float2(sm.x * hn, sm.y * hn); H1[k] = make_float2(df.y * hn, -df.x * hn);
  }
  __syncthreads();
}

DI void hyena_fft_item(const Params& p, int l, int lat, int item, float* ldsf) {
  const int tid = otid(), wid = tid >> 6;
  const int TPF = lat ? 512 : 64, npass = lat ? 4 : 3, L = lat ? 2048 : 256, N = 2 * L;
  const int unit = lat ? 0 : wid; const int j = tid & (TPF - 1);
  int c, rowa, rowb;
  if (lat) { const int bp = item >> 8; c = item & 255; rowa = 4096 + (2 * bp) * 2048; rowb = rowa + 2048; }
  else { const int gidx = item * 8 + unit; const int pair = gidx >> 8; c = gidx & 255; rowa = (2 * pair) * 256; rowb = rowa + 256; }
  float2* lds = (float2*)ldsf + unit * (N + (N >> 3));
  const float2* HS = (const float2*)(p.ws + WS_HSPEC) + (lat ? 0 : 2 * 256 * 4096);
  const float* HYT = (const float*)(p.ws + WS_HYT);
  float2 v[8], z[4];
#pragma unroll
  for (int r = 0; r < 4; ++r) { const int t = j + r * TPF; z[r] = make_float2(HYT[(size_t)(512 + c) * TT + rowa + t], HYT[(size_t)(512 + c) * TT + rowb + t]); v[r] = z[r]; v[4 + r] = make_float2(0.f, 0.f); }
  for (int order = 0; order < 2; ++order) {
    const float2* H = HS + (size_t)(order * 256 + c) * N;
    const float* xq = HYT + (size_t)(order * 256 + c) * TT;
    float2 h[8];
#pragma unroll
    for (int r = 0; r < 8; ++r) h[r] = H[j + r * TPF];
    float xa[4], xb[4];
#pragma unroll
    for (int r = 0; r < 4; ++r) { xa[r] = xq[rowa + j + r * TPF]; xb[r] = xq[rowb + j + r * TPF]; }
    fft_fwd(v, j, TPF, npass, lds);
#pragma unroll
    for (int r = 0; r < 8; ++r) { const float2 y = cmul(v[r], h[r]); v[r] = make_float2(y.x, -y.y); }
    fft_fwd(v, j, TPF, npass, lds);
    const float bias = p.in[39][(l * 2 + order) * 256 + c];
#pragma unroll
    for (int r = 0; r < 4; ++r) {
      const float ya = v[r].x, yb = -v[r].y;
      z[r] = make_float2(xa[r] * (ya + bias * z[r].x), xb[r] * (yb + bias * z[r].y));
      v[r] = z[r]; v[4 + r] = make_float2(0.f, 0.f);
    }
  }
  float* YC = (float*)(p.ws + WS_YC) + (size_t)c * TT;
#pragma unroll
  for (int r = 0; r < 4; ++r) { const int t = j + r * TPF; YC[rowa + t] = z[r].x; YC[rowb + t] = z[r].y; }
  __syncthreads();
}

DI void fin_item(const Params& p, int l, int tile, float* lds) {
  const int tid = otid(), lane = tid & 63, wid = tid >> 6; const int rowb = tile * 64;
  const float* YS0 = (const float*)(p.ws + WS_YS); const float* YS1 = YS0 + (size_t)TT * 256;
  const float* RW = (const float*)(p.ws + WS_RW); const float* G = (const float*)(p.ws + WS_G); const float* BC = (const float*)(p.ws + WS_BC);
  u16* MC = (u16*)(p.ws + WS_MIXCAT);
  for (int q = 0; q < 32; ++q) {
    const int pair = wid * 32 + q, tok = pair >> 2, h = pair & 3, row = rowb + tok, c = h * 64 + lane;
    const float y = YS0[(size_t)row * 256 + c] + YS1[(size_t)row * 256 + c];
    const float mu = wave_sum(y) * (1.f / 64.f); const float dv = y - mu; const float var = wave_sum(dv * dv) * (1.f / 64.f);
    const float yn = dv * rsqrtf(var + 64e-5f) * p.in[23][l * 256 + c] + p.in[24][l * 256 + c];
    const float v = RW[((size_t)(row * 4 + h) * 9 + 2) * 64 + lane]; const float bc = BC[row * 4 + h]; const float g = G[(size_t)row * 256 + c];
    MC[(size_t)row * 1024 + c] = f2bf((yn + bc * v) * g);
  }
  const float* YC = (const float*)(p.ws + WS_YC);
  for (int idx = tid; idx < 16384; idx += 512) { int c = idx >> 6, tt = idx & 63; lds[c * 65 + tt] = YC[(size_t)c * TT + rowb + tt]; }
  __syncthreads();
  for (int idx = tid; idx < 16384; idx += 512) { int tt = idx >> 8, c = idx & 255; MC[(size_t)(rowb + tt) * 1024 + 768 + c] = f2bf(lds[c * 65 + tt]); }
  __syncthreads();
}

constexpr int NPH = 2 + 9 * 4;

DI void run_phase(const Params& p, int ph, unsigned char* smem) {
  float* lds = (float*)smem;
  const int nb = gridDim.x, bid = blockIdx.x;
  if (ph == 0) {
    for (int rep = 0; rep < (((PROBE_DUPK >> 9) & 1) ? 2 : 1); ++rep)
    for (int it = bid; it < 384 + AUX_ITEMS; it += nb) { if (it < 384) mod_item(p, it, lds); else aux_item(p, 0, it - 384, lds); }
    return;
  }
  if (ph == 1) { row_phase(p, 0, 0); return; }
  const int l = (ph - 2) / 9, k = (ph - 2) % 9;
  unsigned char* slot = p.ws + WS_W + (size_t)(l & 1) * W_SLOT;
  const u16* win = (const u16*)slot; const u16* wout = (const u16*)(slot + W_IN_B); const u16* wff1 = (const u16*)(slot + W_IN_B + W_OUT_B); const u16* wff2 = (const u16*)(slot + W_IN_B + W_OUT_B + W_FF_B);
  const int nrep = (k != 2 && k != 5 && k != 8 && ((PROBE_DUPK >> k) & 1)) ? 2 : 1;
  for (int rep = 0; rep < nrep; ++rep)
  switch (k) {
    case 0: gemm_phase<0>(p, (const u16*)(p.ws + WS_H), win, 1024, 14, l, p.ws + WS_U, NU, smem); break;
    case 1:
      for (int it = bid; it < 992 + 288; it += nb) {
        if (it < 384) rwkv_prep_item(p, l, it, lds);
        else if (it < 768) attn_prep_item(p, l, it - 384);
        else if (it < 800) cache_item(p, l, it - 768);
        else if (it < 992) hy_prep_item(p, l, it - 800, lds);
        else if (it < 1248) hspec_item(p, 1, it - 992, lds);
        else hspec_item(p, 0, it - 1248, lds);
      }
      break;
    case 2: {
      __shared__ int s_item; __shared__ float s_lam;
      const float lam_init = 0.8f - 0.6f * expf(-0.3f * (float)l);
      const int tid2 = otid();
      if (tid2 < 64) {
        int ln = tid2; float a = p.in[25][l * 64 + ln] * p.in[26][l * 64 + ln]; float b = p.in[27][l * 64 + ln] * p.in[28][l * 64 + ln];
        a = wave_sum(a); b = wave_sum(b); if (ln == 0) s_lam = expf(a) - expf(b) + lam_init;
      }
      __syncthreads();
      const float lam = s_lam;
      const int npass = ((PROBE_DUPK >> 2) & 1) ? 2 : 1;
      for (int pass = 0; pass < npass; ++pass) {
      unsigned* ctr = (unsigned*)(p.ws + WS_CTL + 16384) + l * 64 + pass * 16;
      const int mask = pass == 0 ? 7 : PROBE_MIXMASK;
      for (;;) {
        __syncthreads();
        if (threadIdx.x == 0) s_item = (int)atomicAdd(ctr, 1u);
        __syncthreads();
        int it = s_item;
        if (it >= 1792) break;
        if (it < 128) { if (mask & 1) scan_item(p, l, 16 + (it >> 5), (it >> 3) & 3, (it >> 2) & 1, it & 3, lds); }
        else if (it < 384) { int j = it - 128; if (mask & 2) attn_item(p, l, 16 + (j >> 6), (j >> 4) & 3, j & 15, smem, lam, lam_init); }
        else if (it < 896) { int j = it - 384; if (mask & 4) hyena_fft_item(p, l, 1, j, lds); }
        else if (it < 1408) { int j = it - 896; if (mask & 1) scan_item(p, l, j >> 5, (j >> 3) & 3, (j >> 2) & 1, j & 3, lds); }
        else if (it < 1536) { int j = it - 1408; if (mask & 2) attn_item(p, l, j >> 3, (j >> 1) & 3, j & 1, smem, lam, lam_init); }
        else { int j = it - 1536; if (mask & 4) hyena_fft_item(p, l, 0, j, lds); }
      }
      }
    } break;
    case 3: for (int it = bid; it < 192; it += nb) fin_item(p, l, it, lds); break;
    case 4: gemm_phase<1>(p, (const u16*)(p.ws + WS_MIXCAT), wout, 1024, 4, l, p.ws + WS_F, 1024, smem); break;
    case 5:
      row_phase(p, l, 1);
      if (l < 3) for (int rep = 0; rep < (((PROBE_DUPK >> 10) & 1) ? 2 : 1); ++rep) for (int it = bid; it < AUX_ITEMS; it += nb) aux_item(p, l + 1, it, lds);
      break;
    case 6: gemm_phase<2>(p, (const u16*)(p.ws + WS_H), wff1, 1024, 16, l, p.ws + WS_A, 4096, smem); break;
    case 7: gemm_phase<1>(p, (const u16*)(p.ws + WS_A), wff2, 4096, 4, l, p.ws + WS_F, 1024, smem); break;
    case 8: row_phase(p, l, 2); break;
  }
}

__global__ void __launch_bounds__(512) mega(Params p, int ph_lo, int ph_hi) {
  extern __shared__ __attribute__((aligned(16))) unsigned char smem[];
  __shared__ uint4 xb_words;
  if (threadIdx.x == 0) xb_words = make_uint4(0u, 0u, 0u, 0u);
  __syncthreads();
  XcdBarrier xb = xcd_barrier_post((unsigned*)(p.ws + WS_CTL), (volatile LAS unsigned*)&xb_words);
  for (int ph = ph_lo; ph < ph_hi; ++ph) {
    if (ph > ph_lo) xcd_barrier(xb);
    run_phase(p, ph, smem);
  }
}

extern "C" void kernel_launch(void* const* d_in, const int* in_sizes, int n_in, void* d_out, int out_size, void* d_ws, size_t ws_size, hipStream_t stream) {
  static int grid = 0;
  if (!grid) {
    int dev = 0, cus = 0, per_cu = 0;
    hipGetDevice(&dev);
    hipDeviceGetAttribute(&cus, hipDeviceAttributeMultiprocessorCount, dev);
    hipFuncSetAttribute((const void*)mega, hipFuncAttributeMaxDynamicSharedMemorySize, (int)LDS_BYTES);
    hipOccupancyMaxActiveBlocksPerMultiprocessor(&per_cu, (const void*)mega, NT, LDS_BYTES);
    if (per_cu < 1) { fprintf(stderr, "occupancy query says %d blocks/CU\n", per_cu); per_cu = 1; }
    grid = cus;
  }
  if (n_in != 43 || ws_size < WS_END) { fprintf(stderr, "kernel_launch: bad n_in %d or ws %zu < %zu\n", n_in, ws_size, (size_t)WS_END); return; }
  Params p{};
  for (int i = 0; i < 43; ++i) p.in[i] = (const float*)d_in[i];
  p.out = (float*)d_out; p.ws = (unsigned char*)d_ws;
  (void)hipMemsetAsync((unsigned char*)d_ws + WS_CTL, 0, 32768, stream);
#if ONE_LAUNCH
  int lo = 0, hi = NPH; void* args[] = {&p, &lo, &hi};
  hipError_t e = hipLaunchCooperativeKernel((const void*)mega, dim3(grid), dim3(NT), args, LDS_BYTES, stream);
  if (e != hipSuccess) fprintf(stderr, "cooperative launch failed: %s\n", hipGetErrorString(e));
#else
  for (int ph = 0; ph < NPH; ++ph) hipLaunchKernelGGL(mega, dim3(grid), dim3(NT), LDS_BYTES, stream, p, ph, ph + 1);
#endif
}
```

```cpp
#include <hip/hip_runtime.h>
#include <hip/hip_cooperative_groups.h>
#include <stdint.h>
#include <stdio.h>
namespace cg = cooperative_groups;

#ifndef ONE_LAUNCH
#define ONE_LAUNCH 1
#endif

#ifndef PROBE_DUPK
#define PROBE_DUPK 0
#endif
#ifndef PROBE_MIXMASK
#define PROBE_MIXMASK 7
#endif
#define DI __device__ __forceinline__
typedef unsigned short u16;
using bf16x8 = __attribute__((ext_vector_type(8))) short;
using s16x4  = __attribute__((ext_vector_type(4))) short;
using f32x4  = __attribute__((ext_vector_type(4))) float;
using f32x16 = __attribute__((ext_vector_type(16))) float;

constexpr int NT = 512;
constexpr int TT = 12288;
constexpr int NU = 3456;
constexpr size_t LDS_BYTES = 131072 + 64;

constexpr size_t WS_CTL = 0;
constexpr size_t WS_MOD = 32768;
constexpr size_t WS_W   = WS_MOD + 491520;
constexpr size_t W_IN_B = 3584ull * 1024 * 2, W_OUT_B = 1024ull * 1024 * 2, W_FF_B = 4096ull * 1024 * 2;
constexpr size_t W_SLOT = W_IN_B + W_OUT_B + 2 * W_FF_B;
constexpr size_t WS_H   = WS_W + 2 * W_SLOT;
constexpr size_t WS_U   = WS_H + (size_t)TT * 1024 * 2;
constexpr size_t WS_MIXCAT = WS_U + (size_t)TT * NU * 2;
constexpr size_t WS_KL  = WS_MIXCAT + (size_t)TT * 1024 * 2;
constexpr size_t WS_VL  = WS_KL + 4ull * 2304 * 512 * 2;
constexpr size_t WS_RW  = WS_VL + 4ull * 2304 * 512 * 2;
constexpr size_t WS_G   = WS_RW + (size_t)TT * 4 * 9 * 64 * 4;
constexpr size_t WS_BC  = WS_G + (size_t)TT * 256 * 4;
constexpr size_t WS_HYT = WS_BC + (size_t)TT * 4 * 8 * 4;
constexpr size_t WS_FILT = WS_HYT + 3ull * 256 * TT * 4;
constexpr size_t WS_HSPEC = WS_FILT + 2ull * 256 * (512 + 4096) * 4;
constexpr size_t WS_ROPE = WS_HSPEC + 2ull * 256 * (512 + 4096) * 8;
constexpr size_t WS_WTL = WS_ROPE + 8192;
constexpr size_t WS_END = WS_WTL + 4ull * 256 * 384 * 2;
constexpr size_t WS_Q  = WS_H;
constexpr size_t WS_KC = WS_Q + (size_t)TT * 512 * 2;
constexpr size_t WS_VC = WS_KC + 16ull * 256 * 512 * 2;
constexpr size_t WS_YS = WS_U;
constexpr size_t WS_YC = WS_U + 2ull * TT * 256 * 4;
constexpr size_t WS_F  = WS_U;
constexpr size_t WS_A  = WS_RW;
static_assert(WS_VC + 16ull * 256 * 512 * 2 <= WS_U, "alias");
static_assert(WS_YC + 256ull * TT * 4 <= WS_MIXCAT, "alias");
static_assert((size_t)TT * 4096 * 2 <= (size_t)TT * 4 * 9 * 64 * 4, "alias");

constexpr size_t OUT_STATE = 12582912, OUT_CK = 14680064, OUT_CV = 23068672;

struct Params {
  const float* in[43];
  float* out;
  unsigned char* ws;
};

DI u16 f2bf(float x) { unsigned u = __float_as_uint(x); u += 0x7fffu + ((u >> 16) & 1u); return (u16)(u >> 16); }
DI float bf2f(u16 b) { return __uint_as_float(((unsigned)b) << 16); }
DI unsigned pack2(float a, float b) { return (unsigned)f2bf(a) | ((unsigned)f2bf(b) << 16); }
template <int CTRL> DI float dppf(float x) {
  return __builtin_bit_cast(float, __builtin_amdgcn_update_dpp(0, __builtin_bit_cast(int, x), CTRL, 0xF, 0xF, true));
}
DI float allreduce16(float x) {
  x += dppf<0xB1>(x); x += dppf<0x4E>(x); x += dppf<0x124>(x); x += dppf<0x128>(x);
  return x;
}
DI float wave_sum(float v) {
  v = allreduce16(v);
  const int iv = __builtin_bit_cast(int, v);
  const float a = __builtin_bit_cast(float, __builtin_amdgcn_readlane(iv, 0)), b = __builtin_bit_cast(float, __builtin_amdgcn_readlane(iv, 16));
  const float c = __builtin_bit_cast(float, __builtin_amdgcn_readlane(iv, 32)), d = __builtin_bit_cast(float, __builtin_amdgcn_readlane(iv, 48));
  return (a + b) + (c + d);
}
DI void seq_of(int row, int& s, int& t, int& L, int& row0) {
  if (row < 4096) { s = row >> 8; t = row & 255; L = 256; row0 = s * 256; }
  else { int r = row - 4096; s = 16 + (r >> 11); t = r & 2047; L = 2048; row0 = 4096 + (r >> 11) * 2048; }
}
DI unsigned cvtpk(float lo, float hi) { unsigned r; asm volatile("v_cvt_pk_bf16_f32 %0, %1, %2" : "=v"(r) : "v"(lo), "v"(hi)); return r; }
DI float ozero() { float z; asm volatile("v_mov_b32 %0, 0" : "=v"(z)); return z; }
DI float shfl32(float v, int lane) { return __builtin_bit_cast(float, __builtin_amdgcn_ds_bpermute((lane ^ 32) << 2, __builtin_bit_cast(int, v))); }
typedef unsigned u32x4_t __attribute__((ext_vector_type(4)));
DI uint4 ldnt_u4(const void* p) { const u32x4_t t = __builtin_nontemporal_load((const u32x4_t*)p); return make_uint4(t[0], t[1], t[2], t[3]); }
DI float4 ldnt_f4(const float* p) { const f32x4 t = __builtin_nontemporal_load((const f32x4*)p); return make_float4(t[0], t[1], t[2], t[3]); }
DI int otid() { int t = threadIdx.x; asm volatile("" : "+v"(t)); return t; }
DI float sigmoidf_(float x) { return 1.f / (1.f + expf(-x)); }
DI float fexp(float x) { return __builtin_amdgcn_exp2f(x * 1.4426950408889634f); }
DI float fsig(float x) { return __builtin_amdgcn_rcpf(1.f + fexp(-x)); }


#define XB_TMO      128
#define XB_XCNT(j)  (256  + 64 * (j))
#define XB_XSUB(j)  (1280 + 64 * (j))
#define XB_XGEN(j)  (2304 + 64 * (j))
#define XB_TOP      3328
#define XB_TOPGEN   3392
#define XB_SPIN_CAP (1u << 22)
#define LAS __attribute__((address_space(3)))
DI unsigned xb_ld(unsigned* p)              { return __hip_atomic_load(p, __ATOMIC_RELAXED, __HIP_MEMORY_SCOPE_AGENT); }
DI unsigned xb_add(unsigned* p, unsigned v) { return __hip_atomic_fetch_add(p, v, __ATOMIC_RELAXED, __HIP_MEMORY_SCOPE_AGENT); }
DI unsigned xb_xcc_id() { return (unsigned)__builtin_amdgcn_s_getreg((3 << 11) | 20) & 0xFu; }
#define XB_SPIN(cond, bar) do { unsigned _sp = 0; while (cond) { __builtin_amdgcn_s_sleep(1); \
    if ((++_sp & 255u) == 0u) { if (xb_ld(&(bar)[XB_TMO])) break; if (_sp > XB_SPIN_CAP) { atomicAdd(&(bar)[XB_TMO], 1u); break; } } } } while (0)
struct XcdBarrier { unsigned* bar; unsigned x; volatile LAS unsigned* st; };
DI XcdBarrier xcd_barrier_post(unsigned* bar, volatile LAS unsigned* st) {
  XcdBarrier b; b.bar = bar; b.x = xb_xcc_id(); b.st = st;
  if (threadIdx.x == 0) (void)xb_add(&bar[XB_XCNT(b.x)], 1u);
  return b;
}
DI void xcd_barrier_complete(unsigned* bar, unsigned x, unsigned& nloc, unsigned& nx) {
  const unsigned G = gridDim.x * gridDim.y * gridDim.z;
  unsigned sum, cnt, mine, sp = 0u;
  for (;;) {
    sum = 0u; cnt = 0u; mine = 0u;
#pragma unroll
    for (unsigned j = 0; j < 16; ++j) { const unsigned c = xb_ld(&bar[XB_XCNT(j)]); sum += c; cnt += (c > 0u) ? 1u : 0u; mine = (j == x) ? c : mine; }
    if (sum == G) break;
    __builtin_amdgcn_s_sleep(1);
    if ((++sp & 255u) == 0u) { if (xb_ld(&bar[XB_TMO])) break; if (sp > XB_SPIN_CAP) { atomicAdd(&bar[XB_TMO], 1u); break; } }
  }
  nloc = mine > 0u ? mine : 1u; nx = cnt > 0u ? cnt : 1u;
}
DI void xcd_barrier(const XcdBarrier& b) {
  asm volatile("s_waitcnt vmcnt(0)" ::: "memory");
  __syncthreads();
  if (threadIdx.x == 0) {
    unsigned* bar = b.bar;
    __builtin_amdgcn_s_waitcnt(0);
    unsigned nloc = b.st[0], nx = b.st[1];
    if (nloc == 0u) { xcd_barrier_complete(bar, b.x, nloc, nx); b.st[0] = nloc; b.st[1] = nx; }
    const unsigned old = xb_add(&bar[XB_XSUB(b.x)], 1u);
    const unsigned gen = old / nloc;
    if (old + 1u == (gen + 1u) * nloc) {
      __builtin_amdgcn_fence(__ATOMIC_RELEASE, "agent");
      asm volatile("s_waitcnt vmcnt(0)" ::: "memory");
      const unsigned og = xb_add(&bar[XB_TOP], 1u);
      const unsigned tg = og / nx;
      if (og + 1u == (tg + 1u) * nx) xb_add(&bar[XB_TOPGEN], 1u);
      else XB_SPIN(xb_ld(&bar[XB_TOPGEN]) == tg, bar);
      __builtin_amdgcn_fence(__ATOMIC_ACQUIRE, "agent");
      xb_add(&bar[XB_XGEN(b.x)], 1u);
      asm volatile("s_waitcnt vmcnt(0)" ::: "memory");
    } else {
      XB_SPIN(xb_ld(&bar[XB_XGEN(b.x)]) == gen, bar);
      __builtin_amdgcn_fence(__ATOMIC_ACQUIRE, "agent");
      asm volatile("s_waitcnt vmcnt(0)" ::: "memory");
    }
  }
  __syncthreads();
}

DI void tr_tile(const float* __restrict__ W, int K, int N, u16* __restrict__ Wt, int k0, int n0, float* lds) {
  const int tid = otid();
  float4 v[4];
#pragma unroll
  for (int i = 0; i < 4; ++i) { int idx = tid + i * 512; int kk = idx >> 5, n4 = (idx & 31) * 4; const f32x4 t_ = __builtin_nontemporal_load((const f32x4*)(W + (size_t)(k0 + kk) * N + n0 + n4)); v[i] = make_float4(t_[0], t_[1], t_[2], t_[3]); }
#pragma unroll
  for (int i = 0; i < 4; ++i) { int idx = tid + i * 512; int kk = idx >> 5, n4 = (idx & 31) * 4; float* d = lds + kk * 129 + n4; d[0] = v[i].x; d[1] = v[i].y; d[2] = v[i].z; d[3] = v[i].w; }
  __syncthreads();
#pragma unroll
  for (int hlf = 0; hlf < 2; ++hlf) {
    const int n = hlf * 64 + (tid >> 3), kg = tid & 7;
    unsigned pk[4];
#pragma unroll
    for (int j = 0; j < 4; ++j) pk[j] = pack2(lds[(kg * 8 + 2 * j) * 129 + n], lds[(kg * 8 + 2 * j + 1) * 129 + n]);
    { const u32x4_t t_ = {pk[0], pk[1], pk[2], pk[3]}; __builtin_nontemporal_store(t_, (u32x4_t*)(Wt + (size_t)(n0 + n) * K + k0 + kg * 8)); }
  }
  __syncthreads();
}

DI void filt_item(const Params& p, int l, int it, float* lds) {
  const int Lsel = it >= 32; const int chunk = Lsel ? it - 32 : it; const int L = Lsel ? 2048 : 256;
  float* emb = lds; float* h1 = lds + 8 * 36; float* h2 = h1 + 512;
  const int tid = otid();
  const float* w1 = p.in[32] + l * 33 * 64; const float* b1 = p.in[33] + l * 64; const float* fr = p.in[34] + l * 64;
  const float* w2 = p.in[35] + l * 4096; const float* b2 = p.in[36] + l * 64; const float* w3 = p.in[37] + (size_t)l * 64 * 1024;
  const float* dec = p.in[38] + l * 256;
  if (tid < 8 * 33) {
    int ti = tid / 33, j = tid % 33; int i = chunk * 8 + ti; float v;
    float ang = (float)(2.0 * 3.14159265358979323846 / (double)L) * (float)i;
    if (j == 0) v = (float)i / (float)(L - 1);
    else if (j <= 16) { float band = 1e-4f + (float)(j - 1) * ((15.f - 1e-4f) / 15.f); v = cosf(band * ang); }
    else { float band = 1e-4f + (float)(j - 17) * ((15.f - 1e-4f) / 15.f); v = -sinf(band * ang); }
    emb[ti * 36 + j] = v;
  }
  __syncthreads();
  { int ti = tid >> 6, j = tid & 63; float a = b1[j];
    for (int k = 0; k < 32; k += 4) { const float q0 = w1[k * 64 + j], q1 = w1[(k + 1) * 64 + j], q2 = w1[(k + 2) * 64 + j], q3 = w1[(k + 3) * 64 + j];
      a += emb[ti * 36 + k] * q0 + emb[ti * 36 + k + 1] * q1 + emb[ti * 36 + k + 2] * q2 + emb[ti * 36 + k + 3] * q3; }
    a += emb[ti * 36 + 32] * w1[32 * 64 + j];
    h1[ti * 64 + j] = sinf(fr[j] * a); }
  __syncthreads();
  { int ti = tid >> 6, j = tid & 63; float a = b2[j];
#pragma unroll 2
    for (int k = 0; k < 64; k += 4) { const float q0 = w2[k * 64 + j], q1 = w2[(k + 1) * 64 + j], q2 = w2[(k + 2) * 64 + j], q3 = w2[(k + 3) * 64 + j];
      const float4 hv = *(const float4*)(h1 + ti * 64 + k); a += hv.x * q0 + hv.y * q1 + hv.z * q2 + hv.w * q3; }
    h2[ti * 64 + j] = sinf(fr[j] * a); }
  __syncthreads();
  float* FILT = (float*)(p.ws + WS_FILT) + (Lsel ? 262144 : 0);
  {
    float acc[2][8];
#pragma unroll
    for (int ti = 0; ti < 8; ++ti) { acc[0][ti] = 0.f; acc[1][ti] = 0.f; }
#pragma unroll 2
    for (int k = 0; k < 64; k += 4) {
      const float2 q0 = *(const float2*)(w3 + k * 1024 + 2 * tid), q1 = *(const float2*)(w3 + (k + 1) * 1024 + 2 * tid);
      const float2 q2 = *(const float2*)(w3 + (k + 2) * 1024 + 2 * tid), q3 = *(const float2*)(w3 + (k + 3) * 1024 + 2 * tid);
#pragma unroll
      for (int ti = 0; ti < 8; ++ti) { const float4 hv = *(const float4*)(h2 + ti * 64 + k);
        acc[0][ti] += hv.x * q0.x + hv.y * q1.x + hv.z * q2.x + hv.w * q3.x;
        acc[1][ti] += hv.x * q0.y + hv.y * q1.y + hv.z * q2.y + hv.w * q3.y; }
    }
#pragma unroll
    for (int cc = 0; cc < 2; ++cc) {
      const int col = 2 * tid + cc;
      int order = col >> 9, dir = (col >> 8) & 1, c = col & 255; float dc = fabsf(dec[c]);
      float* g = FILT + (size_t)(order * 256 + c) * (2 * L);
#pragma unroll
      for (int ti = 0; ti < 8; ++ti) {
        int i = chunk * 8 + ti; float t = (float)i / (float)(L - 1); float val = acc[cc][ti] * expf(-t * dc);
        if (dir == 0) g[L + i] = val; else { if (i == 0) g[0] = 0.f; else g[L - i] = val; }
      }
    }
  }
  __syncthreads();
}

constexpr int AUX_ITEMS = 432 + 128 + 512 + 512 + 1 + 288;
DI void aux_item(const Params& p, int l, int it, float* lds) {
  unsigned char* slot = p.ws + WS_W + (size_t)(l & 1) * W_SLOT;
  u16* win = (u16*)slot; u16* wout = (u16*)(slot + W_IN_B); u16* wff1 = (u16*)(slot + W_IN_B + W_OUT_B); u16* wff2 = (u16*)(slot + W_IN_B + W_OUT_B + W_FF_B);
  if (it < 432) { int kt = it / 27, nt = it % 27; tr_tile(p.in[13] + (size_t)l * 1024 * NU, 1024, NU, win, kt * 64, nt * 128, lds); return; }
  it -= 432;
  if (it < 128) { int kt = it >> 3, nt = it & 7; tr_tile(p.in[40] + (size_t)l * 1024 * 1024, 1024, 1024, wout, kt * 64, nt * 128, lds); return; }
  it -= 128;
  if (it < 512) { int kt = it >> 5, nt = it & 31; tr_tile(p.in[41] + (size_t)l * 1024 * 4096, 1024, 4096, wff1, kt * 64, nt * 128, lds); return; }
  it -= 512;
  if (it < 512) { int kt = it >> 3, nt = it & 7; tr_tile(p.in[42] + (size_t)l * 4096 * 1024, 4096, 1024, wff2, kt * 64, nt * 128, lds); return; }
  it -= 512;
  if (it < 1) { uint4* z = (uint4*)(win + (size_t)NU * 1024); for (int i = otid(); i < 16384; i += 512) z[i] = make_uint4(0, 0, 0, 0); return; }
  it -= 1;
  filt_item(p, l, it, lds);
}

DI void mod_item(const Params& p, int it, float* lds) {
  const int l = it / 96, cgp = it % 96, tid = otid();
  float* sc = lds; float* red = lds + 5120;
  for (int i = tid; i < 5120; i += 512) { int j = i >> 10, k = i & 1023; float c = (j == 0) ? p.in[6][k] : p.in[5][(j - 1) * 1024 + k]; sc[i] = c / (1.f + expf(-c)); }
  __syncthreads();
  const int c4 = (tid & 15) * 4, kg = tid >> 4; const float* w = p.in[7] + (size_t)l * 1024 * 6144 + cgp * 64 + c4;
  float4 acc[5];
#pragma unroll
  for (int j = 0; j < 5; ++j) acc[j] = make_float4(0.f, 0.f, 0.f, 0.f);
#pragma unroll 8
  for (int k = kg; k < 1024; k += 32) { const f32x4 wt_ = __builtin_nontemporal_load((const f32x4*)(w + (size_t)k * 6144)); const float4 wv = make_float4(wt_[0], wt_[1], wt_[2], wt_[3]);
#pragma unroll
    for (int j = 0; j < 5; ++j) { const float sv = sc[j * 1024 + k]; acc[j].x += sv * wv.x; acc[j].y += sv * wv.y; acc[j].z += sv * wv.z; acc[j].w += sv * wv.w; } }
#pragma unroll
  for (int j = 0; j < 5; ++j) *(float4*)(red + (kg * 5 + j) * 64 + c4) = acc[j];
  __syncthreads();
  if (tid < 320) { int j = tid >> 6, cc = tid & 63; float sm = 0.f; for (int g = 0; g < 32; ++g) sm += red[(g * 5 + j) * 64 + cc];
    sm += p.in[8][l * 6144 + cgp * 64 + cc]; ((float*)(p.ws + WS_MOD))[(l * 5 + j) * 6144 + cgp * 64 + cc] = sm; }
  __syncthreads();
}

DI void row_phase(const Params& p, int l, int mode) {
  const int tid = otid(), lane = tid & 63; const int gw = blockIdx.x * 8 + (tid >> 6), nw = gridDim.x * 8;
  float* x = p.out; const u16* F = (const u16*)(p.ws + WS_F); u16* H = (u16*)(p.ws + WS_H); const float* MOD = (const float*)(p.ws + WS_MOD);
  const float* gpost = nullptr; const float* gpre = nullptr; int gate_ch = 0, sc_ch = 0, sh_ch = 0, lm = l; bool do_h = true;
  if (mode == 0) { gpre = p.in[9] + l * 1024; sc_ch = 1; sh_ch = 0; lm = l; }
  else if (mode == 1) { gpost = p.in[10] + l * 1024; gate_ch = 2; gpre = p.in[11] + l * 1024; sc_ch = 4; sh_ch = 3; lm = l; }
  else { gpost = p.in[12] + l * 1024; gate_ch = 5; if (l < 3) { gpre = p.in[9] + (l + 1) * 1024; sc_ch = 1; sh_ch = 0; lm = l + 1; } else do_h = false; }
  const int rpw = (TT + nw - 1) / nw;
  float4 fa[4], fb[4], fc[4]; int jprev = -1;
#pragma unroll
  for (int i = 0; i < 4; ++i) { fa[i] = make_float4(0.f, 0.f, 0.f, 0.f); fb[i] = fa[i]; fc[i] = fa[i]; }
  for (int rr = 0; rr < rpw; ++rr) {
    const int row = gw * rpw + rr; if (row >= TT) break;
    const int j = row < 4096 ? 0 : 1 + ((row - 4096) >> 11);
    if (j != jprev) {
      jprev = j;
#pragma unroll
      for (int i = 0; i < 4; ++i) {
        const int col = i * 256 + lane * 4;
        if (mode != 0) { const float4 g4 = *(const float4*)(MOD + (l * 5 + j) * 6144 + gate_ch * 1024 + col); const float4 p4 = *(const float4*)(gpost + col);
          fa[i] = make_float4(g4.x * p4.x, g4.y * p4.y, g4.z * p4.z, g4.w * p4.w); }
        if (do_h) { const float4 g4 = *(const float4*)(gpre + col); const float4 s4 = *(const float4*)(MOD + (lm * 5 + j) * 6144 + sc_ch * 1024 + col);
          fb[i] = make_float4(g4.x * (1.f + s4.x), g4.y * (1.f + s4.y), g4.z * (1.f + s4.z), g4.w * (1.f + s4.w));
          fc[i] = *(const float4*)(MOD + (lm * 5 + j) * 6144 + sh_ch * 1024 + col); }
      }
    }
    const float* xs = (mode == 0) ? (row < 4096 ? p.in[0] + (size_t)row * 1024 : p.in[1] + (size_t)(row - 4096) * 1024) : x + (size_t)row * 1024;
    float4 xv[4];
#pragma unroll
    for (int i = 0; i < 4; ++i) xv[i] = ldnt_f4(xs + i * 256 + lane * 4);
    if (mode != 0) {
      float4 dv[4]; float ss = 0.f;
#pragma unroll
      for (int i = 0; i < 4; ++i) { const unsigned long long fq_ = __builtin_nontemporal_load((const unsigned long long*)(F + (size_t)row * 1024 + i * 256 + lane * 4)); const uint2 fw = make_uint2((unsigned)fq_, (unsigned)(fq_ >> 32)); dv[i] = make_float4(bf2f((u16)fw.x), bf2f((u16)(fw.x >> 16)), bf2f((u16)fw.y), bf2f((u16)(fw.y >> 16))); ss += dv[i].x * dv[i].x + dv[i].y * dv[i].y + dv[i].z * dv[i].z + dv[i].w * dv[i].w; }
      ss = wave_sum(ss); const float rs = rsqrtf(ss * (1.f / 1024.f) + 1e-6f);
#pragma unroll
      for (int i = 0; i < 4; ++i) { xv[i].x += fa[i].x * dv[i].x * rs; xv[i].y += fa[i].y * dv[i].y * rs; xv[i].z += fa[i].z * dv[i].z * rs; xv[i].w += fa[i].w * dv[i].w * rs; }
    }
#pragma unroll
    for (int i = 0; i < 4; ++i) { const f32x4 t_ = {xv[i].x, xv[i].y, xv[i].z, xv[i].w}; __builtin_nontemporal_store(t_, (f32x4*)(x + (size_t)row * 1024 + i * 256 + lane * 4)); }
    if (do_h) {
      float ss = 0.f;
#pragma unroll
      for (int i = 0; i < 4; ++i) ss += xv[i].x * xv[i].x + xv[i].y * xv[i].y + xv[i].z * xv[i].z + xv[i].w * xv[i].w;
      ss = wave_sum(ss); const float rs = rsqrtf(ss * (1.f / 1024.f) + 1e-6f);
#pragma unroll
      for (int i = 0; i < 4; ++i) { const int col = i * 256 + lane * 4;
        const float a = xv[i].x * rs * fb[i].x + fc[i].x, b2 = xv[i].y * rs * fb[i].y + fc[i].y, c = xv[i].z * rs * fb[i].z + fc[i].z, d = xv[i].w * rs * fb[i].w + fc[i].w;
        *(uint2*)(H + (size_t)row * 1024 + col) = make_uint2(pack2(a, b2), pack2(c, d)); }
    }
  }
}

template <int EPI>
DI void gemm_phase(const Params& p, const u16* __restrict__ A, const u16* __restrict__ Wt, int K, int NTn, int l, void* Cout, int ldc, unsigned char* smem) {
  u16* As = (u16*)smem; u16* Bs = As + 2 * 128 * 72;
  const int tid = otid(), lane = tid & 63, wid = tid >> 6, wm = wid & 1, wn = wid >> 1, fr = lane & 15, fq = lane >> 4;
  const int ntiles = 96 * NTn, nk = K / 64;
  for (int tile = blockIdx.x; tile < ntiles; tile += gridDim.x) {
    const int mt = tile / NTn, nt = tile % NTn; const int m0 = mt * 128, n0 = nt * 256;
    f32x4 acc[4][4];
#pragma unroll
    for (int i = 0; i < 4; ++i)
#pragma unroll
      for (int j = 0; j < 4; ++j) acc[i][j] = f32x4{0.f, 0.f, 0.f, 0.f};
    uint4 pa0, pa1, pb0, pb1, pb2, pb3, qa0, qa1, qb0, qb1, qb2, qb3;
    const int lrow = tid >> 3, lkc = tid & 7;
    const u16* ag = A + (size_t)(m0 + lrow) * K + lkc * 8;
    const u16* bg = Wt + (size_t)(n0 + lrow) * K + lkc * 8;
#define GLOAD(P, kt) { P##a0 = *(const uint4*)(ag + (kt) * 64); P##a1 = *(const uint4*)(ag + (size_t)64 * K + (kt) * 64); \
      P##b0 = *(const uint4*)(bg + (kt) * 64); P##b1 = *(const uint4*)(bg + (size_t)64 * K + (kt) * 64); \
      P##b2 = *(const uint4*)(bg + (size_t)128 * K + (kt) * 64); P##b3 = *(const uint4*)(bg + (size_t)192 * K + (kt) * 64); }
#define SSTORE(P, buf) { u16* sa_ = As + (buf) * 128 * 72 + lrow * 72 + lkc * 8; u16* sb_ = Bs + (buf) * 256 * 72 + lrow * 72 + lkc * 8; \
      *(uint4*)sa_ = P##a0; *(uint4*)(sa_ + 64 * 72) = P##a1; *(uint4*)sb_ = P##b0; *(uint4*)(sb_ + 64 * 72) = P##b1; *(uint4*)(sb_ + 128 * 72) = P##b2; *(uint4*)(sb_ + 192 * 72) = P##b3; }
#define COMPUTE(buf) { const u16* as = As + (buf) * 128 * 72 + (wm * 64 + fr) * 72 + fq * 8; const u16* bs = Bs + (buf) * 256 * 72 + (wn * 64 + fr) * 72 + fq * 8; \
      _Pragma("unroll") for (int ks = 0; ks < 2; ++ks) { bf16x8 wf[4], af[4]; \
        _Pragma("unroll") for (int i = 0; i < 4; ++i) { wf[i] = *(const bf16x8*)(bs + i * 16 * 72 + ks * 32); af[i] = *(const bf16x8*)(as + i * 16 * 72 + ks * 32); } \
        _Pragma("unroll") for (int i = 0; i < 4; ++i) _Pragma("unroll") for (int j = 0; j < 4; ++j) acc[i][j] = __builtin_amdgcn_mfma_f32_16x16x32_bf16(wf[i], af[j], acc[i][j], 0, 0, 0); } }
    GLOAD(p, 0); SSTORE(p, 0);
    GLOAD(p, 1); GLOAD(q, 2);
    __syncthreads();
    for (int kt = 0; kt < nk; kt += 2) {
      SSTORE(p, 1);
      if (kt + 3 < nk) GLOAD(p, kt + 3);
      COMPUTE(0);
      __syncthreads();
      if (kt + 2 < nk) SSTORE(q, 0);
      if (kt + 4 < nk) GLOAD(q, kt + 4);
      COMPUTE(1);
      __syncthreads();
    }
#undef GLOAD
#undef SSTORE
#undef COMPUTE
#pragma unroll
    for (int i = 0; i < 4; ++i)
#pragma unroll
      for (int j = 0; j < 4; ++j) {
        const int row = m0 + wm * 64 + j * 16 + fr; const int col = n0 + wn * 64 + i * 16 + fq * 4; const f32x4 v = acc[i][j];
        if (EPI == 0) {
          if (col < NU) {
            *(uint2*)((u16*)Cout + (size_t)row * NU + col) = make_uint2(pack2(v[0], v[1]), pack2(v[2], v[3]));
            if (row < 4096 && col >= 1664 && col < 2688) {
              int b = row >> 8, t = row & 255;
              float* dst = (col < 2176) ? p.out + OUT_CK + ((size_t)((b * 4 + l) * 256 + t)) * 512 + (col - 1664)
                                        : p.out + OUT_CV + ((size_t)((b * 4 + l) * 256 + t)) * 512 + (col - 2176);
              *(float4*)dst = make_float4(v[0], v[1], v[2], v[3]);
            }
          }
        } else if (EPI == 1) {
          *(float4*)((float*)Cout + (size_t)row * ldc + col) = make_float4(v[0], v[1], v[2], v[3]);
        } else {
          float a = fmaxf(v[0], 0.f), b = fmaxf(v[1], 0.f), c = fmaxf(v[2], 0.f), d = fmaxf(v[3], 0.f);
          *(uint2*)((u16*)Cout + (size_t)row * ldc + col) = make_uint2(pack2(a * a, b * b), pack2(c * c, d * d));
        }
      }
  }
}

namespace pg8 {
#define PG8_LAS __attribute__((address_space(3)))
typedef unsigned short bf16_t;
typedef short bf16x8 __attribute__((ext_vector_type(8)));
typedef float f32x4 __attribute__((ext_vector_type(4)));
typedef unsigned u32x4 __attribute__((ext_vector_type(4)));
constexpr int BM = 256, BK = 64, HALF = 128, HTB = HALF * BK * 2  , STAGE_BYTES = 8 * HTB, NXCD = 8, WGM = 8;

__host__ __device__ __forceinline__ int lds_byte(int r, int c) { const int st = (r >> 4) * 2 + (c >> 5), rr = r & 15, cc = c & 31, ob = rr * 64 + cc * 2; return st * 1024 + (ob ^ (((ob >> 9) & 1) << 5)); }
__host__ __device__ __forceinline__ void stage_rc(int b, int& R, int& C) { const int st = b / 1024, sb = b % 1024, swz = sb ^ (((sb >> 9) & 1) << 5); R = (st >> 1) * 16 + swz / 64; C = (st & 1) * 32 + (swz % 64) / 2; }
__host__ __device__ __forceinline__ int perm32(int rho) { const int n = rho >> 4, i = rho & 15; return 8 * (i >> 2) + 4 * n + (i & 3); }

struct Unit { int pm, pn; };
struct Gemm { const bf16_t* A; const bf16_t* Bt; int M, N, K; };
struct StaticOrder {
    int nM, nN, nwg, G, c;
    __host__ __device__ void init(int M, int N, int G_, int c_) { nM = M / BM; nN = N / BM; nwg = nM * nN; G = G_; c = c_; }
    __host__ __device__ bool next(int i, Unit& u) const {
        const long L = (long)i * G + c; if (L >= nwg) return false;
        int wgid = (int)L; { const int q = nwg / NXCD, r = nwg % NXCD, xcd = wgid % NXCD, off = wgid / NXCD; wgid = (xcd < r ? xcd * (q + 1) : r * (q + 1) + (xcd - r) * q) + off; }
        const int nig = WGM * nN, gid = wgid / nig, fm = gid * WGM, gsz = (nM - fm) < WGM ? (nM - fm) : WGM;
        u.pm = fm + ((wgid % nig) % gsz); u.pn = (wgid % nig) / gsz; return true;
    }
    __device__ __forceinline__ void a_ready(const Unit&) const {}
    __device__ __forceinline__ void done(const Unit&) const {}
};
__device__ __forceinline__ unsigned cvt_pk_bf16(float lo, float hi) { unsigned r; asm volatile("v_cvt_pk_bf16_f32 %0, %1, %2" : "=v"(r) : "v"(lo), "v"(hi)); return r; }
template <class Epi, class Sched, bool STAMP = false>
__device__ __forceinline__ void gemm_phase(PG8_LAS unsigned char* lds, const Gemm g, const Sched& S, const Epi& E, unsigned long long* stamps) {
    const int tid = otid(), wid = __builtin_amdgcn_readfirstlane(tid >> 6), lane = tid & 63, wr = wid >> 2, wc = wid & 3, fr = lane & 15, fq = lane >> 4;
    const int K = g.K, nt = K / BK;
    int ts_lo = 0, ts_hi = 0, nts = 0; const unsigned long long rt_entry = STAMP ? (unsigned long long)wall_clock64() : 0ull;
#define PG8_STAMP() do { if (STAMP && wid == 0 && nts < 64) { const unsigned long long _c = (unsigned long long)clock64(); \
        ts_lo = (lane == nts) ? (int)(unsigned)_c : ts_lo; ts_hi = (lane == nts) ? (int)(unsigned)(_c >> 32) : ts_hi; ++nts; } } while (0)
    PG8_STAMP();
    unsigned voffA[2], voffB[2];
#pragma unroll
    for (int i = 0; i < 2; ++i) { int R, C; stage_rc(tid * 16 + i * 8192, R, C); const int Rb = Epi::PERM ? ((R & ~31) + perm32(R & 31)) : R;
        voffA[i] = (unsigned)(R * K + C) * 2u; voffB[i] = (unsigned)(Rb * K + C) * 2u; }
    const size_t kstep = (size_t)(BK * 2);
    const size_t hstep = (size_t)HALF * K * 2;
    const size_t tstep = 2 * hstep;
    const unsigned ldsw = (unsigned)wid * 1024u;
    const int aoff = lds_byte(wr * 64 + fr, fq * 8), boff = lds_byte(wc * 32 + fr, fq * 8);
#define PG8_SA(b, h) (((b) * 2 + (h)) * HTB)
#define PG8_SB(b, h) ((4 + (b) * 2 + (h)) * HTB)
#define PG8_STAGE(bufoff, gbase, voff) do { _Pragma("unroll") for (int _i = 0; _i < 2; ++_i) \
        __builtin_amdgcn_global_load_lds((const unsigned*)((const char*)(gbase) + (voff)[_i]), (PG8_LAS unsigned*)(lds + (bufoff) + ldsw + _i * 8192), 16, 0, 0); } while (0)
#define PG8_LDA(dst, b, h) do { _Pragma("unroll") for (int m = 0; m < 4; ++m) _Pragma("unroll") for (int k = 0; k < 2; ++k) dst[m][k] = *(const PG8_LAS bf16x8*)(lds + PG8_SA(b, h) + aoff + m * 2048 + k * 1024); } while (0)
#define PG8_LDB(dst, b, h) do { _Pragma("unroll") for (int n = 0; n < 2; ++n) _Pragma("unroll") for (int k = 0; k < 2; ++k) dst[n][k] = *(const PG8_LAS bf16x8*)(lds + PG8_SB(b, h) + boff + n * 2048 + k * 1024); } while (0)
#define PG8_MMA(ai, bj, At, Bt) do { __builtin_amdgcn_s_setprio(1); _Pragma("unroll") for (int m = 0; m < 4; ++m) _Pragma("unroll") for (int n = 0; n < 2; ++n) _Pragma("unroll") for (int k = 0; k < 2; ++k) \
        acc[ai][bj][m][n] = __builtin_amdgcn_mfma_f32_16x16x32_bf16(Bt[n][k], At[m][k], acc[ai][bj][m][n], 0, 0, 0); __builtin_amdgcn_s_setprio(0); } while (0)
#define PG8_WAIT_V(n) asm volatile("s_waitcnt vmcnt(" #n ")" ::: "memory")
#define PG8_WAIT_L(n) asm volatile("s_waitcnt lgkmcnt(" #n ")" ::: "memory")
#define PG8_BAR __builtin_amdgcn_s_barrier()
#define PG8_SCHED __builtin_amdgcn_sched_barrier(0)
    Unit cur, nxt; int ui = 0;
    if (!S.next(0, cur)) return;
    f32x4 acc[2][2][4][2];
#pragma unroll
    for (int a = 0; a < 2; ++a)
#pragma unroll
        for (int b = 0; b < 2; ++b)
#pragma unroll
            for (int m = 0; m < 4; ++m)
#pragma unroll
                for (int n = 0; n < 2; ++n) { const float z_ = ozero(); acc[a][b][m][n] = (f32x4){z_, z_, z_, z_}; }
    bf16x8 At[4][2], B0[2][2], B1[2][2];
    const char* cA = (const char*)g.A + (size_t)cur.pm * tstep; const char* cB = (const char*)g.Bt + (size_t)cur.pn * tstep;
    S.a_ready(cur);
    PG8_STAGE(PG8_SB(0, 0), cB, voffB); PG8_STAGE(PG8_SA(0, 0), cA, voffA); PG8_STAGE(PG8_SB(0, 1), cB + hstep, voffB); PG8_STAGE(PG8_SA(0, 1), cA + hstep, voffA);
    if (wr == 1) PG8_BAR;
    PG8_WAIT_V(4); PG8_BAR;
    PG8_STAGE(PG8_SB(1, 0), cB + kstep, voffB); PG8_STAGE(PG8_SA(1, 0), cA + kstep, voffA); PG8_STAGE(PG8_SB(1, 1), cB + hstep + kstep, voffB);
    PG8_WAIT_V(6); PG8_BAR;
    PG8_STAMP();
    for (;;) {
        const bool has_next = S.next(ui + 1, nxt);
        const char* nA = has_next ? (const char*)g.A + (size_t)nxt.pm * tstep : cA; const char* nB = has_next ? (const char*)g.Bt + (size_t)nxt.pn * tstep : cB;
        for (int t = 0; t < nt; t += 2) {
            const bool last = (t == nt - 2);
            const char* a1 = cA + (size_t)(t + 1) * kstep;
            const char* a2 = last ? nA : cA + (size_t)(t + 2) * kstep; const char* b2 = last ? nB : cB + (size_t)(t + 2) * kstep;
            const char* a3 = a2 + kstep; const char* b3 = b2 + kstep;
            if (last && has_next) S.a_ready(nxt);
            PG8_LDB(B0, 0, 0); PG8_SCHED; PG8_LDA(At, 0, 0); PG8_STAGE(PG8_SA(1, 1), a1 + hstep, voffA);
            PG8_WAIT_L(8); PG8_BAR; PG8_WAIT_L(0); PG8_MMA(0, 0, At, B0); PG8_BAR; PG8_SCHED;
            PG8_LDB(B1, 0, 1); PG8_STAGE(PG8_SB(0, 0), b2, voffB);
            PG8_BAR; PG8_WAIT_L(0); PG8_MMA(0, 1, At, B1); PG8_BAR;
            PG8_LDA(At, 0, 1); PG8_STAGE(PG8_SA(0, 0), a2, voffA);
            PG8_BAR; PG8_WAIT_L(0); PG8_MMA(1, 0, At, B0); PG8_BAR; PG8_SCHED;
            PG8_STAGE(PG8_SB(0, 1), b2 + hstep, voffB);
            PG8_WAIT_V(6); PG8_BAR; PG8_MMA(1, 1, At, B1); PG8_BAR;
            PG8_LDB(B0, 1, 0); PG8_SCHED; PG8_LDA(At, 1, 0); PG8_STAGE(PG8_SA(0, 1), a2 + hstep, voffA);
            PG8_WAIT_L(8); PG8_BAR; PG8_WAIT_L(0); PG8_MMA(0, 0, At, B0); PG8_BAR; PG8_SCHED;
            PG8_LDB(B1, 1, 1); PG8_STAGE(PG8_SB(1, 0), b3, voffB);
            PG8_BAR; PG8_WAIT_L(0); PG8_MMA(0, 1, At, B1); PG8_BAR;
            PG8_LDA(At, 1, 1); PG8_STAGE(PG8_SA(1, 0), a3, voffA);
            PG8_BAR; PG8_WAIT_L(0); PG8_MMA(1, 0, At, B0); PG8_BAR; PG8_SCHED;
            PG8_STAGE(PG8_SB(1, 1), b3 + hstep, voffB);
            PG8_WAIT_V(6); PG8_BAR; PG8_MMA(1, 1, At, B1); PG8_BAR;
        }
        PG8_STAMP();
        if constexpr (!Epi::AFTER_DRAIN) { E(acc, cur, wr, wc, fr, fq); S.done(cur); }
        PG8_STAMP();
        if (!has_next) break;
#pragma unroll
        for (int a = 0; a < 2; ++a)
#pragma unroll
            for (int b = 0; b < 2; ++b)
#pragma unroll
                for (int m = 0; m < 4; ++m)
#pragma unroll
                    for (int n = 0; n < 2; ++n) { const float z_ = ozero(); acc[a][b][m][n] = (f32x4){z_, z_, z_, z_}; }
        cur = nxt; cA = nA; cB = nB; ++ui;
    }
    PG8_WAIT_V(0);
    if (wr == 0) PG8_BAR;
    PG8_BAR;
    if constexpr (Epi::AFTER_DRAIN) { E.fused(acc, cur, wr, wc, fr, fq, lds, wid, lane); S.done(cur); }
    PG8_STAMP();
    if (STAMP && wid == 0) { stamps[lane] = lane < nts ? (((unsigned long long)(unsigned)ts_hi << 32) | (unsigned)ts_lo) : 0ull;
        if (lane == 62) stamps[62] = rt_entry; if (lane == 63) stamps[63] = (unsigned long long)wall_clock64(); }
#undef PG8_STAMP
#undef PG8_SA
#undef PG8_SB
#undef PG8_STAGE
#undef PG8_LDA
#undef PG8_LDB
#undef PG8_MMA
#undef PG8_WAIT_V
#undef PG8_WAIT_L
#undef PG8_BAR
#undef PG8_SCHED
}

struct EpiF32 {
    static constexpr bool PERM = false, AFTER_DRAIN = false;
    float* C; int ldc;
    __device__ __forceinline__ void operator()(const f32x4 (&acc)[2][2][4][2], const Unit& u, int wr, int wc, int fr, int fq) const {
        const int row0 = u.pm * BM + wr * 64 + fr, col0 = u.pn * BM + wc * 32 + 4 * fq;
#pragma unroll
        for (int ai = 0; ai < 2; ++ai)
#pragma unroll
            for (int m = 0; m < 4; ++m) { float* rowp = C + (size_t)(row0 + ai * HALF + m * 16) * ldc + col0;
#pragma unroll
                for (int bj = 0; bj < 2; ++bj)
#pragma unroll
                    for (int n = 0; n < 2; ++n) *(f32x4*)(rowp + bj * HALF + n * 16) = acc[ai][bj][m][n]; }
    }
};
struct EpiBf {
    static constexpr bool PERM = true, AFTER_DRAIN = false;
    bf16_t* O; int ldc;
    __device__ __forceinline__ void operator()(const f32x4 (&acc)[2][2][4][2], const Unit& u, int wr, int wc, int fr, int fq) const {
        const int row0 = u.pm * BM + wr * 64 + fr, col0 = u.pn * BM + wc * 32 + 8 * fq;
#pragma unroll
        for (int ai = 0; ai < 2; ++ai)
#pragma unroll
            for (int m = 0; m < 4; ++m) { bf16_t* rowp = O + (size_t)(row0 + ai * HALF + m * 16) * ldc + col0;
#pragma unroll
                for (int bj = 0; bj < 2; ++bj) { const f32x4 v0 = acc[ai][bj][m][0], v1 = acc[ai][bj][m][1];
                    u32x4 w; w.x = cvt_pk_bf16(v0[0], v0[1]); w.y = cvt_pk_bf16(v0[2], v0[3]); w.z = cvt_pk_bf16(v1[0], v1[1]); w.w = cvt_pk_bf16(v1[2], v1[3]);
                    *(u32x4*)(rowp + bj * HALF) = w; } }
    }
};
struct EpiRelu2 {
    static constexpr bool PERM = true, AFTER_DRAIN = false;
    bf16_t* O; int ldc;
    __device__ __forceinline__ void operator()(const f32x4 (&acc)[2][2][4][2], const Unit& u, int wr, int wc, int fr, int fq) const {
        const int row0 = u.pm * BM + wr * 64 + fr, col0 = u.pn * BM + wc * 32 + 8 * fq;
#pragma unroll
        for (int ai = 0; ai < 2; ++ai)
#pragma unroll
            for (int m = 0; m < 4; ++m) { bf16_t* rowp = O + (size_t)(row0 + ai * HALF + m * 16) * ldc + col0;
#pragma unroll
                for (int bj = 0; bj < 2; ++bj) { f32x4 v0 = acc[ai][bj][m][0], v1 = acc[ai][bj][m][1];
#pragma unroll
                    for (int j = 0; j < 4; ++j) { float a = fmaxf(v0[j], 0.f), b = fmaxf(v1[j], 0.f); v0[j] = a * a; v1[j] = b * b; }
                    u32x4 w; w.x = cvt_pk_bf16(v0[0], v0[1]); w.y = cvt_pk_bf16(v0[2], v0[3]); w.z = cvt_pk_bf16(v1[0], v1[1]); w.w = cvt_pk_bf16(v1[2], v1[3]);
                    *(u32x4*)(rowp + bj * HALF) = w; } }
    }
};
struct EpiU {
    static constexpr bool PERM = true, AFTER_DRAIN = false;
    bf16_t* O; float* out; int l;
    __device__ __forceinline__ void operator()(const f32x4 (&acc)[2][2][4][2], const Unit& u, int wr, int wc, int fr, int fq) const {
        const int row0 = u.pm * BM + wr * 64 + fr, col0 = u.pn * BM + wc * 32 + 8 * fq;
#pragma unroll
        for (int ai = 0; ai < 2; ++ai)
#pragma unroll
            for (int m = 0; m < 4; ++m) { const int row = row0 + ai * HALF + m * 16;
#pragma unroll
                for (int bj = 0; bj < 2; ++bj) { const int col = col0 + bj * HALF; const f32x4 v0 = acc[ai][bj][m][0], v1 = acc[ai][bj][m][1];
                    if (col < 3456) {
                        u32x4 w; w.x = cvt_pk_bf16(v0[0], v0[1]); w.y = cvt_pk_bf16(v0[2], v0[3]); w.z = cvt_pk_bf16(v1[0], v1[1]); w.w = cvt_pk_bf16(v1[2], v1[3]);
                        *(u32x4*)(O + (size_t)row * 3456 + col) = w;
                        if (row < 4096 && col >= 1664 && col < 2688) {
                            const int b = row >> 8, t = row & 255;
                            float* dst = (col < 2176) ? out + 14680064 + ((size_t)((b * 4 + l) * 256 + t)) * 512 + (col - 1664)
                                                      : out + 23068672 + ((size_t)((b * 4 + l) * 256 + t)) * 512 + (col - 2176);
                            __builtin_nontemporal_store(v0, (f32x4*)dst); __builtin_nontemporal_store(v1, (f32x4*)(dst + 4));
                        }
                    } } }
    }
};
}

DI void rwkv_prep_item(const Params& p, int l, int tile, float* lds) {
  const int tid = otid(), lane = tid & 63, wid = tid >> 6, fr = lane & 15, fq = lane >> 4;
  const int rowb = tile * 32; int s, t0, L, row0; seq_of(rowb, s, t0, L, row0);
  const u16* U = (const u16*)(p.ws + WS_U);
  u16* X = (u16*)lds;
  for (int ch = tid; ch < 32 * 48; ch += 512) {
    const int tok = ch / 48, c8 = (ch % 48) * 8;
    const uint4 raw = ldnt_u4(U + (size_t)(rowb + tok) * NU + 768 + c8);
    const unsigned w[4] = {raw.x, raw.y, raw.z, raw.w}; float f[8];
#pragma unroll
    for (int j = 0; j < 8; ++j) { float v = bf2f((u16)(w[j >> 1] >> ((j & 1) * 16))); f[j] = c8 < 128 ? (2.f * fsig(2.f * v) - 1.f) : (c8 < 256 ? v : fsig(v)); }
    *(uint4*)(X + tok * 392 + c8) = make_uint4(pack2(f[0], f[1]), pack2(f[2], f[3]), pack2(f[4], f[5]), pack2(f[6], f[7]));
  }
  u16* UT = X + 32 * 392;
  for (int ch = tid; ch < 34 * 96; ch += 512) {
    const int rr = ch / 96, c8 = (ch % 96) * 8; const int t = t0 - 1 + rr;
    uint4 raw = make_uint4(0u, 0u, 0u, 0u);
    if (t >= 0 && t < L) raw = ldnt_u4(U + (size_t)(rowb - 1 + rr) * NU + c8);
    *(uint4*)(UT + rr * 776 + c8) = raw;
  }
  __syncthreads();
  const int h = wid & 3, tg = wid >> 2;
  const u16* WT = (const u16*)(p.ws + WS_WTL) + ((size_t)l * 256 + h * 64 + 4 * fr) * 384 + fq * 8;
  const u16* xa = X + (tg * 16 + fr) * 392 + fq * 8;
  f32x4 awf[4], awb[4], aaf[4], aab[4], ag[4];
#pragma unroll
  for (int n = 0; n < 4; ++n) { const float z_ = ozero(); awf[n] = f32x4{z_, z_, z_, z_}; awb[n] = awf[n]; aaf[n] = awf[n]; aab[n] = awf[n]; ag[n] = awf[n]; }
#pragma unroll
  for (int ks = 0; ks < 2; ++ks) {
    const bf16x8 x0 = *(const bf16x8*)(xa + ks * 32), x1 = *(const bf16x8*)(xa + 64 + ks * 32), x2 = *(const bf16x8*)(xa + 128 + ks * 32), x3 = *(const bf16x8*)(xa + 192 + ks * 32);
#pragma unroll
    for (int n = 0; n < 4; ++n) {
      const u16* wp = WT + (size_t)n * 384 + ks * 32;
      awf[n] = __builtin_amdgcn_mfma_f32_16x16x32_bf16(x0, *(const bf16x8*)(wp), awf[n], 0, 0, 0);
      awb[n] = __builtin_amdgcn_mfma_f32_16x16x32_bf16(x1, *(const bf16x8*)(wp + 64), awb[n], 0, 0, 0);
      aaf[n] = __builtin_amdgcn_mfma_f32_16x16x32_bf16(x2, *(const bf16x8*)(wp + 128), aaf[n], 0, 0, 0);
      aab[n] = __builtin_amdgcn_mfma_f32_16x16x32_bf16(x3, *(const bf16x8*)(wp + 192), aab[n], 0, 0, 0);
    }
  }
#pragma unroll
  for (int ks = 0; ks < 4; ++ks) {
    const bf16x8 x4 = *(const bf16x8*)(xa + 256 + ks * 32);
#pragma unroll
    for (int n = 0; n < 4; ++n) ag[n] = __builtin_amdgcn_mfma_f32_16x16x32_bf16(x4, *(const bf16x8*)(WT + (size_t)n * 384 + 256 + ks * 32), ag[n], 0, 0, 0);
  }
  const float* cw = p.in[14] + (size_t)l * 3 * 768;
  float cr[4][3], ck[4][3], cv[4][3], kkw[4], ka[4], rk[4], w0f[4], w0b[4], a0f[4], a0b[4];
  {
    const int c0 = h * 64 + 4 * fr;
#define LD4(dst, ptr) { const float4 t_ = *(const float4*)(ptr); dst[0] = t_.x; dst[1] = t_.y; dst[2] = t_.z; dst[3] = t_.w; }
#pragma unroll
    for (int q = 0; q < 3; ++q) {
      const float4 a_ = *(const float4*)(cw + q * 768 + c0), b_ = *(const float4*)(cw + q * 768 + 256 + c0), c_ = *(const float4*)(cw + q * 768 + 512 + c0);
      cr[0][q] = a_.x; cr[1][q] = a_.y; cr[2][q] = a_.z; cr[3][q] = a_.w; ck[0][q] = b_.x; ck[1][q] = b_.y; ck[2][q] = b_.z; ck[3][q] = b_.w;
      cv[0][q] = c_.x; cv[1][q] = c_.y; cv[2][q] = c_.z; cv[3][q] = c_.w;
    }
    LD4(kkw, p.in[20] + l * 256 + c0); LD4(ka, p.in[21] + l * 256 + c0); LD4(rk, p.in[22] + l * 256 + c0);
    LD4(w0f, p.in[15] + (l * 2 + 0) * 256 + c0); LD4(w0b, p.in[15] + (l * 2 + 1) * 256 + c0);
    LD4(a0f, p.in[17] + (l * 2 + 0) * 256 + c0); LD4(a0b, p.in[17] + (l * 2 + 1) * 256 + c0);
#undef LD4
  }
  float* RW = (float*)(p.ws + WS_RW); float* G = (float*)(p.ws + WS_G); float* BC = (float*)(p.ws + WS_BC);
#pragma unroll
  for (int j = 0; j < 4; ++j) {
    const int tok = tg * 16 + fq * 4 + j, row = rowb + tok, t = t0 + tok;
    float r_[4], k_[4], v_[4], kkr[4]; float ss = 0.f;
#pragma unroll
    for (int n = 0; n < 4; ++n) {
      const u16* ur = UT + (tok + 1) * 776 + h * 64 + 4 * fr + n;
      const float r0 = bf2f(ur[0]), k0 = bf2f(ur[256]), v0 = bf2f(ur[512]);
      const float rm = bf2f(ur[-776]), km = bf2f(ur[256 - 776]), vm = bf2f(ur[512 - 776]);
      const float rp = bf2f(ur[776]), kp = bf2f(ur[256 + 776]), vp = bf2f(ur[512 + 776]);
      r_[n] = cr[n][0] * rm + cr[n][1] * r0 + cr[n][2] * rp;
      k_[n] = ck[n][0] * km + ck[n][1] * k0 + ck[n][2] * kp;
      v_[n] = cv[n][0] * vm + cv[n][1] * v0 + cv[n][2] * vp;
      kkr[n] = k_[n] * kkw[n]; ss += kkr[n] * kkr[n];
    }
    ss = allreduce16(ss); const float rn = rsqrtf(ss + 1e-12f);
    float bonus = 0.f, brf = 0.f, krf = 0.f, brb = 0.f, krb = 0.f;
    float* dst0 = RW + ((size_t)(row * 4 + h) * 9) * 64 + 4 * fr;
    float okk[4], odf[4], obf[4], okf[4], odb[4], obb[4], okb[4];
#pragma unroll
    for (int n = 0; n < 4; ++n) {
      const float kk = kkr[n] * rn;
      const float decf = fexp(-0.60653066f * fsig(w0f[n] + awf[n][j])), decb = fexp(-0.60653066f * fsig(w0b[n] + awb[n][j]));
      const float af_ = fsig(a0f[n] + aaf[n][j]), ab_ = fsig(a0b[n] + aab[n][j]);
      const float kdf = k_[n] * (1.f + (af_ - 1.f) * ka[n]), kdb = k_[n] * (1.f + (ab_ - 1.f) * ka[n]);
      const float bf_ = kk * af_, bb_ = kk * ab_;
      bonus += r_[n] * (kdf + kdb) * rk[n]; brf += bf_ * r_[n]; krf += kdf * r_[n]; brb += bb_ * r_[n]; krb += kdb * r_[n];
      okk[n] = kk; odf[n] = decf; obf[n] = bf_; okf[n] = kdf; odb[n] = decb; obb[n] = bb_; okb[n] = kdb;
    }
    *(float4*)(dst0) = make_float4(r_[0], r_[1], r_[2], r_[3]);
    *(float4*)(dst0 + 64) = make_float4(okk[0], okk[1], okk[2], okk[3]);
    *(float4*)(dst0 + 128) = make_float4(v_[0], v_[1], v_[2], v_[3]);
    *(float4*)(dst0 + 192) = make_float4(odf[0], odf[1], odf[2], odf[3]);
    *(float4*)(dst0 + 256) = make_float4(obf[0], obf[1], obf[2], obf[3]);
    *(float4*)(dst0 + 320) = make_float4(okf[0], okf[1], okf[2], okf[3]);
    *(float4*)(dst0 + 384) = make_float4(odb[0], odb[1], odb[2], odb[3]);
    *(float4*)(dst0 + 448) = make_float4(obb[0], obb[1], obb[2], obb[3]);
    *(float4*)(dst0 + 512) = make_float4(okb[0], okb[1], okb[2], okb[3]);
    *(float4*)(G + (size_t)row * 256 + h * 64 + 4 * fr) = make_float4(ag[0][j], ag[1][j], ag[2][j], ag[3][j]);
    bonus = allreduce16(bonus); brf = allreduce16(brf); krf = allreduce16(krf); brb = allreduce16(brb); krb = allreduce16(krb);
    if (fr == 0) { float* bc = BC + (size_t)(row * 4 + h) * 8; *(float4*)bc = make_float4(brf, krf, brb, krb); bc[4] = bonus; }
  }
  __syncthreads();
}

DI void attn_prep_item(const Params& p, int l, int tile, float* lds) {
  const int tid = otid();
  const int rowb = tile * 32; int s, t0, L, row0; seq_of(rowb, s, t0, L, row0);
  const bool lat = s >= 16;
  const u16* U = (const u16*)(p.ws + WS_U);
  u16* Q = (u16*)(p.ws + WS_Q);
  u16* Kd = lat ? (u16*)(p.ws + WS_KL) + ((size_t)(s - 16) * 2304 + 256) * 512 : (u16*)(p.ws + WS_KC) + (size_t)s * 256 * 512;
  u16* Vd = lat ? (u16*)(p.ws + WS_VL) + (size_t)(s - 16) * 2304 * 512 + 256 : (u16*)(p.ws + WS_VC) + (size_t)s * 256 * 512;
  for (int uidx = tid; uidx < 2048; uidx += 512) {
    const int g = uidx & 1, pb = (uidx >> 1) & 1, hm = (uidx >> 2) & 7, which = (uidx >> 5) & 1, tok = uidx >> 6;
    const int row = rowb + tok, t = t0 + tok;
    const u16* src = U + (size_t)row * NU + (which ? 1664 : 1152) + hm * 64 + pb * 32 + g * 8;
    const uint4 va = ldnt_u4(src); const uint4 vb = ldnt_u4(src + 16);
    const unsigned wa[4] = {va.x, va.y, va.z, va.w}, wb[4] = {vb.x, vb.y, vb.z, vb.w};
    float oa[8], ob[8];
#pragma unroll
    for (int j = 0; j < 8; ++j) {
      float xa = bf2f((u16)(wa[j >> 1] >> ((j & 1) * 16))), xb = bf2f((u16)(wb[j >> 1] >> ((j & 1) * 16)));
      if (lat) {
        const int pidx = pb == 0 ? (t >> 6) : (t & 63); const int i = g * 8 + j;
        const float2 csn = ((const float2*)(p.ws + WS_ROPE))[pidx * 16 + i];
        oa[j] = xa * csn.x - xb * csn.y; ob[j] = xb * csn.x + xa * csn.y;
      } else { oa[j] = xa; ob[j] = xb; }
    }
    u16* dst = (which == 0) ? Q + (size_t)row * 512 + hm * 64 + pb * 32 + g * 8 : Kd + (size_t)t * 512 + hm * 64 + pb * 32 + g * 8;
    *(uint4*)dst = make_uint4(pack2(oa[0], oa[1]), pack2(oa[2], oa[3]), pack2(oa[4], oa[5]), pack2(oa[6], oa[7]));
    *(uint4*)(dst + 16) = make_uint4(pack2(ob[0], ob[1]), pack2(ob[2], ob[3]), pack2(ob[4], ob[5]), pack2(ob[6], ob[7]));
  }
  u16* vl = (u16*)lds;
  for (int uidx = tid; uidx < 2048; uidx += 512) {
    const int tok = uidx >> 6, ch = uidx & 63;
    *(uint4*)(vl + tok * 520 + ch * 8) = ldnt_u4(U + (size_t)(rowb + tok) * NU + 2176 + ch * 8);
  }
  __syncthreads();
  {
    const int col = tid, hv = col >> 7, e = col & 127; const int Lk = lat ? 2304 : 256;
    u16* dst = Vd + (size_t)(hv * 128 + e) * Lk + t0;
#pragma unroll
    for (int q = 0; q < 4; ++q) {
      unsigned w[4];
#pragma unroll
      for (int j = 0; j < 4; ++j) w[j] = (unsigned)vl[(q * 8 + 2 * j) * 520 + col] | ((unsigned)vl[(q * 8 + 2 * j + 1) * 520 + col] << 16);
      *(uint4*)(dst + q * 8) = make_uint4(w[0], w[1], w[2], w[3]);
    }
  }
  __syncthreads();
}

DI void cache_item(const Params& p, int l, int it, float* lds) {
  const int b = it >> 3, pc = it & 7; const int tid = otid();
  u16* KL = (u16*)(p.ws + WS_KL); u16* VL = (u16*)(p.ws + WS_VL);
  u16* vl = (u16*)lds;
  for (int idx = tid; idx < 32 * 128; idx += 512) {
    const int r = idx >> 7, c4 = idx & 127, prow = pc * 32 + r;
    const size_t so = ((size_t)(b * 4 + l) * 256 + prow) * 512 + c4 * 4; const size_t d_o = ((size_t)b * 2304 + prow) * 512 + c4 * 4;
    float4 kv = *(const float4*)(p.in[3] + so); float4 vv = *(const float4*)(p.in[4] + so);
    *(uint2*)(KL + d_o) = make_uint2(pack2(kv.x, kv.y), pack2(kv.z, kv.w));
    *(uint2*)(vl + r * 520 + c4 * 4) = make_uint2(pack2(vv.x, vv.y), pack2(vv.z, vv.w));
  }
  __syncthreads();
  {
    const int col = tid, hv = col >> 7, e = col & 127;
    u16* dst = VL + (size_t)b * 2304 * 512 + (size_t)(hv * 128 + e) * 2304 + pc * 32;
#pragma unroll
    for (int q = 0; q < 4; ++q) {
      unsigned w[4];
#pragma unroll
      for (int j = 0; j < 4; ++j) w[j] = (unsigned)vl[(q * 8 + 2 * j) * 520 + col] | ((unsigned)vl[(q * 8 + 2 * j + 1) * 520 + col] << 16);
      *(uint4*)(dst + q * 8) = make_uint4(w[0], w[1], w[2], w[3]);
    }
  }
  __syncthreads();
}

DI void hy_prep_item(const Params& p, int l, int tile, float* lds) {
  const int tid = otid();
  const int rowb = tile * 64; int s, t0, L, row0; seq_of(rowb, s, t0, L, row0);
  const u16* U = (const u16*)(p.ws + WS_U); float* HYT = (float*)(p.ws + WS_HYT);
  u16* UT = (u16*)lds;
  for (int ch = tid; ch < 66 * 96; ch += 512) {
    const int rr = ch / 96, c8 = (ch % 96) * 8; const int t = t0 - 1 + rr;
    uint4 raw = make_uint4(0u, 0u, 0u, 0u);
    if (t >= 0 && t < L) raw = ldnt_u4(U + (size_t)(rowb - 1 + rr) * NU + 2688 + c8);
    *(uint4*)(UT + rr * 776 + c8) = raw;
  }
  __syncthreads();
  const int cc = tid >> 1, half = tid & 1;
#pragma unroll
  for (int which = 0; which < 3; ++which) {
    const int col = which * 256 + cc;
    const float w0 = p.in[30][(size_t)l * 3 * 768 + col], w1 = p.in[30][(size_t)l * 3 * 768 + 768 + col], w2 = p.in[30][(size_t)l * 3 * 768 + 1536 + col];
    const float bias = p.in[31][l * 768 + col];
    const u16* up = UT + (half * 32) * 776 + col;
    float um = bf2f(up[0]), u0 = bf2f(up[776]);
    float* dst = HYT + (size_t)col * TT + rowb + half * 32;
#pragma unroll
    for (int i = 0; i < 32; i += 4) {
      float o[4];
#pragma unroll
      for (int q = 0; q < 4; ++q) { const float un = bf2f(up[(i + q + 2) * 776]); o[q] = w0 * um + w1 * u0 + w2 * un + bias; um = u0; u0 = un; }
      *(float4*)(dst + i) = make_float4(o[0], o[1], o[2], o[3]);
    }
  }
  __syncthreads();
}

DI void scan_item(const Params& p, int l, int s, int h, int d, int rg, int nact, float* lds) {
  int L, row0; if (s < 16) { L = 256; row0 = s * 256; } else { L = 2048; row0 = 4096 + (s - 16) * 2048; }
  const float* RW = (const float*)(p.ws + WS_RW); float* YS = (float*)(p.ws + WS_YS) + (size_t)d * TT * 256;
  const float* BC = (const float*)(p.ws + WS_BC);
  const int tid = otid(), lane = tid & 63, wid = tid >> 6, lane16 = lane & 15, rsub = lane >> 4;
  const int row = rg * (nact * 4) + (wid & (nact - 1)) * 4 + rsub;
  float4 st = make_float4(0.f, 0.f, 0.f, 0.f);
  if (s >= 16 && wid < nact) st = *(const float4*)(p.in[2] + ((((size_t)(s - 16) * 4 + l) * 2 + d) * 4 + h) * 4096 + row * 64 + lane16 * 4);
  const int nch = L / 32;
  float4 pre0, pre1, pre2, pre3, pre4, pre5; float2 presc = make_float2(0.f, 0.f);
  auto ldpre = [&](int ch, int j) -> float4 {
    int f = tid + j * 512; int step = f / 96, within = f % 96; int slot6 = within >> 4, q = within & 15;
    int srcslot = slot6 < 3 ? slot6 : 3 + 3 * d + (slot6 - 3); int i = ch * 32 + step; int t = d ? L - 1 - i : i;
    return ldnt_f4(RW + ((size_t)((row0 + t) * 4 + h) * 9 + srcslot) * 64 + q * 4); };
#define PREFETCH(ch) { pre0 = ldpre(ch, 0); pre1 = ldpre(ch, 1); pre2 = ldpre(ch, 2); pre3 = ldpre(ch, 3); pre4 = ldpre(ch, 4); pre5 = ldpre(ch, 5); \
    if (tid < 32) { int i = (ch) * 32 + tid; int t = d ? L - 1 - i : i; presc = *(const float2*)(BC + (size_t)((row0 + t) * 4 + h) * 8 + 2 * d); } }
  PREFETCH(0);
  float* scl = lds + 12288;
  for (int ch = 0; ch < nch; ++ch) {
    *(float4*)(lds + (size_t)(tid + 0 * 512) * 4) = pre0; *(float4*)(lds + (size_t)(tid + 1 * 512) * 4) = pre1;
    *(float4*)(lds + (size_t)(tid + 2 * 512) * 4) = pre2; *(float4*)(lds + (size_t)(tid + 3 * 512) * 4) = pre3;
    *(float4*)(lds + (size_t)(tid + 4 * 512) * 4) = pre4; *(float4*)(lds + (size_t)(tid + 5 * 512) * 4) = pre5;
    if (tid < 32) *(float2*)(scl + tid * 2) = presc;
    __syncthreads();
    if (ch + 1 < nch) PREFETCH(ch + 1);
    if (wid < nact) {
      float4 r4 = *(const float4*)(lds + lane16 * 4), kk4 = *(const float4*)(lds + 64 + lane16 * 4);
      float vrow = lds[128 + row];
      float4 w4 = *(const float4*)(lds + 192 + lane16 * 4), b4 = *(const float4*)(lds + 256 + lane16 * 4), kd4 = *(const float4*)(lds + 320 + lane16 * 4);
      float2 sc = *(const float2*)scl;
      float ykeep = 0.f;
#pragma unroll 16
      for (int step = 0; step < 32; ++step) {
        const int sn = (step + 1) & 31;
        const float* bn = lds + sn * 384;
        const float4 nr4 = *(const float4*)(bn + lane16 * 4), nkk4 = *(const float4*)(bn + 64 + lane16 * 4);
        const float nvrow = bn[128 + row];
        const float4 nw4 = *(const float4*)(bn + 192 + lane16 * 4), nb4 = *(const float4*)(bn + 256 + lane16 * 4), nkd4 = *(const float4*)(bn + 320 + lane16 * 4);
        const float2 nsc = *(const float2*)(scl + sn * 2);
        __builtin_amdgcn_sched_barrier(0);
        float psa = st.x * kk4.x + st.y * kk4.y + st.z * kk4.z + st.w * kk4.w;
        float py = st.x * (w4.x * r4.x) + st.y * (w4.y * r4.y) + st.z * (w4.z * r4.z) + st.w * (w4.w * r4.w);
        psa += dppf<0xB1>(psa); py += dppf<0xB1>(py);
        psa += dppf<0x4E>(psa); py += dppf<0x4E>(py);
        psa += dppf<0x124>(psa); py += dppf<0x124>(py);
        psa += dppf<0x128>(psa); py += dppf<0x128>(py);
        const float sa = -psa;
        const float y = py + sa * sc.x + vrow * sc.y;
        st.x = st.x * w4.x + (sa * b4.x + vrow * kd4.x);
        st.y = st.y * w4.y + (sa * b4.y + vrow * kd4.y);
        st.z = st.z * w4.z + (sa * b4.z + vrow * kd4.z);
        st.w = st.w * w4.w + (sa * b4.w + vrow * kd4.w);
        ykeep = (lane16 == (step & 15)) ? y : ykeep;
        if ((step & 15) == 15) { const int i = ch * 32 + (step - 15) + lane16; const int t = d ? L - 1 - i : i; YS[(size_t)(row0 + t) * 256 + h * 64 + row] = ykeep; }
        r4 = nr4; kk4 = nkk4; vrow = nvrow; w4 = nw4; b4 = nb4; kd4 = nkd4; sc = nsc;
        __builtin_amdgcn_sched_barrier(0);
      }
    }
    __syncthreads();
  }
#undef PREFETCH
  if (s < 16 && wid < nact) *(float4*)(p.out + OUT_STATE + ((((size_t)s * 4 + l) * 2 + d) * 4 + h) * 4096 + row * 64 + lane16 * 4) = st;
}

DI void attn_item(const Params& p, int l, int s, int h, int qt, unsigned char* smem, float lam, float lam_init) {
  u16* Ks0 = (u16*)smem; float* Ex = (float*)smem;
  const bool lat = s >= 16; const int Lk = lat ? 2304 : 256;
  const u16* Kg = lat ? (const u16*)(p.ws + WS_KL) + (size_t)(s - 16) * 2304 * 512 : (const u16*)(p.ws + WS_KC) + (size_t)s * 256 * 512;
  const u16* Vg = (lat ? (const u16*)(p.ws + WS_VL) + (size_t)(s - 16) * 2304 * 512 : (const u16*)(p.ws + WS_VC) + (size_t)s * 256 * 512) + (size_t)h * 128 * Lk;
  const int row0 = lat ? 4096 + (s - 16) * 2048 : s * 256; const int qrow0 = row0 + qt * 128;
  const u16* Q = (const u16*)(p.ws + WS_Q);
  const int tid = otid(), lane = tid & 63, wid = tid >> 6, m = wid & 1, qs = wid >> 1, r = lane & 31, hh = lane >> 5;
  bf16x8 qf[4];
#pragma unroll
  for (int ks = 0; ks < 4; ++ks) qf[ks] = __builtin_nontemporal_load((const bf16x8*)(Q + (size_t)(qrow0 + qs * 32 + r) * 512 + h * 128 + m * 64 + ks * 16 + hh * 8));
  f32x16 o[4];
#pragma unroll
  for (int et = 0; et < 4; ++et)
#pragma unroll
    for (int i = 0; i < 16; ++i) o[et][i] = ozero();
  float mrun = -1e30f, lsum = 0.f, lsum2 = 0.f; const float cs = 0.125f * 1.4426950408889634f;
  uint4 kr0, kr1, vr0, vr1;
  const int kkey = tid >> 4, kch = tid & 15, ve = tid >> 3, vkc = tid & 7;
#define ALOAD(kt0) { kr0 = *(const uint4*)(Kg + (size_t)((kt0) + kkey) * 512 + h * 128 + kch * 8); kr1 = *(const uint4*)(Kg + (size_t)((kt0) + kkey + 32) * 512 + h * 128 + kch * 8); \
                     vr0 = *(const uint4*)(Vg + (size_t)ve * Lk + (kt0) + vkc * 8); vr1 = *(const uint4*)(Vg + (size_t)(ve + 64) * Lk + (kt0) + vkc * 8); }
#define ASTORE(b) { u16* ks_ = Ks0 + (b) * 17920; u16* vs_ = ks_ + 64 * 136; \
    *(uint4*)(ks_ + kkey * 136 + kch * 8) = kr0; *(uint4*)(ks_ + (kkey + 32) * 136 + kch * 8) = kr1; \
    *(uint2*)(vs_ + ve * 68 + vkc * 8) = make_uint2(vr0.x, vr0.y); *(uint2*)(vs_ + ve * 68 + vkc * 8 + 4) = make_uint2(vr0.z, vr0.w); \
    *(uint2*)(vs_ + (ve + 64) * 68 + vkc * 8) = make_uint2(vr1.x, vr1.y); *(uint2*)(vs_ + (ve + 64) * 68 + vkc * 8 + 4) = make_uint2(vr1.z, vr1.w); }
  ALOAD(0);
  __syncthreads();
  ASTORE(0);
  if (64 < Lk) ALOAD(64);
  __syncthreads();
  for (int kt0 = 0; kt0 < Lk; kt0 += 64) {
    const int cb = (kt0 >> 6) & 1;
    const u16* Ks = Ks0 + cb * 17920; const u16* Vs = Ks + 64 * 136;
    f32x16 st[2];
#pragma unroll
    for (int kt = 0; kt < 2; ++kt) {
#pragma unroll
      for (int i = 0; i < 16; ++i) st[kt][i] = 0.f;
#pragma unroll
      for (int ks = 0; ks < 4; ++ks) { const bf16x8 kf = *(const bf16x8*)(Ks + (kt * 32 + r) * 136 + m * 64 + ks * 16 + hh * 8);
        st[kt] = __builtin_amdgcn_mfma_f32_32x32x16_bf16(kf, qf[ks], st[kt], 0, 0, 0); }
    }
    float mx = st[0][0];
#pragma unroll
    for (int i = 0; i < 16; ++i) { mx = fmaxf(mx, st[0][i]); mx = fmaxf(mx, st[1][i]); }
    mx = fmaxf(mx, shfl32(mx, lane));
    const float mnew = fmaxf(mrun, mx);
    if (__builtin_amdgcn_ballot_w64(mnew > mrun) != 0ull) {
      const float alpha = __builtin_amdgcn_exp2f((mrun - mnew) * cs); mrun = mnew;
      lsum *= alpha; lsum2 *= alpha;
#pragma unroll
      for (int et = 0; et < 4; ++et)
#pragma unroll
        for (int i = 0; i < 16; ++i) o[et][i] *= alpha;
    }
    const float nb = -mrun * cs;
#pragma unroll
    for (int kt = 0; kt < 2; ++kt)
#pragma unroll
      for (int i = 0; i < 16; i += 2) {
        const float p0 = __builtin_amdgcn_exp2f(__builtin_fmaf(st[kt][i], cs, nb)), p1 = __builtin_amdgcn_exp2f(__builtin_fmaf(st[kt][i + 1], cs, nb));
        lsum += p0; lsum2 += p1; st[kt][i] = p0; st[kt][i + 1] = p1; }
#pragma unroll
    for (int kt = 0; kt < 2; ++kt)
#pragma unroll
      for (int ss = 0; ss < 2; ++ss) {
        unsigned pw0, pw1, pw2, pw3;
        asm volatile("v_cvt_pk_bf16_f32 %0, %4, %5\n\tv_cvt_pk_bf16_f32 %1, %6, %7\n\tv_cvt_pk_bf16_f32 %2, %8, %9\n\tv_cvt_pk_bf16_f32 %3, %10, %11\n\ts_nop 1"
                     : "=&v"(pw0), "=&v"(pw1), "=&v"(pw2), "=&v"(pw3)
                     : "v"(st[kt][8 * ss + 0]), "v"(st[kt][8 * ss + 1]), "v"(st[kt][8 * ss + 2]), "v"(st[kt][8 * ss + 3]),
                       "v"(st[kt][8 * ss + 4]), "v"(st[kt][8 * ss + 5]), "v"(st[kt][8 * ss + 6]), "v"(st[kt][8 * ss + 7]));
        const bf16x8 pf = __builtin_bit_cast(bf16x8, make_uint4(pw0, pw1, pw2, pw3));
#pragma unroll
        for (int et = 0; et < 4; ++et) {
          const u16* vp = Vs + (et * 32 + r) * 68 + kt * 32 + 16 * ss + 4 * hh;
          const s16x4 lo = *(const s16x4*)vp, hi = *(const s16x4*)(vp + 8);
          const bf16x8 vf = __builtin_shufflevector(lo, hi, 0, 1, 2, 3, 4, 5, 6, 7);
          o[et] = __builtin_amdgcn_mfma_f32_32x32x16_bf16(vf, pf, o[et], 0, 0, 0);
        }
      }
    if (kt0 + 64 < Lk) ASTORE(cb ^ 1);
    __syncthreads();
    if (kt0 + 128 < Lk) ALOAD(kt0 + 128);
  }
#undef ALOAD
#undef ASTORE
  lsum += lsum2; lsum += shfl32(lsum, lane); const float inv = 1.f / lsum;
  float* ex = Ex + qs * (32 * 132);
  if (m == 1) {
#pragma unroll
    for (int et = 0; et < 4; ++et)
#pragma unroll
      for (int i = 0; i < 16; ++i) { int e = et * 32 + (i & 3) + 8 * (i >> 2) + 4 * hh; ex[r * 132 + e] = o[et][i] * inv; }
  }
  __syncthreads();
  if (m == 0) {
    float ssq = 0.f;
#pragma unroll
    for (int et = 0; et < 4; ++et)
#pragma unroll
      for (int i = 0; i < 16; ++i) { int e = et * 32 + (i & 3) + 8 * (i >> 2) + 4 * hh; float v = o[et][i] * inv - lam * ex[r * 132 + e]; o[et][i] = v; ssq += v * v; }
    ssq += shfl32(ssq, lane);
    const float rs = rsqrtf(ssq * (1.f / 128.f) + 1e-6f) * (1.f - lam_init);
    const float* subln = p.in[29] + l * 128;
    u16* dstrow = (u16*)(p.ws + WS_MIXCAT) + (size_t)(qrow0 + qs * 32 + r) * 1024 + 256 + h * 128;
#pragma unroll
    for (int et = 0; et < 4; ++et)
#pragma unroll
      for (int g4 = 0; g4 < 4; ++g4) {
        const int e0 = et * 32 + 8 * g4 + 4 * hh; const float4 sl = *(const float4*)(subln + e0);
        *(uint2*)(dstrow + e0) = make_uint2(pack2(o[et][4 * g4] * rs * sl.x, o[et][4 * g4 + 1] * rs * sl.y), pack2(o[et][4 * g4 + 2] * rs * sl.z, o[et][4 * g4 + 3] * rs * sl.w));
      }
  }
}

DI void hy_conv(const float* g, const float* z, int L, int t0, float& a0, float& a1, float& a2, float& a3) {
  a0 = a1 = a2 = a3 = 0.f;
  const float* gp = g + L + t0 - 4;
  const int nb = L >> 2;
#pragma unroll 4
  for (int sb = 0; sb < nb; ++sb) {
    const float4 zz = *(const float4*)(z + sb * 4);
    const float4 ga = *(const float4*)(gp - 4 * sb), gb = *(const float4*)(gp - 4 * sb + 4);
    a0 += gb.x * zz.x + ga.w * zz.y + ga.z * zz.z + ga.y * zz.w;
    a1 += gb.y * zz.x + gb.x * zz.y + ga.w * zz.z + ga.z * zz.w;
    a2 += gb.z * zz.x + gb.y * zz.y + gb.x * zz.z + ga.w * zz.w;
    a3 += gb.w * zz.x + gb.z * zz.y + gb.y * zz.z + gb.x * zz.w;
  }
}

DI void hyena_item(const Params& p, int l, int s, int c0, float* lds) {
  const bool lat = s >= 16; const int L = lat ? 2048 : 256; const int row0 = lat ? 4096 + (s - 16) * 2048 : s * 256;
  const int TPC = L >> 2; const int tid = otid(), lane = tid & 63, wid = tid >> 6;
  const int ch = tid / TPC, tl = tid % TPC, t0 = tl * 4, c = c0 + ch;
  float* G = lds; float* Z = lds + 8192; float* red = lds + 8192 + 2048;
  const float* F = (const float*)(p.ws + WS_FILT) + (lat ? 262144 : 0);
  const float* HYT = (const float*)(p.ws + WS_HYT);
  float ssq[2];
#pragma unroll
  for (int o = 0; o < 2; ++o) {
    const float* src = F + (size_t)(o * 256 + c) * (2 * L); float* dst = G + (size_t)(ch * 2 + o) * (2 * L); float sacc = 0.f;
#pragma unroll
    for (int i = 0; i < 2; ++i) { int idx = (tl + i * TPC) * 4; float4 v = *(const float4*)(src + idx); *(float4*)(dst + idx) = v; sacc += v.x * v.x + v.y * v.y + v.z * v.z + v.w * v.w; }
    ssq[o] = wave_sum(sacc);
  }
  if (lane == 0) { red[wid * 2] = ssq[0]; red[wid * 2 + 1] = ssq[1]; }
  const float4 x1 = *(const float4*)(HYT + (size_t)(0 * 256 + c) * TT + row0 + t0);
  const float4 x2 = *(const float4*)(HYT + (size_t)(1 * 256 + c) * TT + row0 + t0);
  const float4 v4 = *(const float4*)(HYT + (size_t)(2 * 256 + c) * TT + row0 + t0);
  *(float4*)(Z + ch * L + t0) = v4;
  __syncthreads();
  const int wpc = TPC >> 6, w0 = ch * wpc; float sc0 = 0.f, sc1 = 0.f;
  for (int w = 0; w < wpc; ++w) { sc0 += red[(w0 + w) * 2]; sc1 += red[(w0 + w) * 2 + 1]; }
  sc0 = rsqrtf(sc0 + 1e-6f); sc1 = rsqrtf(sc1 + 1e-6f);
  const float bias0 = p.in[39][(l * 2 + 0) * 256 + c], bias1 = p.in[39][(l * 2 + 1) * 256 + c];
  float a0, a1, a2, a3;
  hy_conv(G + (size_t)(ch * 2 + 0) * (2 * L), Z + ch * L, L, t0, a0, a1, a2, a3);
  float4 z1;
  z1.x = x1.x * (sc0 * a0 + bias0 * v4.x); z1.y = x1.y * (sc0 * a1 + bias0 * v4.y); z1.z = x1.z * (sc0 * a2 + bias0 * v4.z); z1.w = x1.w * (sc0 * a3 + bias0 * v4.w);
  __syncthreads();
  *(float4*)(Z + ch * L + t0) = z1;
  __syncthreads();
  hy_conv(G + (size_t)(ch * 2 + 1) * (2 * L), Z + ch * L, L, t0, a0, a1, a2, a3);
  float4 yo;
  yo.x = x2.x * (sc1 * a0 + bias1 * z1.x); yo.y = x2.y * (sc1 * a1 + bias1 * z1.y); yo.z = x2.z * (sc1 * a2 + bias1 * z1.z); yo.w = x2.w * (sc1 * a3 + bias1 * z1.w);
  *(float4*)((float*)(p.ws + WS_YC) + (size_t)c * TT + row0 + t0) = yo;
  __syncthreads();
}


DI float2 cmul(float2 a, float2 b) { return make_float2(a.x * b.x - a.y * b.y, a.x * b.y + a.y * b.x); }
#define BF2(a, b) { float2 t_ = a; a.x = t_.x + b.x; a.y = t_.y + b.y; b.x = t_.x - b.x; b.y = t_.y - b.y; }
#define MNI(a) { float t_ = a.x; a.x = a.y; a.y = -t_; }
DI void fft_fwd(float2 (&v)[8], int j, int TPF, int npass, float2* lds) {
  int Ns = 1;
  for (int ps = 0; ps < npass; ++ps) {
    const int k = j & (Ns - 1);
    if (ps > 0) {
      const float a2 = -2.f * (float)k / (float)(Ns * 8);
      const float2 w1 = make_float2(cospif(a2), sinpif(a2));
      float2 w = w1; v[1] = cmul(v[1], w);
      w = cmul(w, w1); v[2] = cmul(v[2], w);
      w = cmul(w, w1); v[3] = cmul(v[3], w);
      w = cmul(w, w1); v[4] = cmul(v[4], w);
      w = cmul(w, w1); v[5] = cmul(v[5], w);
      w = cmul(w, w1); v[6] = cmul(v[6], w);
      w = cmul(w, w1); v[7] = cmul(v[7], w);
    }
    BF2(v[0], v[4]); BF2(v[1], v[5]); BF2(v[2], v[6]); BF2(v[3], v[7]);
    v[5] = cmul(v[5], make_float2(0.70710678118654752f, -0.70710678118654752f)); MNI(v[6]); v[7] = cmul(v[7], make_float2(-0.70710678118654752f, -0.70710678118654752f));
    BF2(v[0], v[2]); BF2(v[1], v[3]); BF2(v[4], v[6]); BF2(v[5], v[7]);
    MNI(v[3]); MNI(v[7]);
    BF2(v[0], v[1]); BF2(v[2], v[3]); BF2(v[4], v[5]); BF2(v[6], v[7]);
    { float2 t1 = v[1], t3 = v[3]; v[1] = v[4]; v[3] = v[6]; v[4] = t1; v[6] = t3; }
    if (ps == npass - 1) break;
    __syncthreads();
    const int base = (j - k) * 8 + k;
#pragma unroll
    for (int r = 0; r < 8; ++r) { const int idx = base + r * Ns; lds[idx + (idx >> 3)] = v[r]; }
    __syncthreads();
#pragma unroll
    for (int r = 0; r < 8; ++r) { const int idx = j + r * TPF; v[r] = lds[idx + (idx >> 3)]; }
    Ns *= 8;
  }
}

DI void hspec_item(const Params& p, int lat, int item, float* ldsf) {
  const int tid = otid(), lane = tid & 63, wid = tid >> 6;
  const int TPF = lat ? 512 : 64, npass = lat ? 4 : 3, L = lat ? 2048 : 256, N = 2 * L;
  const int unit = lat ? 0 : wid; const int j = tid & (TPF - 1);
  const int c = lat ? item : item * 8 + unit;
  float2* lds = (float2*)ldsf + unit * (N + (N >> 3));
  float* red = ldsf + 9216;
  const float* F = (const float*)(p.ws + WS_FILT) + (lat ? 262144 : 0);
  const float* g0 = F + (size_t)c * N; const float* g1 = F + (size_t)(256 + c) * N;
  float2 v[8]; float s0 = 0.f, s1 = 0.f;
#pragma unroll
  for (int r = 0; r < 8; ++r) { const int n = j + r * TPF; const int gi = (n + L) & (N - 1); const float a = g0[gi], b = g1[gi]; v[r] = make_float2(a, b); s0 += a * a; s1 += b * b; }
  s0 = wave_sum(s0); s1 = wave_sum(s1);
  if (lane == 0) { red[wid * 2] = s0; red[wid * 2 + 1] = s1; }
  __syncthreads();
  if (lat) { s0 = 0.f; s1 = 0.f; for (int w = 0; w < 8; ++w) { s0 += red[w * 2]; s1 += red[w * 2 + 1]; } }
  const float sc0 = rsqrtf(s0 + 1e-6f), sc1 = rsqrtf(s1 + 1e-6f);
#pragma unroll
  for (int r = 0; r < 8; ++r) { v[r].x *= sc0; v[r].y *= sc1; }
  fft_fwd(v, j, TPF, npass, lds);
  __syncthreads();
#pragma unroll
  for (int r = 0; r < 8; ++r) { const int idx = j + r * TPF; lds[idx + (idx >> 3)] = v[r]; }
  __syncthreads();
  const float hn = 0.5f / (float)N;
  float2* HS = (float2*)(p.ws + WS_HSPEC) + (lat ? 0 : 2 * 256 * 4096);
  float2* H0 = HS + (size_t)c * N; float2* H1 = HS + (size_t)(256 + c) * N;
#pragma unroll
  for (int r = 0; r < 8; ++r) {
    const int k = j + r * TPF; const int km = (N - k) & (N - 1); const float2 wm = lds[km + (km >> 3)];
    const float2 sm = make_float2(v[r].x + wm.x, v[r].y - wm.y); const float2 df = make_float2(v[r].x - wm.x, v[r].y + wm.y);
    H0[k] = make_float2(sm.x * hn, sm.y * hn); H1[k] = make_float2(df.y * hn, -df.x * hn);
  }
  __syncthreads();
}

DI void hyena_fft_item(const Params& p, int l, int lat, int item, float* ldsf) {
  const int tid = otid(), wid = tid >> 6;
  const int TPF = lat ? 512 : 64, npass = lat ? 4 : 3, L = lat ? 2048 : 256, N = 2 * L;
  const int unit = lat ? 0 : wid; const int j = tid & (TPF - 1);
  int c, rowa, rowb;
  if (lat) { const int bp = item >> 8; c = item & 255; rowa = 4096 + (2 * bp) * 2048; rowb = rowa + 2048; }
  else { const int gidx = item * 8 + unit; const int pair = gidx >> 8; c = gidx & 255; rowa = (2 * pair) * 256; rowb = rowa + 256; }
  float2* lds = (float2*)ldsf + unit * (N + (N >> 3));
  const float2* HS = (const float2*)(p.ws + WS_HSPEC) + (lat ? 0 : 2 * 256 * 4096);
  const float* HYT = (const float*)(p.ws + WS_HYT);
  float2 v[8], z[4];
#pragma unroll
  for (int r = 0; r < 4; ++r) { const int t = j + r * TPF; z[r] = make_float2(__builtin_nontemporal_load(HYT + (size_t)(512 + c) * TT + rowa + t), __builtin_nontemporal_load(HYT + (size_t)(512 + c) * TT + rowb + t)); v[r] = z[r]; v[4 + r] = make_float2(0.f, 0.f); }
  for (int order = 0; order < 2; ++order) {
    const float2* H = HS + (size_t)(order * 256 + c) * N;
    const float* xq = HYT + (size_t)(order * 256 + c) * TT;
    float2 h[8];
#pragma unroll
    for (int r = 0; r < 8; ++r) h[r] = H[j + r * TPF];
    float xa[4], xb[4];
#pragma unroll
    for (int r = 0; r < 4; ++r) { xa[r] = __builtin_nontemporal_load(xq + rowa + j + r * TPF); xb[r] = __builtin_nontemporal_load(xq + rowb + j + r * TPF); }
    fft_fwd(v, j, TPF, npass, lds);
#pragma unroll
    for (int r = 0; r < 8; ++r) { const float2 y = cmul(v[r], h[r]); v[r] = make_float2(y.x, -y.y); }
    fft_fwd(v, j, TPF, npass, lds);
    const float bias = p.in[39][(l * 2 + order) * 256 + c];
#pragma unroll
    for (int r = 0; r < 4; ++r) {
      const float ya = v[r].x, yb = -v[r].y;
      z[r] = make_float2(xa[r] * (ya + bias * z[r].x), xb[r] * (yb + bias * z[r].y));
      v[r] = z[r]; v[4 + r] = make_float2(0.f, 0.f);
    }
  }
  float* YC = (float*)(p.ws + WS_YC) + (size_t)c * TT;
#pragma unroll
  for (int r = 0; r < 4; ++r) { const int t = j + r * TPF; YC[rowa + t] = z[r].x; YC[rowb + t] = z[r].y; }
  __syncthreads();
}

DI void fin_item(const Params& p, int l, int tile, float* lds) {
  const int tid = otid(), lane = tid & 63, wid = tid >> 6; const int rowb = tile * 64;
  const float* YS0 = (const float*)(p.ws + WS_YS); const float* YS1 = YS0 + (size_t)TT * 256;
  const float* RW = (const float*)(p.ws + WS_RW); const float* G = (const float*)(p.ws + WS_G); const float* BC = (const float*)(p.ws + WS_BC);
  u16* MC = (u16*)(p.ws + WS_MIXCAT);
  {
    const int l16 = lane & 15, sub = lane >> 4;
#pragma unroll 2
    for (int q = 0; q < 8; ++q) {
      const int pair = wid * 32 + q * 4 + sub, tok = pair >> 2, h = pair & 3, row = rowb + tok, c = h * 64 + l16 * 4;
      const float4 y0 = ldnt_f4(YS0 + (size_t)row * 256 + c), y1 = ldnt_f4(YS1 + (size_t)row * 256 + c);
      const float4 y = make_float4(y0.x + y1.x, y0.y + y1.y, y0.z + y1.z, y0.w + y1.w);
      const float mu = allreduce16(y.x + y.y + y.z + y.w) * (1.f / 64.f);
      const float4 dv = make_float4(y.x - mu, y.y - mu, y.z - mu, y.w - mu);
      const float var = allreduce16(dv.x * dv.x + dv.y * dv.y + dv.z * dv.z + dv.w * dv.w) * (1.f / 64.f);
      const float rs = rsqrtf(var + 64e-5f);
      const float4 lw = *(const float4*)(p.in[23] + l * 256 + c), lb = *(const float4*)(p.in[24] + l * 256 + c);
      const float4 v = ldnt_f4(RW + ((size_t)(row * 4 + h) * 9 + 2) * 64 + l16 * 4); const float bc = BC[(size_t)(row * 4 + h) * 8 + 4];
      const float4 g = ldnt_f4(G + (size_t)row * 256 + c);
      const float o0 = (dv.x * rs * lw.x + lb.x + bc * v.x) * g.x, o1 = (dv.y * rs * lw.y + lb.y + bc * v.y) * g.y;
      const float o2 = (dv.z * rs * lw.z + lb.z + bc * v.z) * g.z, o3 = (dv.w * rs * lw.w + lb.w + bc * v.w) * g.w;
      *(uint2*)(MC + (size_t)row * 1024 + c) = make_uint2(pack2(o0, o1), pack2(o2, o3));
    }
  }
  const float* YC = (const float*)(p.ws + WS_YC);
#pragma unroll
  for (int it = 0; it < 8; ++it) { const int idx = tid + it * 512; const int c = idx >> 4, t4 = (idx & 15) * 4;
    const float4 v = ldnt_f4(YC + (size_t)c * TT + rowb + t4); float* d = lds + c * 65 + t4; d[0] = v.x; d[1] = v.y; d[2] = v.z; d[3] = v.w; }
  __syncthreads();
#pragma unroll
  for (int it = 0; it < 8; ++it) { const int idx = tid + it * 512; const int tt = idx >> 6, c4 = (idx & 63) * 4;
    *(uint2*)(MC + (size_t)(rowb + tt) * 1024 + 768 + c4) = make_uint2(pack2(lds[c4 * 65 + tt], lds[(c4 + 1) * 65 + tt]), pack2(lds[(c4 + 2) * 65 + tt], lds[(c4 + 3) * 65 + tt])); }
  __syncthreads();
}

constexpr int NPH = 2 + 9 * 4;

DI void run_phase(const Params& p, int ph, unsigned char* smem) {
  float* lds = (float*)smem;
  PG8_LAS unsigned char* ldsp = (PG8_LAS unsigned char*)smem;
  const int nb = gridDim.x, bid = blockIdx.x;
  if (ph == 0) {
    int& s_ip = *(int*)(smem + 131072 + 28);
    unsigned* ctr0 = (unsigned*)(p.ws + WS_CTL + 16384) + 4 * 64;
    for (;;) {
      __syncthreads();
      if (threadIdx.x == 0) s_ip = (int)atomicAdd(ctr0, 1u);
      __syncthreads();
      const int q0 = s_ip;
      if (q0 >= 384 + AUX_ITEMS + 1 + 32) break;
      const int it = q0 < 288 ? 384 + AUX_ITEMS - 288 + q0 : (q0 - 288 < 384 + AUX_ITEMS - 288 ? q0 - 288 : q0);
      if (it < 384) mod_item(p, it, lds);
      else if (it < 384 + AUX_ITEMS) aux_item(p, 0, it - 384, lds);
      else if (it >= 384 + AUX_ITEMS + 1) {
        const int q = it - (384 + AUX_ITEMS + 1), ll = q >> 3, c0 = (q & 7) * 32; u16* WT = (u16*)(p.ws + WS_WTL);
        for (int e = otid(); e < 32 * 384; e += 512) { const int k = e >> 5, cc = e & 31, col = c0 + cc; float v;
          if (k < 64) v = p.in[16][((size_t)(ll * 2 + 0) * 64 + k) * 256 + col];
          else if (k < 128) v = p.in[16][((size_t)(ll * 2 + 1) * 64 + (k - 64)) * 256 + col];
          else if (k < 192) v = p.in[18][((size_t)(ll * 2 + 0) * 64 + (k - 128)) * 256 + col];
          else if (k < 256) v = p.in[18][((size_t)(ll * 2 + 1) * 64 + (k - 192)) * 256 + col];
          else v = p.in[19][((size_t)ll * 128 + (k - 256)) * 256 + col];
          WT[((size_t)ll * 256 + col) * 384 + k] = f2bf(v); }
      }
      else { float2* tab = (float2*)(p.ws + WS_ROPE); for (int e = otid(); e < 1024; e += 512) { const int pidx = e >> 4, i = e & 15;
               const float inv = exp2f(-(float)(2 * i) * (13.287712379549449f / 32.f)); const float ang = (float)pidx * inv; tab[e] = make_float2(cosf(ang), sinf(ang)); } }
    }
    return;
  }
  if (ph == 1) { row_phase(p, 0, 0);
#ifdef PROBE_R
    __syncthreads(); row_phase(p, 0, 0);
#endif
    return; }
  const int l = (ph - 2) / 9, k = (ph - 2) % 9;
  unsigned char* slot = p.ws + WS_W + (size_t)(l & 1) * W_SLOT;
  const u16* win = (const u16*)slot; const u16* wout = (const u16*)(slot + W_IN_B); const u16* wff1 = (const u16*)(slot + W_IN_B + W_OUT_B); const u16* wff2 = (const u16*)(slot + W_IN_B + W_OUT_B + W_FF_B);
  const int nrep = (k != 2 && k != 5 && k != 8 && ((PROBE_DUPK >> k) & 1)) ? 2 : 1;
  for (int rep = 0; rep < nrep; ++rep)
  switch (k) {
    case 0: { pg8::Gemm g{(const u16*)(p.ws + WS_H), win, TT, 3584, 1024}; pg8::StaticOrder S; S.init(TT, 3584, nb, bid);
              pg8::EpiU E{(u16*)(p.ws + WS_U), p.out, l}; pg8::gemm_phase(ldsp, g, S, E, nullptr);
#ifdef PROBE_G
              __syncthreads(); pg8::gemm_phase(ldsp, g, S, E, nullptr);
#endif
              } break;
    case 1: {
      int& s_it = *(int*)(smem + 131072 + 24);
#ifdef PROBE_P
      _Pragma("unroll") for (int pp_ = 0; pp_ < 2; ++pp_) {
      unsigned* ctr = (unsigned*)(p.ws + WS_CTL + 16384) + l * 64 + 32 + pp_ * 8;
#else
      {
      unsigned* ctr = (unsigned*)(p.ws + WS_CTL + 16384) + l * 64 + 32;
#endif
      for (;;) {
        __syncthreads();
        if (threadIdx.x == 0) s_it = (int)atomicAdd(ctr, 1u);
        __syncthreads();
        const int it = s_it;
        if (it >= 1280) break;
        if (it < 384) rwkv_prep_item(p, l, it, lds);
        else if (it < 576) hy_prep_item(p, l, it - 384, lds);
        else if (it < 960) attn_prep_item(p, l, it - 576, lds);
        else if (it < 1216) hspec_item(p, 1, it - 960, lds);
        else if (it < 1248) hspec_item(p, 0, it - 1216, lds);
        else cache_item(p, l, it - 1248, lds);
      }
      }
    } break;
    case 2: {
      int& s_item = *(int*)(smem + 131072 + 16); float& s_lam = *(float*)(smem + 131072 + 20);
      const float lam_init = 0.8f - 0.6f * expf(-0.3f * (float)l);
      const int tid2 = otid();
      if (tid2 < 64) {
        int ln = tid2; float a = p.in[25][l * 64 + ln] * p.in[26][l * 64 + ln]; float b = p.in[27][l * 64 + ln] * p.in[28][l * 64 + ln];
        a = wave_sum(a); b = wave_sum(b); if (ln == 0) s_lam = expf(a) - expf(b) + lam_init;
      }
      __syncthreads();
      const float lam = s_lam;
#ifdef PROBE_M
      const int npass = 2;
#else
      const int npass = 1;
#endif
      _Pragma("unroll") for (int pass = 0; pass < npass; ++pass) {
      unsigned* ctr = (unsigned*)(p.ws + WS_CTL + 16384) + l * 64 + pass * 16;
      const int mask = pass == 0 ? 7 : PROBE_MIXMASK;
      for (;;) {
        __syncthreads();
        if (threadIdx.x == 0) s_item = (int)atomicAdd(ctr, 1u);
        __syncthreads();
        int it = s_item;
        if (it >= 1536) break;
        if (it < 128) { if (mask & 1) scan_item(p, l, 16 + (it >> 5), (it >> 3) & 3, (it >> 2) & 1, it & 3, 4, lds); }
        else if (it < 384) { int j = it - 128; if (mask & 2) attn_item(p, l, 16 + (j >> 6), (j >> 4) & 3, j & 15, smem, lam, lam_init); }
        else if (it < 640) { int j = it - 384; if (mask & 1) scan_item(p, l, j >> 4, (j >> 2) & 3, (j >> 1) & 1, j & 1, 8, lds); }
        else if (it < 1152) { int j = it - 640; if (mask & 4) hyena_fft_item(p, l, 1, j, lds); }
        else if (it < 1280) { int j = it - 1152; if (mask & 2) attn_item(p, l, j >> 3, (j >> 1) & 3, j & 1, smem, lam, lam_init); }
        else { int j = it - 1280; if (mask & 4) hyena_fft_item(p, l, 0, j, lds); }
      }
      }
    } break;
    case 3: for (int it = bid; it < 192; it += nb) fin_item(p, l, it, lds);
#ifdef PROBE_F
      for (int it = bid; it < 192; it += nb) fin_item(p, l, it, lds);
#endif
      break;
    case 4: { pg8::Gemm g{(const u16*)(p.ws + WS_MIXCAT), wout, TT, 1024, 1024}; pg8::StaticOrder S; S.init(TT, 1024, nb, bid);
              pg8::EpiBf E{(u16*)(p.ws + WS_F), 1024}; pg8::gemm_phase(ldsp, g, S, E, nullptr);
#ifdef PROBE_G
              __syncthreads(); pg8::gemm_phase(ldsp, g, S, E, nullptr);
#endif
              } break;
    case 5:
      row_phase(p, l, 1);
      if (l < 3) {
        int& s_ia = *(int*)(smem + 131072 + 28);
        unsigned* ctr = (unsigned*)(p.ws + WS_CTL + 16384) + l * 64 + 48;
        for (;;) {
          __syncthreads();
          if (threadIdx.x == 0) s_ia = (int)atomicAdd(ctr, 1u);
          __syncthreads();
          const int q = s_ia;
          if (q >= AUX_ITEMS) break;
          aux_item(p, l + 1, q < 288 ? AUX_ITEMS - 288 + q : q - 288, lds);
        }
      }
#ifdef PROBE_A
      if (l < 3) for (int it = bid; it < AUX_ITEMS; it += nb) aux_item(p, l + 1, it, lds);
#endif
#ifdef PROBE_A1
      if (l < 3) for (int it = bid; it < AUX_ITEMS - 288; it += nb) aux_item(p, l + 1, it, lds);
#endif
#ifdef PROBE_A2
      if (l < 3) for (int it = AUX_ITEMS - 288 + bid; it < AUX_ITEMS; it += nb) aux_item(p, l + 1, it, lds);
#endif
      break;
    case 6: { pg8::Gemm g{(const u16*)(p.ws + WS_H), wff1, TT, 4096, 1024}; pg8::StaticOrder S; S.init(TT, 4096, nb, bid);
              pg8::EpiRelu2 E{(u16*)(p.ws + WS_A), 4096}; pg8::gemm_phase(ldsp, g, S, E, nullptr);
#ifdef PROBE_G
              __syncthreads(); pg8::gemm_phase(ldsp, g, S, E, nullptr);
#endif
              } break;
    case 7: { pg8::Gemm g{(const u16*)(p.ws + WS_A), wff2, TT, 1024, 4096}; pg8::StaticOrder S; S.init(TT, 1024, nb, bid);
              pg8::EpiBf E{(u16*)(p.ws + WS_F), 1024}; pg8::gemm_phase(ldsp, g, S, E, nullptr);
#ifdef PROBE_G
              __syncthreads(); pg8::gemm_phase(ldsp, g, S, E, nullptr);
#endif
              } break;
    case 8: row_phase(p, l, 2); break;
  }
}

__global__ void __launch_bounds__(512) mega(Params p, int ph_lo, int ph_hi) {
  extern __shared__ __attribute__((aligned(16))) unsigned char smem[];
  uint4& xb_words = *(uint4*)(smem + 131072);
  if (threadIdx.x == 0) xb_words = make_uint4(0u, 0u, 0u, 0u);
  __syncthreads();
  (void)xcd_barrier_post((unsigned*)(p.ws + WS_CTL), (volatile LAS unsigned*)&xb_words);
  for (int ph = ph_lo; ph < ph_hi; ++ph) {
    if (ph > ph_lo) { XcdBarrier xb; xb.bar = (unsigned*)(p.ws + WS_CTL); xb.x = xb_xcc_id(); xb.st = (volatile LAS unsigned*)(smem + 131072); xcd_barrier(xb);
#ifdef PROBE_B
      xcd_barrier(xb);
#endif
    }
    run_phase(p, ph, smem);
  }
}

extern "C" void kernel_launch(void* const* d_in, const int* in_sizes, int n_in, void* d_out, int out_size, void* d_ws, size_t ws_size, hipStream_t stream) {
  static int grid = 0;
  if (!grid) {
    int dev = 0, cus = 0, per_cu = 0;
    hipGetDevice(&dev);
    hipDeviceGetAttribute(&cus, hipDeviceAttributeMultiprocessorCount, dev);
    hipFuncSetAttribute((const void*)mega, hipFuncAttributeMaxDynamicSharedMemorySize, (int)LDS_BYTES);
    hipOccupancyMaxActiveBlocksPerMultiprocessor(&per_cu, (const void*)mega, NT, LDS_BYTES);
    if (per_cu < 1) { fprintf(stderr, "occupancy query says %d blocks/CU\n", per_cu); per_cu = 1; }
    grid = cus;
  }
  if (n_in != 43 || ws_size < WS_END) { fprintf(stderr, "kernel_launch: bad n_in %d or ws %zu < %zu\n", n_in, ws_size, (size_t)WS_END); return; }
  Params p{};
  for (int i = 0; i < 43; ++i) p.in[i] = (const float*)d_in[i];
  p.out = (float*)d_out; p.ws = (unsigned char*)d_ws;
  (void)hipMemsetAsync((unsigned char*)d_ws + WS_CTL, 0, 32768, stream);
#if ONE_LAUNCH
  int lo = 0, hi = NPH; void* args[] = {&p, &lo, &hi};
  hipError_t e = hipLaunchCooperativeKernel((const void*)mega, dim3(grid), dim3(NT), args, LDS_BYTES, stream);
  if (e != hipSuccess) fprintf(stderr, "cooperative launch failed: %s\n", hipGetErrorString(e));
#else
  for (int ph = 0; ph < NPH; ++ph) hipLaunchKernelGGL(mega, dim3(grid), dim3(NT), LDS_BYTES, stream, p, ph, ph + 1);
#endif
}
```

```cpp
#include <hip/hip_runtime.h>
#include <hip/hip_cooperative_groups.h>
#include <stdint.h>
#include <stdio.h>
namespace cg = cooperative_groups;

#ifndef ONE_LAUNCH
#define ONE_LAUNCH 1
#endif

#ifndef PROBE_DUPK
#define PROBE_DUPK 0
#endif
#ifndef PROBE_MIXMASK
#define PROBE_MIXMASK 7
#endif
#define DI __device__ __forceinline__
typedef unsigned short u16;
using bf16x8 = __attribute__((ext_vector_type(8))) short;
using s16x4  = __attribute__((ext_vector_type(4))) short;
using f32x4  = __attribute__((ext_vector_type(4))) float;
using f32x16 = __attribute__((ext_vector_type(16))) float;

constexpr int NT = 512;
constexpr int TT = 12288;
constexpr int NU = 3456;
constexpr size_t LDS_BYTES = 131072 + 64;

constexpr size_t WS_CTL = 0;
constexpr size_t WS_MOD = 32768;
constexpr size_t WS_W   = WS_MOD + 491520;
constexpr size_t W_IN_B = 3584ull * 1024 * 2, W_OUT_B = 1024ull * 1024 * 2, W_FF_B = 4096ull * 1024 * 2;
constexpr size_t W_SLOT = W_IN_B + W_OUT_B + 2 * W_FF_B;
constexpr size_t WS_H   = WS_W + 2 * W_SLOT;
constexpr size_t WS_U   = WS_H + (size_t)TT * 1024 * 2;
constexpr size_t WS_MIXCAT = WS_U + (size_t)TT * NU * 2;
constexpr size_t WS_KL  = WS_MIXCAT + (size_t)TT * 1024 * 2;
constexpr size_t WS_VL  = WS_KL + 4ull * 2304 * 512 * 2;
constexpr size_t WS_RW  = WS_VL + 4ull * 2304 * 512 * 2;
constexpr size_t WS_G   = WS_RW + (size_t)TT * 4 * 9 * 64 * 4;
constexpr size_t WS_BC  = WS_G + (size_t)TT * 256 * 4;
constexpr size_t WS_HYT = WS_BC + (size_t)TT * 4 * 8 * 4;
constexpr size_t WS_FILT = WS_HYT + 3ull * 256 * TT * 4;
constexpr size_t WS_HSPEC = WS_FILT + 2ull * 256 * (512 + 4096) * 4;
constexpr size_t WS_ROPE = WS_HSPEC + 2ull * 256 * (512 + 4096) * 8;
constexpr size_t WS_WTL = WS_ROPE + 8192;
constexpr size_t WS_END = WS_WTL + 4ull * 256 * 384 * 2;
constexpr size_t WS_Q  = WS_H;
constexpr size_t WS_KC = WS_Q + (size_t)TT * 512 * 2;
constexpr size_t WS_VC = WS_KC + 16ull * 256 * 512 * 2;
constexpr size_t WS_YS = WS_U;
constexpr size_t WS_YC = WS_U + 2ull * TT * 256 * 4;
constexpr size_t WS_F  = WS_U;
constexpr size_t WS_A  = WS_RW;
static_assert(WS_VC + 16ull * 256 * 512 * 2 <= WS_U, "alias");
static_assert(WS_YC + 256ull * TT * 4 <= WS_MIXCAT, "alias");
static_assert((size_t)TT * 4096 * 2 <= (size_t)TT * 4 * 9 * 64 * 4, "alias");

constexpr size_t OUT_STATE = 12582912, OUT_CK = 14680064, OUT_CV = 23068672;

struct Params {
  const float* in[43];
  float* out;
  unsigned char* ws;
};

DI u16 f2bf(float x) { unsigned u = __float_as_uint(x); u += 0x7fffu + ((u >> 16) & 1u); return (u16)(u >> 16); }
DI float bf2f(u16 b) { return __uint_as_float(((unsigned)b) << 16); }
DI unsigned pack2(float a, float b) { return (unsigned)f2bf(a) | ((unsigned)f2bf(b) << 16); }
template <int CTRL> DI float dppf(float x) {
  return __builtin_bit_cast(float, __builtin_amdgcn_update_dpp(0, __builtin_bit_cast(int, x), CTRL, 0xF, 0xF, true));
}
DI float allreduce16(float x) {
  x += dppf<0xB1>(x); x += dppf<0x4E>(x); x += dppf<0x124>(x); x += dppf<0x128>(x);
  return x;
}
DI float wave_sum(float v) {
  v = allreduce16(v);
  const int iv = __builtin_bit_cast(int, v);
  const float a = __builtin_bit_cast(float, __builtin_amdgcn_readlane(iv, 0)), b = __builtin_bit_cast(float, __builtin_amdgcn_readlane(iv, 16));
  const float c = __builtin_bit_cast(float, __builtin_amdgcn_readlane(iv, 32)), d = __builtin_bit_cast(float, __builtin_amdgcn_readlane(iv, 48));
  return (a + b) + (c + d);
}
DI void seq_of(int row, int& s, int& t, int& L, int& row0) {
  if (row < 4096) { s = row >> 8; t = row & 255; L = 256; row0 = s * 256; }
  else { int r = row - 4096; s = 16 + (r >> 11); t = r & 2047; L = 2048; row0 = 4096 + (r >> 11) * 2048; }
}
DI unsigned cvtpk(float lo, float hi) { unsigned r; asm volatile("v_cvt_pk_bf16_f32 %0, %1, %2" : "=v"(r) : "v"(lo), "v"(hi)); return r; }
DI float ozero() { float z; asm volatile("v_mov_b32 %0, 0" : "=v"(z)); return z; }
DI float shfl32(float v, int lane) { return __builtin_bit_cast(float, __builtin_amdgcn_ds_bpermute((lane ^ 32) << 2, __builtin_bit_cast(int, v))); }
typedef unsigned u32x4_t __attribute__((ext_vector_type(4)));
DI uint4 ldnt_u4(const void* p) { const u32x4_t t = __builtin_nontemporal_load((const u32x4_t*)p); return make_uint4(t[0], t[1], t[2], t[3]); }
DI float4 ldnt_f4(const float* p) { const f32x4 t = __builtin_nontemporal_load((const f32x4*)p); return make_float4(t[0], t[1], t[2], t[3]); }
DI int otid() { int t = threadIdx.x; asm volatile("" : "+v"(t)); return t; }
DI float sigmoidf_(float x) { return 1.f / (1.f + expf(-x)); }
DI float fexp(float x) { return __builtin_amdgcn_exp2f(x * 1.4426950408889634f); }
DI float fsig(float x) { return __builtin_amdgcn_rcpf(1.f + fexp(-x)); }


#define XB_TMO      128
#define XB_XCNT(j)  (256  + 64 * (j))
#define XB_XSUB(j)  (1280 + 64 * (j))
#define XB_XGEN(j)  (2304 + 64 * (j))
#define XB_TOP      3328
#define XB_TOPGEN   3392
#define XB_SPIN_CAP (1u << 22)
#define LAS __attribute__((address_space(3)))
DI unsigned xb_ld(unsigned* p)              { return __hip_atomic_load(p, __ATOMIC_RELAXED, __HIP_MEMORY_SCOPE_AGENT); }
DI unsigned xb_add(unsigned* p, unsigned v) { return __hip_atomic_fetch_add(p, v, __ATOMIC_RELAXED, __HIP_MEMORY_SCOPE_AGENT); }
DI unsigned xb_xcc_id() { return (unsigned)__builtin_amdgcn_s_getreg((3 << 11) | 20) & 0xFu; }
#define XB_SPIN(cond, bar) do { unsigned _sp = 0; while (cond) { __builtin_amdgcn_s_sleep(1); \
    if ((++_sp & 255u) == 0u) { if (xb_ld(&(bar)[XB_TMO])) break; if (_sp > XB_SPIN_CAP) { atomicAdd(&(bar)[XB_TMO], 1u); break; } } } } while (0)
struct XcdBarrier { unsigned* bar; unsigned x; volatile LAS unsigned* st; };
DI XcdBarrier xcd_barrier_post(unsigned* bar, volatile LAS unsigned* st) {
  XcdBarrier b; b.bar = bar; b.x = xb_xcc_id(); b.st = st;
  if (threadIdx.x == 0) (void)xb_add(&bar[XB_XCNT(b.x)], 1u);
  return b;
}
DI void xcd_barrier_complete(unsigned* bar, unsigned x, unsigned& nloc, unsigned& nx) {
  const unsigned G = gridDim.x * gridDim.y * gridDim.z;
  unsigned sum, cnt, mine, sp = 0u;
  for (;;) {
    sum = 0u; cnt = 0u; mine = 0u;
#pragma unroll
    for (unsigned j = 0; j < 16; ++j) { const unsigned c = xb_ld(&bar[XB_XCNT(j)]); sum += c; cnt += (c > 0u) ? 1u : 0u; mine = (j == x) ? c : mine; }
    if (sum == G) break;
    __builtin_amdgcn_s_sleep(1);
    if ((++sp & 255u) == 0u) { if (xb_ld(&bar[XB_TMO])) break; if (sp > XB_SPIN_CAP) { atomicAdd(&bar[XB_TMO], 1u); break; } }
  }
  nloc = mine > 0u ? mine : 1u; nx = cnt > 0u ? cnt : 1u;
}
DI void xcd_barrier(const XcdBarrier& b) {
  asm volatile("s_waitcnt vmcnt(0)" ::: "memory");
  __syncthreads();
  if (threadIdx.x == 0) {
    unsigned* bar = b.bar;
    __builtin_amdgcn_s_waitcnt(0);
    unsigned nloc = b.st[0], nx = b.st[1];
    if (nloc == 0u) { xcd_barrier_complete(bar, b.x, nloc, nx); b.st[0] = nloc; b.st[1] = nx; }
    const unsigned old = xb_add(&bar[XB_XSUB(b.x)], 1u);
    const unsigned gen = old / nloc;
    if (old + 1u == (gen + 1u) * nloc) {
      __builtin_amdgcn_fence(__ATOMIC_RELEASE, "agent");
      asm volatile("s_waitcnt vmcnt(0)" ::: "memory");
      const unsigned og = xb_add(&bar[XB_TOP], 1u);
      const unsigned tg = og / nx;
      if (og + 1u == (tg + 1u) * nx) xb_add(&bar[XB_TOPGEN], 1u);
      else XB_SPIN(xb_ld(&bar[XB_TOPGEN]) == tg, bar);
      __builtin_amdgcn_fence(__ATOMIC_ACQUIRE, "agent");
      xb_add(&bar[XB_XGEN(b.x)], 1u);
      asm volatile("s_waitcnt vmcnt(0)" ::: "memory");
    } else {
      XB_SPIN(xb_ld(&bar[XB_XGEN(b.x)]) == gen, bar);
      __builtin_amdgcn_fence(__ATOMIC_ACQUIRE, "agent");
      asm volatile("s_waitcnt vmcnt(0)" ::: "memory");
    }
  }
  __syncthreads();
}

DI void tr_tile(const float* __restrict__ W, int K, int N, u16* __restrict__ Wt, int k0, int n0, float* lds) {
  const int tid = otid();
  float4 v[4];
#pragma unroll
  for (int i = 0; i < 4; ++i) { int idx = tid + i * 512; int kk = idx >> 5, n4 = (idx & 31) * 4; const f32x4 t_ = __builtin_nontemporal_load((const f32x4*)(W + (size_t)(k0 + kk) * N + n0 + n4)); v[i] = make_float4(t_[0], t_[1], t_[2], t_[3]); }
#pragma unroll
  for (int i = 0; i < 4; ++i) { int idx = tid + i * 512; int kk = idx >> 5, n4 = (idx & 31) * 4; float* d = lds + kk * 129 + n4; d[0] = v[i].x; d[1] = v[i].y; d[2] = v[i].z; d[3] = v[i].w; }
  __syncthreads();
#pragma unroll
  for (int hlf = 0; hlf < 2; ++hlf) {
    const int n = hlf * 64 + (tid >> 3), kg = tid & 7;
    unsigned pk[4];
#pragma unroll
    for (int j = 0; j < 4; ++j) pk[j] = pack2(lds[(kg * 8 + 2 * j) * 129 + n], lds[(kg * 8 + 2 * j + 1) * 129 + n]);
    { const u32x4_t t_ = {pk[0], pk[1], pk[2], pk[3]}; __builtin_nontemporal_store(t_, (u32x4_t*)(Wt + (size_t)(n0 + n) * K + k0 + kg * 8)); }
  }
  __syncthreads();
}

DI void filt_item(const Params& p, int l, int it, float* lds) {
  const int Lsel = it >= 32; const int chunk = Lsel ? it - 32 : it; const int L = Lsel ? 2048 : 256;
  float* emb = lds; float* h1 = lds + 8 * 36; float* h2 = h1 + 512;
  const int tid = otid();
  const float* w1 = p.in[32] + l * 33 * 64; const float* b1 = p.in[33] + l * 64; const float* fr = p.in[34] + l * 64;
  const float* w2 = p.in[35] + l * 4096; const float* b2 = p.in[36] + l * 64; const float* w3 = p.in[37] + (size_t)l * 64 * 1024;
  const float* dec = p.in[38] + l * 256;
  if (tid < 8 * 33) {
    int ti = tid / 33, j = tid % 33; int i = chunk * 8 + ti; float v;
    float ang = (float)(2.0 * 3.14159265358979323846 / (double)L) * (float)i;
    if (j == 0) v = (float)i / (float)(L - 1);
    else if (j <= 16) { float band = 1e-4f + (float)(j - 1) * ((15.f - 1e-4f) / 15.f); v = cosf(band * ang); }
    else { float band = 1e-4f + (float)(j - 17) * ((15.f - 1e-4f) / 15.f); v = -sinf(band * ang); }
    emb[ti * 36 + j] = v;
  }
  __syncthreads();
  { int ti = tid >> 6, j = tid & 63; float a = b1[j];
    for (int k = 0; k < 32; k += 4) { const float q0 = w1[k * 64 + j], q1 = w1[(k + 1) * 64 + j], q2 = w1[(k + 2) * 64 + j], q3 = w1[(k + 3) * 64 + j];
      a += emb[ti * 36 + k] * q0 + emb[ti * 36 + k + 1] * q1 + emb[ti * 36 + k + 2] * q2 + emb[ti * 36 + k + 3] * q3; }
    a += emb[ti * 36 + 32] * w1[32 * 64 + j];
    h1[ti * 64 + j] = sinf(fr[j] * a); }
  __syncthreads();
  { int ti = tid >> 6, j = tid & 63; float a = b2[j];
#pragma unroll 2
    for (int k = 0; k < 64; k += 4) { const float q0 = w2[k * 64 + j], q1 = w2[(k + 1) * 64 + j], q2 = w2[(k + 2) * 64 + j], q3 = w2[(k + 3) * 64 + j];
      const float4 hv = *(const float4*)(h1 + ti * 64 + k); a += hv.x * q0 + hv.y * q1 + hv.z * q2 + hv.w * q3; }
    h2[ti * 64 + j] = sinf(fr[j] * a); }
  __syncthreads();
  float* FILT = (float*)(p.ws + WS_FILT) + (Lsel ? 262144 : 0);
  {
    float acc[2][8];
#pragma unroll
    for (int ti = 0; ti < 8; ++ti) { acc[0][ti] = 0.f; acc[1][ti] = 0.f; }
#pragma unroll 2
    for (int k = 0; k < 64; k += 4) {
      const float2 q0 = *(const float2*)(w3 + k * 1024 + 2 * tid), q1 = *(const float2*)(w3 + (k + 1) * 1024 + 2 * tid);
      const float2 q2 = *(const float2*)(w3 + (k + 2) * 1024 + 2 * tid), q3 = *(const float2*)(w3 + (k + 3) * 1024 + 2 * tid);
#pragma unroll
      for (int ti = 0; ti < 8; ++ti) { const float4 hv = *(const float4*)(h2 + ti * 64 + k);
        acc[0][ti] += hv.x * q0.x + hv.y * q1.x + hv.z * q2.x + hv.w * q3.x;
        acc[1][ti] += hv.x * q0.y + hv.y * q1.y + hv.z * q2.y + hv.w * q3.y; }
    }
#pragma unroll
    for (int cc = 0; cc < 2; ++cc) {
      const int col = 2 * tid + cc;
      int order = col >> 9, dir = (col >> 8) & 1, c = col & 255; float dc = fabsf(dec[c]);
      float* g = FILT + (size_t)(order * 256 + c) * (2 * L);
#pragma unroll
      for (int ti = 0; ti < 8; ++ti) {
        int i = chunk * 8 + ti; float t = (float)i / (float)(L - 1); float val = acc[cc][ti] * expf(-t * dc);
        if (dir == 0) g[L + i] = val; else { if (i == 0) g[0] = 0.f; else g[L - i] = val; }
      }
    }
  }
  __syncthreads();
}

constexpr int AUX_ITEMS = 432 + 128 + 512 + 512 + 1 + 288;
DI void aux_item(const Params& p, int l, int it, float* lds) {
  unsigned char* slot = p.ws + WS_W + (size_t)(l & 1) * W_SLOT;
  u16* win = (u16*)slot; u16* wout = (u16*)(slot + W_IN_B); u16* wff1 = (u16*)(slot + W_IN_B + W_OUT_B); u16* wff2 = (u16*)(slot + W_IN_B + W_OUT_B + W_FF_B);
  if (it < 432) { int kt = it / 27, nt = it % 27; tr_tile(p.in[13] + (size_t)l * 1024 * NU, 1024, NU, win, kt * 64, nt * 128, lds); return; }
  it -= 432;
  if (it < 128) { int kt = it >> 3, nt = it & 7; tr_tile(p.in[40] + (size_t)l * 1024 * 1024, 1024, 1024, wout, kt * 64, nt * 128, lds); return; }
  it -= 128;
  if (it < 512) { int kt = it >> 5, nt = it & 31; tr_tile(p.in[41] + (size_t)l * 1024 * 4096, 1024, 4096, wff1, kt * 64, nt * 128, lds); return; }
  it -= 512;
  if (it < 512) { int kt = it >> 3, nt = it & 7; tr_tile(p.in[42] + (size_t)l * 4096 * 1024, 4096, 1024, wff2, kt * 64, nt * 128, lds); return; }
  it -= 512;
  if (it < 1) { uint4* z = (uint4*)(win + (size_t)NU * 1024); for (int i = otid(); i < 16384; i += 512) z[i] = make_uint4(0, 0, 0, 0); return; }
  it -= 1;
  filt_item(p, l, it, lds);
}

DI void mod_item(const Params& p, int it, float* lds) {
  const int l = it / 96, cgp = it % 96, tid = otid();
  float* sc = lds; float* red = lds + 5120;
  for (int i = tid; i < 5120; i += 512) { int j = i >> 10, k = i & 1023; float c = (j == 0) ? p.in[6][k] : p.in[5][(j - 1) * 1024 + k]; sc[i] = c / (1.f + expf(-c)); }
  __syncthreads();
  const int c4 = (tid & 15) * 4, kg = tid >> 4; const float* w = p.in[7] + (size_t)l * 1024 * 6144 + cgp * 64 + c4;
  float4 acc[5];
#pragma unroll
  for (int j = 0; j < 5; ++j) acc[j] = make_float4(0.f, 0.f, 0.f, 0.f);
#pragma unroll 8
  for (int k = kg; k < 1024; k += 32) { const f32x4 wt_ = __builtin_nontemporal_load((const f32x4*)(w + (size_t)k * 6144)); const float4 wv = make_float4(wt_[0], wt_[1], wt_[2], wt_[3]);
#pragma unroll
    for (int j = 0; j < 5; ++j) { const float sv = sc[j * 1024 + k]; acc[j].x += sv * wv.x; acc[j].y += sv * wv.y; acc[j].z += sv * wv.z; acc[j].w += sv * wv.w; } }
#pragma unroll
  for (int j = 0; j < 5; ++j) *(float4*)(red + (kg * 5 + j) * 64 + c4) = acc[j];
  __syncthreads();
  if (tid < 320) { int j = tid >> 6, cc = tid & 63; float sm = 0.f; for (int g = 0; g < 32; ++g) sm += red[(g * 5 + j) * 64 + cc];
    sm += p.in[8][l * 6144 + cgp * 64 + cc]; ((float*)(p.ws + WS_MOD))[(l * 5 + j) * 6144 + cgp * 64 + cc] = sm; }
  __syncthreads();
}

DI void row_phase(const Params& p, int l, int mode) {
  const int tid = otid(), lane = tid & 63; const int gw = blockIdx.x * 8 + (tid >> 6), nw = gridDim.x * 8;
  float* x = p.out; const u16* F = (const u16*)(p.ws + WS_F); u16* H = (u16*)(p.ws + WS_H); const float* MOD = (const float*)(p.ws + WS_MOD);
  const float* gpost = nullptr; const float* gpre = nullptr; int gate_ch = 0, sc_ch = 0, sh_ch = 0, lm = l; bool do_h = true;
  if (mode == 0) { gpre = p.in[9] + l * 1024; sc_ch = 1; sh_ch = 0; lm = l; }
  else if (mode == 1) { gpost = p.in[10] + l * 1024; gate_ch = 2; gpre = p.in[11] + l * 1024; sc_ch = 4; sh_ch = 3; lm = l; }
  else { gpost = p.in[12] + l * 1024; gate_ch = 5; if (l < 3) { gpre = p.in[9] + (l + 1) * 1024; sc_ch = 1; sh_ch = 0; lm = l + 1; } else do_h = false; }
  const int rpw = (TT + nw - 1) / nw;
  float4 fa[4], fb[4], fc[4]; int jprev = -1;
#pragma unroll
  for (int i = 0; i < 4; ++i) { fa[i] = make_float4(0.f, 0.f, 0.f, 0.f); fb[i] = fa[i]; fc[i] = fa[i]; }
  for (int rr = 0; rr < rpw; ++rr) {
    const int row = gw * rpw + rr; if (row >= TT) break;
    const int j = row < 4096 ? 0 : 1 + ((row - 4096) >> 11);
    if (j != jprev) {
      jprev = j;
#pragma unroll
      for (int i = 0; i < 4; ++i) {
        const int col = i * 256 + lane * 4;
        if (mode != 0) { const float4 g4 = *(const float4*)(MOD + (l * 5 + j) * 6144 + gate_ch * 1024 + col); const float4 p4 = *(const float4*)(gpost + col);
          fa[i] = make_float4(g4.x * p4.x, g4.y * p4.y, g4.z * p4.z, g4.w * p4.w); }
        if (do_h) { const float4 g4 = *(const float4*)(gpre + col); const float4 s4 = *(const float4*)(MOD + (lm * 5 + j) * 6144 + sc_ch * 1024 + col);
          fb[i] = make_float4(g4.x * (1.f + s4.x), g4.y * (1.f + s4.y), g4.z * (1.f + s4.z), g4.w * (1.f + s4.w));
          fc[i] = *(const float4*)(MOD + (lm * 5 + j) * 6144 + sh_ch * 1024 + col); }
      }
    }
    const float* xs = (mode == 0) ? (row < 4096 ? p.in[0] + (size_t)row * 1024 : p.in[1] + (size_t)(row - 4096) * 1024) : x + (size_t)row * 1024;
    float4 xv[4];
#pragma unroll
    for (int i = 0; i < 4; ++i) xv[i] = ldnt_f4(xs + i * 256 + lane * 4);
    if (mode != 0) {
      float4 dv[4]; float ss = 0.f;
#pragma unroll
      for (int i = 0; i < 4; ++i) { const unsigned long long fq_ = __builtin_nontemporal_load((const unsigned long long*)(F + (size_t)row * 1024 + i * 256 + lane * 4)); const uint2 fw = make_uint2((unsigned)fq_, (unsigned)(fq_ >> 32)); dv[i] = make_float4(bf2f((u16)fw.x), bf2f((u16)(fw.x >> 16)), bf2f((u16)fw.y), bf2f((u16)(fw.y >> 16))); ss += dv[i].x * dv[i].x + dv[i].y * dv[i].y + dv[i].z * dv[i].z + dv[i].w * dv[i].w; }
      ss = wave_sum(ss); const float rs = rsqrtf(ss * (1.f / 1024.f) + 1e-6f);
#pragma unroll
      for (int i = 0; i < 4; ++i) { xv[i].x += fa[i].x * dv[i].x * rs; xv[i].y += fa[i].y * dv[i].y * rs; xv[i].z += fa[i].z * dv[i].z * rs; xv[i].w += fa[i].w * dv[i].w * rs; }
    }
#pragma unroll
    for (int i = 0; i < 4; ++i) { const f32x4 t_ = {xv[i].x, xv[i].y, xv[i].z, xv[i].w}; __builtin_nontemporal_store(t_, (f32x4*)(x + (size_t)row * 1024 + i * 256 + lane * 4)); }
    if (do_h) {
      float ss = 0.f;
#pragma unroll
      for (int i = 0; i < 4; ++i) ss += xv[i].x * xv[i].x + xv[i].y * xv[i].y + xv[i].z * xv[i].z + xv[i].w * xv[i].w;
      ss = wave_sum(ss); const float rs = rsqrtf(ss * (1.f / 1024.f) + 1e-6f);
#pragma unroll
      for (int i = 0; i < 4; ++i) { const int col = i * 256 + lane * 4;
        const float a = xv[i].x * rs * fb[i].x + fc[i].x, b2 = xv[i].y * rs * fb[i].y + fc[i].y, c = xv[i].z * rs * fb[i].z + fc[i].z, d = xv[i].w * rs * fb[i].w + fc[i].w;
        *(uint2*)(H + (size_t)row * 1024 + col) = make_uint2(pack2(a, b2), pack2(c, d)); }
    }
  }
}

template <int EPI>
DI void gemm_phase(const Params& p, const u16* __restrict__ A, const u16* __restrict__ Wt, int K, int NTn, int l, void* Cout, int ldc, unsigned char* smem) {
  u16* As = (u16*)smem; u16* Bs = As + 2 * 128 * 72;
  const int tid = otid(), lane = tid & 63, wid = tid >> 6, wm = wid & 1, wn = wid >> 1, fr = lane & 15, fq = lane >> 4;
  const int ntiles = 96 * NTn, nk = K / 64;
  for (int tile = blockIdx.x; tile < ntiles; tile += gridDim.x) {
    const int mt = tile / NTn, nt = tile % NTn; const int m0 = mt * 128, n0 = nt * 256;
    f32x4 acc[4][4];
#pragma unroll
    for (int i = 0; i < 4; ++i)
#pragma unroll
      for (int j = 0; j < 4; ++j) acc[i][j] = f32x4{0.f, 0.f, 0.f, 0.f};
    uint4 pa0, pa1, pb0, pb1, pb2, pb3, qa0, qa1, qb0, qb1, qb2, qb3;
    const int lrow = tid >> 3, lkc = tid & 7;
    const u16* ag = A + (size_t)(m0 + lrow) * K + lkc * 8;
    const u16* bg = Wt + (size_t)(n0 + lrow) * K + lkc * 8;
#define GLOAD(P, kt) { P##a0 = *(const uint4*)(ag + (kt) * 64); P##a1 = *(const uint4*)(ag + (size_t)64 * K + (kt) * 64); \
      P##b0 = *(const uint4*)(bg + (kt) * 64); P##b1 = *(const uint4*)(bg + (size_t)64 * K + (kt) * 64); \
      P##b2 = *(const uint4*)(bg + (size_t)128 * K + (kt) * 64); P##b3 = *(const uint4*)(bg + (size_t)192 * K + (kt) * 64); }
#define SSTORE(P, buf) { u16* sa_ = As + (buf) * 128 * 72 + lrow * 72 + lkc * 8; u16* sb_ = Bs + (buf) * 256 * 72 + lrow * 72 + lkc * 8; \
      *(uint4*)sa_ = P##a0; *(uint4*)(sa_ + 64 * 72) = P##a1; *(uint4*)sb_ = P##b0; *(uint4*)(sb_ + 64 * 72) = P##b1; *(uint4*)(sb_ + 128 * 72) = P##b2; *(uint4*)(sb_ + 192 * 72) = P##b3; }
#define COMPUTE(buf) { const u16* as = As + (buf) * 128 * 72 + (wm * 64 + fr) * 72 + fq * 8; const u16* bs = Bs + (buf) * 256 * 72 + (wn * 64 + fr) * 72 + fq * 8; \
      _Pragma("unroll") for (int ks = 0; ks < 2; ++ks) { bf16x8 wf[4], af[4]; \
        _Pragma("unroll") for (int i = 0; i < 4; ++i) { wf[i] = *(const bf16x8*)(bs + i * 16 * 72 + ks * 32); af[i] = *(const bf16x8*)(as + i * 16 * 72 + ks * 32); } \
        _Pragma("unroll") for (int i = 0; i < 4; ++i) _Pragma("unroll") for (int j = 0; j < 4; ++j) acc[i][j] = __builtin_amdgcn_mfma_f32_16x16x32_bf16(wf[i], af[j], acc[i][j], 0, 0, 0); } }
    GLOAD(p, 0); SSTORE(p, 0);
    GLOAD(p, 1); GLOAD(q, 2);
    __syncthreads();
    for (int kt = 0; kt < nk; kt += 2) {
      SSTORE(p, 1);
      if (kt + 3 < nk) GLOAD(p, kt + 3);
      COMPUTE(0);
      __syncthreads();
      if (kt + 2 < nk) SSTORE(q, 0);
      if (kt + 4 < nk) GLOAD(q, kt + 4);
      COMPUTE(1);
      __syncthreads();
    }
#undef GLOAD
#undef SSTORE
#undef COMPUTE
#pragma unroll
    for (int i = 0; i < 4; ++i)
#pragma unroll
      for (int j = 0; j < 4; ++j) {
        const int row = m0 + wm * 64 + j * 16 + fr; const int col = n0 + wn * 64 + i * 16 + fq * 4; const f32x4 v = acc[i][j];
        if (EPI == 0) {
          if (col < NU) {
            *(uint2*)((u16*)Cout + (size_t)row * NU + col) = make_uint2(pack2(v[0], v[1]), pack2(v[2], v[3]));
            if (row < 4096 && col >= 1664 && col < 2688) {
              int b = row >> 8, t = row & 255;
              float* dst = (col < 2176) ? p.out + OUT_CK + ((size_t)((b * 4 + l) * 256 + t)) * 512 + (col - 1664)
                                        : p.out + OUT_CV + ((size_t)((b * 4 + l) * 256 + t)) * 512 + (col - 2176);
              *(float4*)dst = make_float4(v[0], v[1], v[2], v[3]);
            }
          }
        } else if (EPI == 1) {
          *(float4*)((float*)Cout + (size_t)row * ldc + col) = make_float4(v[0], v[1], v[2], v[3]);
        } else {
          float a = fmaxf(v[0], 0.f), b = fmaxf(v[1], 0.f), c = fmaxf(v[2], 0.f), d = fmaxf(v[3], 0.f);
          *(uint2*)((u16*)Cout + (size_t)row * ldc + col) = make_uint2(pack2(a * a, b * b), pack2(c * c, d * d));
        }
      }
  }
}

namespace pg8 {
#define PG8_LAS __attribute__((address_space(3)))
typedef unsigned short bf16_t;
typedef short bf16x8 __attribute__((ext_vector_type(8)));
typedef float f32x4 __attribute__((ext_vector_type(4)));
typedef unsigned u32x4 __attribute__((ext_vector_type(4)));
constexpr int BM = 256, BK = 64, HALF = 128, HTB = HALF * BK * 2  , STAGE_BYTES = 8 * HTB, NXCD = 8, WGM = 8;

__host__ __device__ __forceinline__ int lds_byte(int r, int c) { const int st = (r >> 4) * 2 + (c >> 5), rr = r & 15, cc = c & 31, ob = rr * 64 + cc * 2; return st * 1024 + (ob ^ (((ob >> 9) & 1) << 5)); }
__host__ __device__ __forceinline__ void stage_rc(int b, int& R, int& C) { const int st = b / 1024, sb = b % 1024, swz = sb ^ (((sb >> 9) & 1) << 5); R = (st >> 1) * 16 + swz / 64; C = (st & 1) * 32 + (swz % 64) / 2; }
__host__ __device__ __forceinline__ int perm32(int rho) { const int n = rho >> 4, i = rho & 15; return 8 * (i >> 2) + 4 * n + (i & 3); }

struct Unit { int pm, pn; };
struct Gemm { const bf16_t* A; const bf16_t* Bt; int M, N, K; };
struct StaticOrder {
    int nM, nN, nwg, G, c;
    __host__ __device__ void init(int M, int N, int G_, int c_) { nM = M / BM; nN = N / BM; nwg = nM * nN; G = G_; c = c_; }
    __host__ __device__ bool next(int i, Unit& u) const {
        const long L = (long)i * G + c; if (L >= nwg) return false;
        int wgid = (int)L; { const int q = nwg / NXCD, r = nwg % NXCD, xcd = wgid % NXCD, off = wgid / NXCD; wgid = (xcd < r ? xcd * (q + 1) : r * (q + 1) + (xcd - r) * q) + off; }
        const int nig = WGM * nN, gid = wgid / nig, fm = gid * WGM, gsz = (nM - fm) < WGM ? (nM - fm) : WGM;
        u.pm = fm + ((wgid % nig) % gsz); u.pn = (wgid % nig) / gsz; return true;
    }
    __device__ __forceinline__ void a_ready(const Unit&) const {}
    __device__ __forceinline__ void done(const Unit&) const {}
};
__device__ __forceinline__ unsigned cvt_pk_bf16(float lo, float hi) { unsigned r; asm volatile("v_cvt_pk_bf16_f32 %0, %1, %2" : "=v"(r) : "v"(lo), "v"(hi)); return r; }
template <class Epi, class Sched, bool STAMP = false>
__device__ __forceinline__ void gemm_phase(PG8_LAS unsigned char* lds, const Gemm g, const Sched& S, const Epi& E, unsigned long long* stamps) {
    const int tid = otid(), wid = __builtin_amdgcn_readfirstlane(tid >> 6), lane = tid & 63, wr = wid >> 2, wc = wid & 3, fr = lane & 15, fq = lane >> 4;
    const int K = g.K, nt = K / BK;
    int ts_lo = 0, ts_hi = 0, nts = 0; const unsigned long long rt_entry = STAMP ? (unsigned long long)wall_clock64() : 0ull;
#define PG8_STAMP() do { if (STAMP && wid == 0 && nts < 64) { const unsigned long long _c = (unsigned long long)clock64(); \
        ts_lo = (lane == nts) ? (int)(unsigned)_c : ts_lo; ts_hi = (lane == nts) ? (int)(unsigned)(_c >> 32) : ts_hi; ++nts; } } while (0)
    PG8_STAMP();
    unsigned voffA[2], voffB[2];
#pragma unroll
    for (int i = 0; i < 2; ++i) { int R, C; stage_rc(tid * 16 + i * 8192, R, C); const int Rb = Epi::PERM ? ((R & ~31) + perm32(R & 31)) : R;
        voffA[i] = (unsigned)(R * K + C) * 2u; voffB[i] = (unsigned)(Rb * K + C) * 2u; }
    const size_t kstep = (size_t)(BK * 2);
    const size_t hstep = (size_t)HALF * K * 2;
    const size_t tstep = 2 * hstep;
    const unsigned ldsw = (unsigned)wid * 1024u;
    const int aoff = lds_byte(wr * 64 + fr, fq * 8), boff = lds_byte(wc * 32 + fr, fq * 8);
#define PG8_SA(b, h) (((b) * 2 + (h)) * HTB)
#define PG8_SB(b, h) ((4 + (b) * 2 + (h)) * HTB)
#define PG8_STAGE(bufoff, gbase, voff) do { _Pragma("unroll") for (int _i = 0; _i < 2; ++_i) \
        __builtin_amdgcn_global_load_lds((const unsigned*)((const char*)(gbase) + (voff)[_i]), (PG8_LAS unsigned*)(lds + (bufoff) + ldsw + _i * 8192), 16, 0, 0); } while (0)
#define PG8_LDA(dst, b, h) do { _Pragma("unroll") for (int m = 0; m < 4; ++m) _Pragma("unroll") for (int k = 0; k < 2; ++k) dst[m][k] = *(const PG8_LAS bf16x8*)(lds + PG8_SA(b, h) + aoff + m * 2048 + k * 1024); } while (0)
#define PG8_LDB(dst, b, h) do { _Pragma("unroll") for (int n = 0; n < 2; ++n) _Pragma("unroll") for (int k = 0; k < 2; ++k) dst[n][k] = *(const PG8_LAS bf16x8*)(lds + PG8_SB(b, h) + boff + n * 2048 + k * 1024); } while (0)
#define PG8_MMA(ai, bj, At, Bt) do { __builtin_amdgcn_s_setprio(1); _Pragma("unroll") for (int m = 0; m < 4; ++m) _Pragma("unroll") for (int n = 0; n < 2; ++n) _Pragma("unroll") for (int k = 0; k < 2; ++k) \
        acc[ai][bj][m][n] = __builtin_amdgcn_mfma_f32_16x16x32_bf16(Bt[n][k], At[m][k], acc[ai][bj][m][n], 0, 0, 0); __builtin_amdgcn_s_setprio(0); } while (0)
#define PG8_WAIT_V(n) asm volatile("s_waitcnt vmcnt(" #n ")" ::: "memory")
#define PG8_WAIT_L(n) asm volatile("s_waitcnt lgkmcnt(" #n ")" ::: "memory")
#define PG8_BAR __builtin_amdgcn_s_barrier()
#define PG8_SCHED __builtin_amdgcn_sched_barrier(0)
    Unit cur, nxt; int ui = 0;
    if (!S.next(0, cur)) return;
    f32x4 acc[2][2][4][2];
#pragma unroll
    for (int a = 0; a < 2; ++a)
#pragma unroll
        for (int b = 0; b < 2; ++b)
#pragma unroll
            for (int m = 0; m < 4; ++m)
#pragma unroll
                for (int n = 0; n < 2; ++n) { const float z_ = ozero(); acc[a][b][m][n] = (f32x4){z_, z_, z_, z_}; }
    bf16x8 At[4][2], B0[2][2], B1[2][2];
    const char* cA = (const char*)g.A + (size_t)cur.pm * tstep; const char* cB = (const char*)g.Bt + (size_t)cur.pn * tstep;
    S.a_ready(cur);
    PG8_STAGE(PG8_SB(0, 0), cB, voffB); PG8_STAGE(PG8_SA(0, 0), cA, voffA); PG8_STAGE(PG8_SB(0, 1), cB + hstep, voffB); PG8_STAGE(PG8_SA(0, 1), cA + hstep, voffA);
    if (wr == 1) PG8_BAR;
    PG8_WAIT_V(4); PG8_BAR;
    PG8_STAGE(PG8_SB(1, 0), cB + kstep, voffB); PG8_STAGE(PG8_SA(1, 0), cA + kstep, voffA); PG8_STAGE(PG8_SB(1, 1), cB + hstep + kstep, voffB);
    PG8_WAIT_V(6); PG8_BAR;
    PG8_STAMP();
    for (;;) {
        const bool has_next = S.next(ui + 1, nxt);
        const char* nA = has_next ? (const char*)g.A + (size_t)nxt.pm * tstep : cA; const char* nB = has_next ? (const char*)g.Bt + (size_t)nxt.pn * tstep : cB;
        for (int t = 0; t < nt; t += 2) {
            const bool last = (t == nt - 2);
            const char* a1 = cA + (size_t)(t + 1) * kstep;
            const char* a2 = last ? nA : cA + (size_t)(t + 2) * kstep; const char* b2 = last ? nB : cB + (size_t)(t + 2) * kstep;
            const char* a3 = a2 + kstep; const char* b3 = b2 + kstep;
            if (last && has_next) S.a_ready(nxt);
            PG8_LDB(B0, 0, 0); PG8_SCHED; PG8_LDA(At, 0, 0); PG8_STAGE(PG8_SA(1, 1), a1 + hstep, voffA);
            PG8_WAIT_L(8); PG8_BAR; PG8_WAIT_L(0); PG8_MMA(0, 0, At, B0); PG8_BAR; PG8_SCHED;
            PG8_LDB(B1, 0, 1); PG8_STAGE(PG8_SB(0, 0), b2, voffB);
            PG8_BAR; PG8_WAIT_L(0); PG8_MMA(0, 1, At, B1); PG8_BAR;
            PG8_LDA(At, 0, 1); PG8_STAGE(PG8_SA(0, 0), a2, voffA);
            PG8_BAR; PG8_WAIT_L(0); PG8_MMA(1, 0, At, B0); PG8_BAR; PG8_SCHED;
            PG8_STAGE(PG8_SB(0, 1), b2 + hstep, voffB);
            PG8_WAIT_V(6); PG8_BAR; PG8_MMA(1, 1, At, B1); PG8_BAR;
            PG8_LDB(B0, 1, 0); PG8_SCHED; PG8_LDA(At, 1, 0); PG8_STAGE(PG8_SA(0, 1), a2 + hstep, voffA);
            PG8_WAIT_L(8); PG8_BAR; PG8_WAIT_L(0); PG8_MMA(0, 0, At, B0); PG8_BAR; PG8_SCHED;
            PG8_LDB(B1, 1, 1); PG8_STAGE(PG8_SB(1, 0), b3, voffB);
            PG8_BAR; PG8_WAIT_L(0); PG8_MMA(0, 1, At, B1); PG8_BAR;
            PG8_LDA(At, 1, 1); PG8_STAGE(PG8_SA(1, 0), a3, voffA);
            PG8_BAR; PG8_WAIT_L(0); PG8_MMA(1, 0, At, B0); PG8_BAR; PG8_SCHED;
            PG8_STAGE(PG8_SB(1, 1), b3 + hstep, voffB);
            PG8_WAIT_V(6); PG8_BAR; PG8_MMA(1, 1, At, B1); PG8_BAR;
        }
        PG8_STAMP();
        if constexpr (!Epi::AFTER_DRAIN) { E(acc, cur, wr, wc, fr, fq); S.done(cur); }
        PG8_STAMP();
        if (!has_next) break;
#pragma unroll
        for (int a = 0; a < 2; ++a)
#pragma unroll
            for (int b = 0; b < 2; ++b)
#pragma unroll
                for (int m = 0; m < 4; ++m)
#pragma unroll
                    for (int n = 0; n < 2; ++n) { const float z_ = ozero(); acc[a][b][m][n] = (f32x4){z_, z_, z_, z_}; }
        cur = nxt; cA = nA; cB = nB; ++ui;
    }
    PG8_WAIT_V(0);
    if (wr == 0) PG8_BAR;
    PG8_BAR;
    if constexpr (Epi::AFTER_DRAIN) { E.fused(acc, cur, wr, wc, fr, fq, lds, wid, lane); S.done(cur); }
    PG8_STAMP();
    if (STAMP && wid == 0) { stamps[lane] = lane < nts ? (((unsigned long long)(unsigned)ts_hi << 32) | (unsigned)ts_lo) : 0ull;
        if (lane == 62) stamps[62] = rt_entry; if (lane == 63) stamps[63] = (unsigned long long)wall_clock64(); }
#undef PG8_STAMP
#undef PG8_SA
#undef PG8_SB
#undef PG8_STAGE
#undef PG8_LDA
#undef PG8_LDB
#undef PG8_MMA
#undef PG8_WAIT_V
#undef PG8_WAIT_L
#undef PG8_BAR
#undef PG8_SCHED
}

struct EpiF32 {
    static constexpr bool PERM = false, AFTER_DRAIN = false;
    float* C; int ldc;
    __device__ __forceinline__ void operator()(const f32x4 (&acc)[2][2][4][2], const Unit& u, int wr, int wc, int fr, int fq) const {
        const int row0 = u.pm * BM + wr * 64 + fr, col0 = u.pn * BM + wc * 32 + 4 * fq;
#pragma unroll
        for (int ai = 0; ai < 2; ++ai)
#pragma unroll
            for (int m = 0; m < 4; ++m) { float* rowp = C + (size_t)(row0 + ai * HALF + m * 16) * ldc + col0;
#pragma unroll
                for (int bj = 0; bj < 2; ++bj)
#pragma unroll
                    for (int n = 0; n < 2; ++n) *(f32x4*)(rowp + bj * HALF + n * 16) = acc[ai][bj][m][n]; }
    }
};
struct EpiBf {
    static constexpr bool PERM = true, AFTER_DRAIN = false;
    bf16_t* O; int ldc;
    __device__ __forceinline__ void operator()(const f32x4 (&acc)[2][2][4][2], const Unit& u, int wr, int wc, int fr, int fq) const {
        const int row0 = u.pm * BM + wr * 64 + fr, col0 = u.pn * BM + wc * 32 + 8 * fq;
#pragma unroll
        for (int ai = 0; ai < 2; ++ai)
#pragma unroll
            for (int m = 0; m < 4; ++m) { bf16_t* rowp = O + (size_t)(row0 + ai * HALF + m * 16) * ldc + col0;
#pragma unroll
                for (int bj = 0; bj < 2; ++bj) { const f32x4 v0 = acc[ai][bj][m][0], v1 = acc[ai][bj][m][1];
                    u32x4 w; w.x = cvt_pk_bf16(v0[0], v0[1]); w.y = cvt_pk_bf16(v0[2], v0[3]); w.z = cvt_pk_bf16(v1[0], v1[1]); w.w = cvt_pk_bf16(v1[2], v1[3]);
                    *(u32x4*)(rowp + bj * HALF) = w; } }
    }
};
struct EpiRelu2 {
    static constexpr bool PERM = true, AFTER_DRAIN = false;
    bf16_t* O; int ldc;
    __device__ __forceinline__ void operator()(const f32x4 (&acc)[2][2][4][2], const Unit& u, int wr, int wc, int fr, int fq) const {
        const int row0 = u.pm * BM + wr * 64 + fr, col0 = u.pn * BM + wc * 32 + 8 * fq;
#pragma unroll
        for (int ai = 0; ai < 2; ++ai)
#pragma unroll
            for (int m = 0; m < 4; ++m) { bf16_t* rowp = O + (size_t)(row0 + ai * HALF + m * 16) * ldc + col0;
#pragma unroll
                for (int bj = 0; bj < 2; ++bj) { f32x4 v0 = acc[ai][bj][m][0], v1 = acc[ai][bj][m][1];
#pragma unroll
                    for (int j = 0; j < 4; ++j) { float a = fmaxf(v0[j], 0.f), b = fmaxf(v1[j], 0.f); v0[j] = a * a; v1[j] = b * b; }
                    u32x4 w; w.x = cvt_pk_bf16(v0[0], v0[1]); w.y = cvt_pk_bf16(v0[2], v0[3]); w.z = cvt_pk_bf16(v1[0], v1[1]); w.w = cvt_pk_bf16(v1[2], v1[3]);
                    *(u32x4*)(rowp + bj * HALF) = w; } }
    }
};
struct EpiU {
    static constexpr bool PERM = true, AFTER_DRAIN = false;
    bf16_t* O; float* out; int l;
    __device__ __forceinline__ void operator()(const f32x4 (&acc)[2][2][4][2], const Unit& u, int wr, int wc, int fr, int fq) const {
        const int row0 = u.pm * BM + wr * 64 + fr, col0 = u.pn * BM + wc * 32 + 8 * fq;
#pragma unroll
        for (int ai = 0; ai < 2; ++ai)
#pragma unroll
            for (int m = 0; m < 4; ++m) { const int row = row0 + ai * HALF + m * 16;
#pragma unroll
                for (int bj = 0; bj < 2; ++bj) { const int col = col0 + bj * HALF; const f32x4 v0 = acc[ai][bj][m][0], v1 = acc[ai][bj][m][1];
                    if (col < 3456) {
                        u32x4 w; w.x = cvt_pk_bf16(v0[0], v0[1]); w.y = cvt_pk_bf16(v0[2], v0[3]); w.z = cvt_pk_bf16(v1[0], v1[1]); w.w = cvt_pk_bf16(v1[2], v1[3]);
                        *(u32x4*)(O + (size_t)row * 3456 + col) = w;
                        if (row < 4096 && col >= 1664 && col < 2688) {
                            const int b = row >> 8, t = row & 255;
                            float* dst = (col < 2176) ? out + 14680064 + ((size_t)((b * 4 + l) * 256 + t)) * 512 + (col - 1664)
                                                      : out + 23068672 + ((size_t)((b * 4 + l) * 256 + t)) * 512 + (col - 2176);
                            __builtin_nontemporal_store(v0, (f32x4*)dst); __builtin_nontemporal_store(v1, (f32x4*)(dst + 4));
                        }
                    } } }
    }
};
}

DI void rwkv_prep_item(const Params& p, int l, int tile, float* lds) {
  const int tid = otid(), lane = tid & 63, wid = tid >> 6, fr = lane & 15, fq = lane >> 4;
  const int rowb = tile * 32; int s, t0, L, row0; seq_of(rowb, s, t0, L, row0);
  const u16* U = (const u16*)(p.ws + WS_U);
  u16* X = (u16*)lds;
  for (int ch = tid; ch < 32 * 48; ch += 512) {
    const int tok = ch / 48, c8 = (ch % 48) * 8;
    const uint4 raw = ldnt_u4(U + (size_t)(rowb + tok) * NU + 768 + c8);
    const unsigned w[4] = {raw.x, raw.y, raw.z, raw.w}; float f[8];
#pragma unroll
    for (int j = 0; j < 8; ++j) { float v = bf2f((u16)(w[j >> 1] >> ((j & 1) * 16))); f[j] = c8 < 128 ? (2.f * fsig(2.f * v) - 1.f) : (c8 < 256 ? v : fsig(v)); }
    *(uint4*)(X + tok * 392 + c8) = make_uint4(pack2(f[0], f[1]), pack2(f[2], f[3]), pack2(f[4], f[5]), pack2(f[6], f[7]));
  }
  u16* UT = X + 32 * 392;
  for (int ch = tid; ch < 34 * 96; ch += 512) {
    const int rr = ch / 96, c8 = (ch % 96) * 8; const int t = t0 - 1 + rr;
    uint4 raw = make_uint4(0u, 0u, 0u, 0u);
    if (t >= 0 && t < L) raw = ldnt_u4(U + (size_t)(rowb - 1 + rr) * NU + c8);
    *(uint4*)(UT + rr * 776 + c8) = raw;
  }
  __syncthreads();
  const int h = wid & 3, tg = wid >> 2;
  const u16* WT = (const u16*)(p.ws + WS_WTL) + ((size_t)l * 256 + h * 64 + 4 * fr) * 384 + fq * 8;
  const u16* xa = X + (tg * 16 + fr) * 392 + fq * 8;
  f32x4 awf[4], awb[4], aaf[4], aab[4], ag[4];
#pragma unroll
  for (int n = 0; n < 4; ++n) { const float z_ = ozero(); awf[n] = f32x4{z_, z_, z_, z_}; awb[n] = awf[n]; aaf[n] = awf[n]; aab[n] = awf[n]; ag[n] = awf[n]; }
#pragma unroll
  for (int ks = 0; ks < 2; ++ks) {
    const bf16x8 x0 = *(const bf16x8*)(xa + ks * 32), x1 = *(const bf16x8*)(xa + 64 + ks * 32), x2 = *(const bf16x8*)(xa + 128 + ks * 32), x3 = *(const bf16x8*)(xa + 192 + ks * 32);
#pragma unroll
    for (int n = 0; n < 4; ++n) {
      const u16* wp = WT + (size_t)n * 384 + ks * 32;
      awf[n] = __builtin_amdgcn_mfma_f32_16x16x32_bf16(x0, *(const bf16x8*)(wp), awf[n], 0, 0, 0);
      awb[n] = __builtin_amdgcn_mfma_f32_16x16x32_bf16(x1, *(const bf16x8*)(wp + 64), awb[n], 0, 0, 0);
      aaf[n] = __builtin_amdgcn_mfma_f32_16x16x32_bf16(x2, *(const bf16x8*)(wp + 128), aaf[n], 0, 0, 0);
      aab[n] = __builtin_amdgcn_mfma_f32_16x16x32_bf16(x3, *(const bf16x8*)(wp + 192), aab[n], 0, 0, 0);
    }
  }
#pragma unroll
  for (int ks = 0; ks < 4; ++ks) {
    const bf16x8 x4 = *(const bf16x8*)(xa + 256 + ks * 32);
#pragma unroll
    for (int n = 0; n < 4; ++n) ag[n] = __builtin_amdgcn_mfma_f32_16x16x32_bf16(x4, *(const bf16x8*)(WT + (size_t)n * 384 + 256 + ks * 32), ag[n], 0, 0, 0);
  }
  const float* cw = p.in[14] + (size_t)l * 3 * 768;
  float cr[4][3], ck[4][3], cv[4][3], kkw[4], ka[4], rk[4], w0f[4], w0b[4], a0f[4], a0b[4];
  {
    const int c0 = h * 64 + 4 * fr;
#define LD4(dst, ptr) { const float4 t_ = *(const float4*)(ptr); dst[0] = t_.x; dst[1] = t_.y; dst[2] = t_.z; dst[3] = t_.w; }
#pragma unroll
    for (int q = 0; q < 3; ++q) {
      const float4 a_ = *(const float4*)(cw + q * 768 + c0), b_ = *(const float4*)(cw + q * 768 + 256 + c0), c_ = *(const float4*)(cw + q * 768 + 512 + c0);
      cr[0][q] = a_.x; cr[1][q] = a_.y; cr[2][q] = a_.z; cr[3][q] = a_.w; ck[0][q] = b_.x; ck[1][q] = b_.y; ck[2][q] = b_.z; ck[3][q] = b_.w;
      cv[0][q] = c_.x; cv[1][q] = c_.y; cv[2][q] = c_.z; cv[3][q] = c_.w;
    }
    LD4(kkw, p.in[20] + l * 256 + c0); LD4(ka, p.in[21] + l * 256 + c0); LD4(rk, p.in[22] + l * 256 + c0);
    LD4(w0f, p.in[15] + (l * 2 + 0) * 256 + c0); LD4(w0b, p.in[15] + (l * 2 + 1) * 256 + c0);
    LD4(a0f, p.in[17] + (l * 2 + 0) * 256 + c0); LD4(a0b, p.in[17] + (l * 2 + 1) * 256 + c0);
#undef LD4
  }
  float* RW = (float*)(p.ws + WS_RW); float* G = (float*)(p.ws + WS_G); float* BC = (float*)(p.ws + WS_BC);
#pragma unroll
  for (int j = 0; j < 4; ++j) {
    const int tok = tg * 16 + fq * 4 + j, row = rowb + tok, t = t0 + tok;
    float r_[4], k_[4], v_[4], kkr[4]; float ss = 0.f;
#pragma unroll
    for (int n = 0; n < 4; ++n) {
      const u16* ur = UT + (tok + 1) * 776 + h * 64 + 4 * fr + n;
      const float r0 = bf2f(ur[0]), k0 = bf2f(ur[256]), v0 = bf2f(ur[512]);
      const float rm = bf2f(ur[-776]), km = bf2f(ur[256 - 776]), vm = bf2f(ur[512 - 776]);
      const float rp = bf2f(ur[776]), kp = bf2f(ur[256 + 776]), vp = bf2f(ur[512 + 776]);
      r_[n] = cr[n][0] * rm + cr[n][1] * r0 + cr[n][2] * rp;
      k_[n] = ck[n][0] * km + ck[n][1] * k0 + ck[n][2] * kp;
      v_[n] = cv[n][0] * vm + cv[n][1] * v0 + cv[n][2] * vp;
      kkr[n] = k_[n] * kkw[n]; ss += kkr[n] * kkr[n];
    }
    ss = allreduce16(ss); const float rn = rsqrtf(ss + 1e-12f);
    float bonus = 0.f, brf = 0.f, krf = 0.f, brb = 0.f, krb = 0.f;
    float* dst0 = RW + ((size_t)(row * 4 + h) * 9) * 64 + 4 * fr;
    float okk[4], odf[4], obf[4], okf[4], odb[4], obb[4], okb[4];
#pragma unroll
    for (int n = 0; n < 4; ++n) {
      const float kk = kkr[n] * rn;
      const float decf = fexp(-0.60653066f * fsig(w0f[n] + awf[n][j])), decb = fexp(-0.60653066f * fsig(w0b[n] + awb[n][j]));
      const float af_ = fsig(a0f[n] + aaf[n][j]), ab_ = fsig(a0b[n] + aab[n][j]);
      const float kdf = k_[n] * (1.f + (af_ - 1.f) * ka[n]), kdb = k_[n] * (1.f + (ab_ - 1.f) * ka[n]);
      const float bf_ = kk * af_, bb_ = kk * ab_;
      bonus += r_[n] * (kdf + kdb) * rk[n]; brf += bf_ * r_[n]; krf += kdf * r_[n]; brb += bb_ * r_[n]; krb += kdb * r_[n];
      okk[n] = kk; odf[n] = decf; obf[n] = bf_; okf[n] = kdf; odb[n] = decb; obb[n] = bb_; okb[n] = kdb;
    }
    *(float4*)(dst0) = make_float4(r_[0], r_[1], r_[2], r_[3]);
    *(float4*)(dst0 + 64) = make_float4(okk[0], okk[1], okk[2], okk[3]);
    *(float4*)(dst0 + 128) = make_float4(v_[0], v_[1], v_[2], v_[3]);
    *(float4*)(dst0 + 192) = make_float4(odf[0], odf[1], odf[2], odf[3]);
    *(float4*)(dst0 + 256) = make_float4(obf[0], obf[1], obf[2], obf[3]);
    *(float4*)(dst0 + 320) = make_float4(okf[0], okf[1], okf[2], okf[3]);
    *(float4*)(dst0 + 384) = make_float4(odb[0], odb[1], odb[2], odb[3]);
    *(float4*)(dst0 + 448) = make_float4(obb[0], obb[1], obb[2], obb[3]);
    *(float4*)(dst0 + 512) = make_float4(okb[0], okb[1], okb[2], okb[3]);
    { const f32x4 t_ = {ag[0][j], ag[1][j], ag[2][j], ag[3][j]}; __builtin_nontemporal_store(t_, (f32x4*)(G + (size_t)row * 256 + h * 64 + 4 * fr)); }
    bonus = allreduce16(bonus); brf = allreduce16(brf); krf = allreduce16(krf); brb = allreduce16(brb); krb = allreduce16(krb);
    if (fr == 0) { float* bc = BC + (size_t)(row * 4 + h) * 8; *(float4*)bc = make_float4(brf, krf, brb, krb); bc[4] = bonus; }
  }
  __syncthreads();
}

DI void attn_prep_item(const Params& p, int l, int tile, float* lds) {
  const int tid = otid();
  const int rowb = tile * 32; int s, t0, L, row0; seq_of(rowb, s, t0, L, row0);
  const bool lat = s >= 16;
  const u16* U = (const u16*)(p.ws + WS_U);
  u16* Q = (u16*)(p.ws + WS_Q);
  u16* Kd = lat ? (u16*)(p.ws + WS_KL) + ((size_t)(s - 16) * 2304 + 256) * 512 : (u16*)(p.ws + WS_KC) + (size_t)s * 256 * 512;
  u16* Vd = lat ? (u16*)(p.ws + WS_VL) + (size_t)(s - 16) * 2304 * 512 + 256 : (u16*)(p.ws + WS_VC) + (size_t)s * 256 * 512;
  for (int uidx = tid; uidx < 2048; uidx += 512) {
    const int g = uidx & 1, pb = (uidx >> 1) & 1, hm = (uidx >> 2) & 7, which = (uidx >> 5) & 1, tok = uidx >> 6;
    const int row = rowb + tok, t = t0 + tok;
    const u16* src = U + (size_t)row * NU + (which ? 1664 : 1152) + hm * 64 + pb * 32 + g * 8;
    const uint4 va = ldnt_u4(src); const uint4 vb = ldnt_u4(src + 16);
    const unsigned wa[4] = {va.x, va.y, va.z, va.w}, wb[4] = {vb.x, vb.y, vb.z, vb.w};
    float oa[8], ob[8];
#pragma unroll
    for (int j = 0; j < 8; ++j) {
      float xa = bf2f((u16)(wa[j >> 1] >> ((j & 1) * 16))), xb = bf2f((u16)(wb[j >> 1] >> ((j & 1) * 16)));
      if (lat) {
        const int pidx = pb == 0 ? (t >> 6) : (t & 63); const int i = g * 8 + j;
        const float2 csn = ((const float2*)(p.ws + WS_ROPE))[pidx * 16 + i];
        oa[j] = xa * csn.x - xb * csn.y; ob[j] = xb * csn.x + xa * csn.y;
      } else { oa[j] = xa; ob[j] = xb; }
    }
    u16* dst = (which == 0) ? Q + (size_t)row * 512 + hm * 64 + pb * 32 + g * 8 : Kd + (size_t)t * 512 + hm * 64 + pb * 32 + g * 8;
    *(uint4*)dst = make_uint4(pack2(oa[0], oa[1]), pack2(oa[2], oa[3]), pack2(oa[4], oa[5]), pack2(oa[6], oa[7]));
    *(uint4*)(dst + 16) = make_uint4(pack2(ob[0], ob[1]), pack2(ob[2], ob[3]), pack2(ob[4], ob[5]), pack2(ob[6], ob[7]));
  }
  u16* vl = (u16*)lds;
  for (int uidx = tid; uidx < 2048; uidx += 512) {
    const int tok = uidx >> 6, ch = uidx & 63;
    *(uint4*)(vl + tok * 520 + ch * 8) = ldnt_u4(U + (size_t)(rowb + tok) * NU + 2176 + ch * 8);
  }
  __syncthreads();
  {
    const int col = tid, hv = col >> 7, e = col & 127; const int Lk = lat ? 2304 : 256;
    u16* dst = Vd + (size_t)(hv * 128 + e) * Lk + t0;
#pragma unroll
    for (int q = 0; q < 4; ++q) {
      unsigned w[4];
#pragma unroll
      for (int j = 0; j < 4; ++j) w[j] = (unsigned)vl[(q * 8 + 2 * j) * 520 + col] | ((unsigned)vl[(q * 8 + 2 * j + 1) * 520 + col] << 16);
      *(uint4*)(dst + q * 8) = make_uint4(w[0], w[1], w[2], w[3]);
    }
  }
  __syncthreads();
}

DI void cache_item(const Params& p, int l, int it, float* lds) {
  const int b = it >> 3, pc = it & 7; const int tid = otid();
  u16* KL = (u16*)(p.ws + WS_KL); u16* VL = (u16*)(p.ws + WS_VL);
  u16* vl = (u16*)lds;
  for (int idx = tid; idx < 32 * 128; idx += 512) {
    const int r = idx >> 7, c4 = idx & 127, prow = pc * 32 + r;
    const size_t so = ((size_t)(b * 4 + l) * 256 + prow) * 512 + c4 * 4; const size_t d_o = ((size_t)b * 2304 + prow) * 512 + c4 * 4;
    float4 kv = ldnt_f4(p.in[3] + so); float4 vv = ldnt_f4(p.in[4] + so);
    *(uint2*)(KL + d_o) = make_uint2(pack2(kv.x, kv.y), pack2(kv.z, kv.w));
    *(uint2*)(vl + r * 520 + c4 * 4) = make_uint2(pack2(vv.x, vv.y), pack2(vv.z, vv.w));
  }
  __syncthreads();
  {
    const int col = tid, hv = col >> 7, e = col & 127;
    u16* dst = VL + (size_t)b * 2304 * 512 + (size_t)(hv * 128 + e) * 2304 + pc * 32;
#pragma unroll
    for (int q = 0; q < 4; ++q) {
      unsigned w[4];
#pragma unroll
      for (int j = 0; j < 4; ++j) w[j] = (unsigned)vl[(q * 8 + 2 * j) * 520 + col] | ((unsigned)vl[(q * 8 + 2 * j + 1) * 520 + col] << 16);
      *(uint4*)(dst + q * 8) = make_uint4(w[0], w[1], w[2], w[3]);
    }
  }
  __syncthreads();
}

DI void hy_prep_item(const Params& p, int l, int tile, float* lds) {
  const int tid = otid();
  const int rowb = tile * 64; int s, t0, L, row0; seq_of(rowb, s, t0, L, row0);
  const u16* U = (const u16*)(p.ws + WS_U); float* HYT = (float*)(p.ws + WS_HYT);
  u16* UT = (u16*)lds;
  for (int ch = tid; ch < 66 * 96; ch += 512) {
    const int rr = ch / 96, c8 = (ch % 96) * 8; const int t = t0 - 1 + rr;
    uint4 raw = make_uint4(0u, 0u, 0u, 0u);
    if (t >= 0 && t < L) raw = ldnt_u4(U + (size_t)(rowb - 1 + rr) * NU + 2688 + c8);
    *(uint4*)(UT + rr * 776 + c8) = raw;
  }
  __syncthreads();
  const int cc = tid >> 1, half = tid & 1;
#pragma unroll
  for (int which = 0; which < 3; ++which) {
    const int col = which * 256 + cc;
    const float w0 = p.in[30][(size_t)l * 3 * 768 + col], w1 = p.in[30][(size_t)l * 3 * 768 + 768 + col], w2 = p.in[30][(size_t)l * 3 * 768 + 1536 + col];
    const float bias = p.in[31][l * 768 + col];
    const u16* up = UT + (half * 32) * 776 + col;
    float um = bf2f(up[0]), u0 = bf2f(up[776]);
    float* dst = HYT + (size_t)col * TT + rowb + half * 32;
#pragma unroll
    for (int i = 0; i < 32; i += 4) {
      float o[4];
#pragma unroll
      for (int q = 0; q < 4; ++q) { const float un = bf2f(up[(i + q + 2) * 776]); o[q] = w0 * um + w1 * u0 + w2 * un + bias; um = u0; u0 = un; }
      *(float4*)(dst + i) = make_float4(o[0], o[1], o[2], o[3]);
    }
  }
  __syncthreads();
}

DI void scan_item(const Params& p, int l, int s, int h, int d, int rg, int nact, float* lds) {
  int L, row0; if (s < 16) { L = 256; row0 = s * 256; } else { L = 2048; row0 = 4096 + (s - 16) * 2048; }
  const float* RW = (const float*)(p.ws + WS_RW); float* YS = (float*)(p.ws + WS_YS) + (size_t)d * TT * 256;
  const float* BC = (const float*)(p.ws + WS_BC);
  const int tid = otid(), lane = tid & 63, wid = tid >> 6, lane16 = lane & 15, rsub = lane >> 4;
  const int row = rg * (nact * 4) + (wid & (nact - 1)) * 4 + rsub;
  float4 st = make_float4(0.f, 0.f, 0.f, 0.f);
  if (s >= 16 && wid < nact) st = *(const float4*)(p.in[2] + ((((size_t)(s - 16) * 4 + l) * 2 + d) * 4 + h) * 4096 + row * 64 + lane16 * 4);
  const int nch = L / 32;
  float4 pre0, pre1, pre2, pre3, pre4, pre5; float2 presc = make_float2(0.f, 0.f);
  auto ldpre = [&](int ch, int j) -> float4 {
    int f = tid + j * 512; int step = f / 96, within = f % 96; int slot6 = within >> 4, q = within & 15;
    int srcslot = slot6 < 3 ? slot6 : 3 + 3 * d + (slot6 - 3); int i = ch * 32 + step; int t = d ? L - 1 - i : i;
    return *(const float4*)(RW + ((size_t)((row0 + t) * 4 + h) * 9 + srcslot) * 64 + q * 4); };
#define PREFETCH(ch) { pre0 = ldpre(ch, 0); pre1 = ldpre(ch, 1); pre2 = ldpre(ch, 2); pre3 = ldpre(ch, 3); pre4 = ldpre(ch, 4); pre5 = ldpre(ch, 5); \
    if (tid < 32) { int i = (ch) * 32 + tid; int t = d ? L - 1 - i : i; presc = *(const float2*)(BC + (size_t)((row0 + t) * 4 + h) * 8 + 2 * d); } }
  PREFETCH(0);
  float* scl = lds + 12288;
  for (int ch = 0; ch < nch; ++ch) {
    *(float4*)(lds + (size_t)(tid + 0 * 512) * 4) = pre0; *(float4*)(lds + (size_t)(tid + 1 * 512) * 4) = pre1;
    *(float4*)(lds + (size_t)(tid + 2 * 512) * 4) = pre2; *(float4*)(lds + (size_t)(tid + 3 * 512) * 4) = pre3;
    *(float4*)(lds + (size_t)(tid + 4 * 512) * 4) = pre4; *(float4*)(lds + (size_t)(tid + 5 * 512) * 4) = pre5;
    if (tid < 32) *(float2*)(scl + tid * 2) = presc;
    __syncthreads();
    if (ch + 1 < nch) PREFETCH(ch + 1);
    if (wid < nact) {
      float4 r4 = *(const float4*)(lds + lane16 * 4), kk4 = *(const float4*)(lds + 64 + lane16 * 4);
      float vrow = lds[128 + row];
      float4 w4 = *(const float4*)(lds + 192 + lane16 * 4), b4 = *(const float4*)(lds + 256 + lane16 * 4), kd4 = *(const float4*)(lds + 320 + lane16 * 4);
      float2 sc = *(const float2*)scl;
      float ykeep = 0.f;
#pragma unroll 16
      for (int step = 0; step < 32; ++step) {
        const int sn = (step + 1) & 31;
        const float* bn = lds + sn * 384;
        const float4 nr4 = *(const float4*)(bn + lane16 * 4), nkk4 = *(const float4*)(bn + 64 + lane16 * 4);
        const float nvrow = bn[128 + row];
        const float4 nw4 = *(const float4*)(bn + 192 + lane16 * 4), nb4 = *(const float4*)(bn + 256 + lane16 * 4), nkd4 = *(const float4*)(bn + 320 + lane16 * 4);
        const float2 nsc = *(const float2*)(scl + sn * 2);
        __builtin_amdgcn_sched_barrier(0);
        float psa = st.x * kk4.x + st.y * kk4.y + st.z * kk4.z + st.w * kk4.w;
        float py = st.x * (w4.x * r4.x) + st.y * (w4.y * r4.y) + st.z * (w4.z * r4.z) + st.w * (w4.w * r4.w);
        psa += dppf<0xB1>(psa); py += dppf<0xB1>(py);
        psa += dppf<0x4E>(psa); py += dppf<0x4E>(py);
        psa += dppf<0x124>(psa); py += dppf<0x124>(py);
        psa += dppf<0x128>(psa); py += dppf<0x128>(py);
        const float sa = -psa;
        const float y = py + sa * sc.x + vrow * sc.y;
        st.x = st.x * w4.x + (sa * b4.x + vrow * kd4.x);
        st.y = st.y * w4.y + (sa * b4.y + vrow * kd4.y);
        st.z = st.z * w4.z + (sa * b4.z + vrow * kd4.z);
        st.w = st.w * w4.w + (sa * b4.w + vrow * kd4.w);
        ykeep = (lane16 == (step & 15)) ? y : ykeep;
        if ((step & 15) == 15) { const int i = ch * 32 + (step - 15) + lane16; const int t = d ? L - 1 - i : i; YS[(size_t)(row0 + t) * 256 + h * 64 + row] = ykeep; }
        r4 = nr4; kk4 = nkk4; vrow = nvrow; w4 = nw4; b4 = nb4; kd4 = nkd4; sc = nsc;
        __builtin_amdgcn_sched_barrier(0);
      }
    }
    __syncthreads();
  }
#undef PREFETCH
  if (s < 16 && wid < nact) *(float4*)(p.out + OUT_STATE + ((((size_t)s * 4 + l) * 2 + d) * 4 + h) * 4096 + row * 64 + lane16 * 4) = st;
}

DI void attn_item(const Params& p, int l, int s, int h, int qt, unsigned char* smem, float lam, float lam_init) {
  u16* Ks0 = (u16*)smem; float* Ex = (float*)smem;
  const bool lat = s >= 16; const int Lk = lat ? 2304 : 256;
  const u16* Kg = lat ? (const u16*)(p.ws + WS_KL) + (size_t)(s - 16) * 2304 * 512 : (const u16*)(p.ws + WS_KC) + (size_t)s * 256 * 512;
  const u16* Vg = (lat ? (const u16*)(p.ws + WS_VL) + (size_t)(s - 16) * 2304 * 512 : (const u16*)(p.ws + WS_VC) + (size_t)s * 256 * 512) + (size_t)h * 128 * Lk;
  const int row0 = lat ? 4096 + (s - 16) * 2048 : s * 256; const int qrow0 = row0 + qt * 128;
  const u16* Q = (const u16*)(p.ws + WS_Q);
  const int tid = otid(), lane = tid & 63, wid = tid >> 6, m = wid & 1, qs = wid >> 1, r = lane & 31, hh = lane >> 5;
  bf16x8 qf[4];
#pragma unroll
  for (int ks = 0; ks < 4; ++ks) qf[ks] = __builtin_nontemporal_load((const bf16x8*)(Q + (size_t)(qrow0 + qs * 32 + r) * 512 + h * 128 + m * 64 + ks * 16 + hh * 8));
  f32x16 o[4];
#pragma unroll
  for (int et = 0; et < 4; ++et)
#pragma unroll
    for (int i = 0; i < 16; ++i) o[et][i] = ozero();
  float mrun = -1e30f, lsum = 0.f, lsum2 = 0.f; const float cs = 0.125f * 1.4426950408889634f;
  uint4 kr0, kr1, vr0, vr1;
  const int kkey = tid >> 4, kch = tid & 15, ve = tid >> 3, vkc = tid & 7;
#define ALOAD(kt0) { kr0 = *(const uint4*)(Kg + (size_t)((kt0) + kkey) * 512 + h * 128 + kch * 8); kr1 = *(const uint4*)(Kg + (size_t)((kt0) + kkey + 32) * 512 + h * 128 + kch * 8); \
                     vr0 = *(const uint4*)(Vg + (size_t)ve * Lk + (kt0) + vkc * 8); vr1 = *(const uint4*)(Vg + (size_t)(ve + 64) * Lk + (kt0) + vkc * 8); }
#define ASTORE(b) { u16* ks_ = Ks0 + (b) * 17920; u16* vs_ = ks_ + 64 * 136; \
    *(uint4*)(ks_ + kkey * 136 + kch * 8) = kr0; *(uint4*)(ks_ + (kkey + 32) * 136 + kch * 8) = kr1; \
    *(uint2*)(vs_ + ve * 68 + vkc * 8) = make_uint2(vr0.x, vr0.y); *(uint2*)(vs_ + ve * 68 + vkc * 8 + 4) = make_uint2(vr0.z, vr0.w); \
    *(uint2*)(vs_ + (ve + 64) * 68 + vkc * 8) = make_uint2(vr1.x, vr1.y); *(uint2*)(vs_ + (ve + 64) * 68 + vkc * 8 + 4) = make_uint2(vr1.z, vr1.w); }
  ALOAD(0);
  __syncthreads();
  ASTORE(0);
  if (64 < Lk) ALOAD(64);
  __syncthreads();
  for (int kt0 = 0; kt0 < Lk; kt0 += 64) {
    const int cb = (kt0 >> 6) & 1;
    const u16* Ks = Ks0 + cb * 17920; const u16* Vs = Ks + 64 * 136;
    f32x16 st[2];
#pragma unroll
    for (int kt = 0; kt < 2; ++kt) {
#pragma unroll
      for (int i = 0; i < 16; ++i) st[kt][i] = 0.f;
#pragma unroll
      for (int ks = 0; ks < 4; ++ks) { const bf16x8 kf = *(const bf16x8*)(Ks + (kt * 32 + r) * 136 + m * 64 + ks * 16 + hh * 8);
        st[kt] = __builtin_amdgcn_mfma_f32_32x32x16_bf16(kf, qf[ks], st[kt], 0, 0, 0); }
    }
    float mx = st[0][0];
#pragma unroll
    for (int i = 0; i < 16; ++i) { mx = fmaxf(mx, st[0][i]); mx = fmaxf(mx, st[1][i]); }
    mx = fmaxf(mx, shfl32(mx, lane));
    const float mnew = fmaxf(mrun, mx);
    if (__builtin_amdgcn_ballot_w64(mnew > mrun) != 0ull) {
      const float alpha = __builtin_amdgcn_exp2f((mrun - mnew) * cs); mrun = mnew;
      lsum *= alpha; lsum2 *= alpha;
#pragma unroll
      for (int et = 0; et < 4; ++et)
#pragma unroll
        for (int i = 0; i < 16; ++i) o[et][i] *= alpha;
    }
    const float nb = -mrun * cs;
#pragma unroll
    for (int kt = 0; kt < 2; ++kt)
#pragma unroll
      for (int i = 0; i < 16; i += 2) {
        const float p0 = __builtin_amdgcn_exp2f(__builtin_fmaf(st[kt][i], cs, nb)), p1 = __builtin_amdgcn_exp2f(__builtin_fmaf(st[kt][i + 1], cs, nb));
        lsum += p0; lsum2 += p1; st[kt][i] = p0; st[kt][i + 1] = p1; }
#pragma unroll
    for (int kt = 0; kt < 2; ++kt)
#pragma unroll
      for (int ss = 0; ss < 2; ++ss) {
        unsigned pw0, pw1, pw2, pw3;
        asm volatile("v_cvt_pk_bf16_f32 %0, %4, %5\n\tv_cvt_pk_bf16_f32 %1, %6, %7\n\tv_cvt_pk_bf16_f32 %2, %8, %9\n\tv_cvt_pk_bf16_f32 %3, %10, %11\n\ts_nop 1"
                     : "=&v"(pw0), "=&v"(pw1), "=&v"(pw2), "=&v"(pw3)
                     : "v"(st[kt][8 * ss + 0]), "v"(st[kt][8 * ss + 1]), "v"(st[kt][8 * ss + 2]), "v"(st[kt][8 * ss + 3]),
                       "v"(st[kt][8 * ss + 4]), "v"(st[kt][8 * ss + 5]), "v"(st[kt][8 * ss + 6]), "v"(st[kt][8 * ss + 7]));
        const bf16x8 pf = __builtin_bit_cast(bf16x8, make_uint4(pw0, pw1, pw2, pw3));
#pragma unroll
        for (int et = 0; et < 4; ++et) {
          const u16* vp = Vs + (et * 32 + r) * 68 + kt * 32 + 16 * ss + 4 * hh;
          const s16x4 lo = *(const s16x4*)vp, hi = *(const s16x4*)(vp + 8);
          const bf16x8 vf = __builtin_shufflevector(lo, hi, 0, 1, 2, 3, 4, 5, 6, 7);
          o[et] = __builtin_amdgcn_mfma_f32_32x32x16_bf16(vf, pf, o[et], 0, 0, 0);
        }
      }
    if (kt0 + 64 < Lk) ASTORE(cb ^ 1);
    __syncthreads();
    if (kt0 + 128 < Lk) ALOAD(kt0 + 128);
  }
#undef ALOAD
#undef ASTORE
  lsum += lsum2; lsum += shfl32(lsum, lane); const float inv = 1.f / lsum;
  float* ex = Ex + qs * (32 * 132);
  if (m == 1) {
#pragma unroll
    for (int et = 0; et < 4; ++et)
#pragma unroll
      for (int i = 0; i < 16; ++i) { int e = et * 32 + (i & 3) + 8 * (i >> 2) + 4 * hh; ex[r * 132 + e] = o[et][i] * inv; }
  }
  __syncthreads();
  if (m == 0) {
    float ssq = 0.f;
#pragma unroll
    for (int et = 0; et < 4; ++et)
#pragma unroll
      for (int i = 0; i < 16; ++i) { int e = et * 32 + (i & 3) + 8 * (i >> 2) + 4 * hh; float v = o[et][i] * inv - lam * ex[r * 132 + e]; o[et][i] = v; ssq += v * v; }
    ssq += shfl32(ssq, lane);
    const float rs = rsqrtf(ssq * (1.f / 128.f) + 1e-6f) * (1.f - lam_init);
    const float* subln = p.in[29] + l * 128;
    u16* dstrow = (u16*)(p.ws + WS_MIXCAT) + (size_t)(qrow0 + qs * 32 + r) * 1024 + 256 + h * 128;
#pragma unroll
    for (int et = 0; et < 4; ++et)
#pragma unroll
      for (int g4 = 0; g4 < 4; ++g4) {
        const int e0 = et * 32 + 8 * g4 + 4 * hh; const float4 sl = *(const float4*)(subln + e0);
        *(uint2*)(dstrow + e0) = make_uint2(pack2(o[et][4 * g4] * rs * sl.x, o[et][4 * g4 + 1] * rs * sl.y), pack2(o[et][4 * g4 + 2] * rs * sl.z, o[et][4 * g4 + 3] * rs * sl.w));
      }
  }
}

DI void hy_conv(const float* g, const float* z, int L, int t0, float& a0, float& a1, float& a2, float& a3) {
  a0 = a1 = a2 = a3 = 0.f;
  const float* gp = g + L + t0 - 4;
  const int nb = L >> 2;
#pragma unroll 4
  for (int sb = 0; sb < nb; ++sb) {
    const float4 zz = *(const float4*)(z + sb * 4);
    const float4 ga = *(const float4*)(gp - 4 * sb), gb = *(const float4*)(gp - 4 * sb + 4);
    a0 += gb.x * zz.x + ga.w * zz.y + ga.z * zz.z + ga.y * zz.w;
    a1 += gb.y * zz.x + gb.x * zz.y + ga.w * zz.z + ga.z * zz.w;
    a2 += gb.z * zz.x + gb.y * zz.y + gb.x * zz.z + ga.w * zz.w;
    a3 += gb.w * zz.x + gb.z * zz.y + gb.y * zz.z + gb.x * zz.w;
  }
}

DI void hyena_item(const Params& p, int l, int s, int c0, float* lds) {
  const bool lat = s >= 16; const int L = lat ? 2048 : 256; const int row0 = lat ? 4096 + (s - 16) * 2048 : s * 256;
  const int TPC = L >> 2; const int tid = otid(), lane = tid & 63, wid = tid >> 6;
  const int ch = tid / TPC, tl = tid % TPC, t0 = tl * 4, c = c0 + ch;
  float* G = lds; float* Z = lds + 8192; float* red = lds + 8192 + 2048;
  const float* F = (const float*)(p.ws + WS_FILT) + (lat ? 262144 : 0);
  const float* HYT = (const float*)(p.ws + WS_HYT);
  float ssq[2];
#pragma unroll
  for (int o = 0; o < 2; ++o) {
    const float* src = F + (size_t)(o * 256 + c) * (2 * L); float* dst = G + (size_t)(ch * 2 + o) * (2 * L); float sacc = 0.f;
#pragma unroll
    for (int i = 0; i < 2; ++i) { int idx = (tl + i * TPC) * 4; float4 v = *(const float4*)(src + idx); *(float4*)(dst + idx) = v; sacc += v.x * v.x + v.y * v.y + v.z * v.z + v.w * v.w; }
    ssq[o] = wave_sum(sacc);
  }
  if (lane == 0) { red[wid * 2] = ssq[0]; red[wid * 2 + 1] = ssq[1]; }
  const float4 x1 = *(const float4*)(HYT + (size_t)(0 * 256 + c) * TT + row0 + t0);
  const float4 x2 = *(const float4*)(HYT + (size_t)(1 * 256 + c) * TT + row0 + t0);
  const float4 v4 = *(const float4*)(HYT + (size_t)(2 * 256 + c) * TT + row0 + t0);
  *(float4*)(Z + ch * L + t0) = v4;
  __syncthreads();
  const int wpc = TPC >> 6, w0 = ch * wpc; float sc0 = 0.f, sc1 = 0.f;
  for (int w = 0; w < wpc; ++w) { sc0 += red[(w0 + w) * 2]; sc1 += red[(w0 + w) * 2 + 1]; }
  sc0 = rsqrtf(sc0 + 1e-6f); sc1 = rsqrtf(sc1 + 1e-6f);
  const float bias0 = p.in[39][(l * 2 + 0) * 256 + c], bias1 = p.in[39][(l * 2 + 1) * 256 + c];
  float a0, a1, a2, a3;
  hy_conv(G + (size_t)(ch * 2 + 0) * (2 * L), Z + ch * L, L, t0, a0, a1, a2, a3);
  float4 z1;
  z1.x = x1.x * (sc0 * a0 + bias0 * v4.x); z1.y = x1.y * (sc0 * a1 + bias0 * v4.y); z1.z = x1.z * (sc0 * a2 + bias0 * v4.z); z1.w = x1.w * (sc0 * a3 + bias0 * v4.w);
  __syncthreads();
  *(float4*)(Z + ch * L + t0) = z1;
  __syncthreads();
  hy_conv(G + (size_t)(ch * 2 + 1) * (2 * L), Z + ch * L, L, t0, a0, a1, a2, a3);
  float4 yo;
  yo.x = x2.x * (sc1 * a0 + bias1 * z1.x); yo.y = x2.y * (sc1 * a1 + bias1 * z1.y); yo.z = x2.z * (sc1 * a2 + bias1 * z1.z); yo.w = x2.w * (sc1 * a3 + bias1 * z1.w);
  *(float4*)((float*)(p.ws + WS_YC) + (size_t)c * TT + row0 + t0) = yo;
  __syncthreads();
}


DI float2 cmul(float2 a, float2 b) { return make_float2(a.x * b.x - a.y * b.y, a.x * b.y + a.y * b.x); }
#define BF2(a, b) { float2 t_ = a; a.x = t_.x + b.x; a.y = t_.y + b.y; b.x = t_.x - b.x; b.y = t_.y - b.y; }
#define MNI(a) { float t_ = a.x; a.x = a.y; a.y = -t_; }
DI void fft_fwd(float2 (&v)[8], int j, int TPF, int npass, float2* lds) {
  int Ns = 1;
  for (int ps = 0; ps < npass; ++ps) {
    const int k = j & (Ns - 1);
    if (ps > 0) {
      const float a2 = -2.f * (float)k / (float)(Ns * 8);
      const float2 w1 = make_float2(cospif(a2), sinpif(a2));
      float2 w = w1; v[1] = cmul(v[1], w);
      w = cmul(w, w1); v[2] = cmul(v[2], w);
      w = cmul(w, w1); v[3] = cmul(v[3], w);
      w = cmul(w, w1); v[4] = cmul(v[4], w);
      w = cmul(w, w1); v[5] = cmul(v[5], w);
      w = cmul(w, w1); v[6] = cmul(v[6], w);
      w = cmul(w, w1); v[7] = cmul(v[7], w);
    }
    BF2(v[0], v[4]); BF2(v[1], v[5]); BF2(v[2], v[6]); BF2(v[3], v[7]);
    v[5] = cmul(v[5], make_float2(0.70710678118654752f, -0.70710678118654752f)); MNI(v[6]); v[7] = cmul(v[7], make_float2(-0.70710678118654752f, -0.70710678118654752f));
    BF2(v[0], v[2]); BF2(v[1], v[3]); BF2(v[4], v[6]); BF2(v[5], v[7]);
    MNI(v[3]); MNI(v[7]);
    BF2(v[0], v[1]); BF2(v[2], v[3]); BF2(v[4], v[5]); BF2(v[6], v[7]);
    { float2 t1 = v[1], t3 = v[3]; v[1] = v[4]; v[3] = v[6]; v[4] = t1; v[6] = t3; }
    if (ps == npass - 1) break;
    __syncthreads();
    const int base = (j - k) * 8 + k;
#pragma unroll
    for (int r = 0; r < 8; ++r) { const int idx = base + r * Ns; lds[idx + (idx >> 3)] = v[r]; }
    __syncthreads();
#pragma unroll
    for (int r = 0; r < 8; ++r) { const int idx = j + r * TPF; v[r] = lds[idx + (idx >> 3)]; }
    Ns *= 8;
  }
}

DI void hspec_item(const Params& p, int lat, int item, float* ldsf) {
  const int tid = otid(), lane = tid & 63, wid = tid >> 6;
  const int TPF = lat ? 512 : 64, npass = lat ? 4 : 3, L = lat ? 2048 : 256, N = 2 * L;
  const int unit = lat ? 0 : wid; const int j = tid & (TPF - 1);
  const int c = lat ? item : item * 8 + unit;
  float2* lds = (float2*)ldsf + unit * (N + (N >> 3));
  float* red = ldsf + 9216;
  const float* F = (const float*)(p.ws + WS_FILT) + (lat ? 262144 : 0);
  const float* g0 = F + (size_t)c * N; const float* g1 = F + (size_t)(256 + c) * N;
  float2 v[8]; float s0 = 0.f, s1 = 0.f;
#pragma unroll
  for (int r = 0; r < 8; ++r) { const int n = j + r * TPF; const int gi = (n + L) & (N - 1); const float a = g0[gi], b = g1[gi]; v[r] = make_float2(a, b); s0 += a * a; s1 += b * b; }
  s0 = wave_sum(s0); s1 = wave_sum(s1);
  if (lane == 0) { red[wid * 2] = s0; red[wid * 2 + 1] = s1; }
  __syncthreads();
  if (lat) { s0 = 0.f; s1 = 0.f; for (int w = 0; w < 8; ++w) { s0 += red[w * 2]; s1 += red[w * 2 + 1]; } }
  const float sc0 = rsqrtf(s0 + 1e-6f), sc1 = rsqrtf(s1 + 1e-6f);
#pragma unroll
  for (int r = 0; r < 8; ++r) { v[r].x *= sc0; v[r].y *= sc1; }
  fft_fwd(v, j, TPF, npass, lds);
  __syncthreads();
#pragma unroll
  for (int r = 0; r < 8; ++r) { const int idx = j + r * TPF; lds[idx + (idx >> 3)] = v[r]; }
  __syncthreads();
  const float hn = 0.5f / (float)N;
  float2* HS = (float2*)(p.ws + WS_HSPEC) + (lat ? 0 : 2 * 256 * 4096);
  float2* H0 = HS + (size_t)c * N; float2* H1 = HS + (size_t)(256 + c) * N;
#pragma unroll
  for (int r = 0; r < 8; ++r) {
    const int k = j + r * TPF; const int km = (N - k) & (N - 1); const float2 wm = lds[km + (km >> 3)];
    const float2 sm = make_float2(v[r].x + wm.x, v[r].y - wm.y); const float2 df = make_float2(v[r].x - wm.x, v[r].y + wm.y);
    H0[k] = make_float2(sm.x * hn, sm.y * hn); H1[k] = make_float2(df.y * hn, -df.x * hn);
  }
  __syncthreads();
}

DI void hyena_fft_item(const Params& p, int l, int lat, int item, float* ldsf) {
  const int tid = otid(), wid = tid >> 6;
  const int TPF = lat ? 512 : 64, npass = lat ? 4 : 3, L = lat ? 2048 : 256, N = 2 * L;
  const int unit = lat ? 0 : wid; const int j = tid & (TPF - 1);
  int c, rowa, rowb;
  if (lat) { const int bp = item >> 8; c = item & 255; rowa = 4096 + (2 * bp) * 2048; rowb = rowa + 2048; }
  else { const int gidx = item * 8 + unit; const int pair = gidx >> 8; c = gidx & 255; rowa = (2 * pair) * 256; rowb = rowa + 256; }
  float2* lds = (float2*)ldsf + unit * (N + (N >> 3));
  const float2* HS = (const float2*)(p.ws + WS_HSPEC) + (lat ? 0 : 2 * 256 * 4096);
  const float* HYT = (const float*)(p.ws + WS_HYT);
  float2 v[8], z[4];
#pragma unroll
  for (int r = 0; r < 4; ++r) { const int t = j + r * TPF; z[r] = make_float2(__builtin_nontemporal_load(HYT + (size_t)(512 + c) * TT + rowa + t), __builtin_nontemporal_load(HYT + (size_t)(512 + c) * TT + rowb + t)); v[r] = z[r]; v[4 + r] = make_float2(0.f, 0.f); }
  for (int order = 0; order < 2; ++order) {
    const float2* H = HS + (size_t)(order * 256 + c) * N;
    const float* xq = HYT + (size_t)(order * 256 + c) * TT;
    float2 h[8];
#pragma unroll
    for (int r = 0; r < 8; ++r) h[r] = H[j + r * TPF];
    float xa[4], xb[4];
#pragma unroll
    for (int r = 0; r < 4; ++r) { xa[r] = __builtin_nontemporal_load(xq + rowa + j + r * TPF); xb[r] = __builtin_nontemporal_load(xq + rowb + j + r * TPF); }
    fft_fwd(v, j, TPF, npass, lds);
#pragma unroll
    for (int r = 0; r < 8; ++r) { const float2 y = cmul(v[r], h[r]); v[r] = make_float2(y.x, -y.y); }
    fft_fwd(v, j, TPF, npass, lds);
    const float bias = p.in[39][(l * 2 + order) * 256 + c];
#pragma unroll
    for (int r = 0; r < 4; ++r) {
      const float ya = v[r].x, yb = -v[r].y;
      z[r] = make_float2(xa[r] * (ya + bias * z[r].x), xb[r] * (yb + bias * z[r].y));
      v[r] = z[r]; v[4 + r] = make_float2(0.f, 0.f);
    }
  }
  float* YC = (float*)(p.ws + WS_YC) + (size_t)c * TT;
#pragma unroll
  for (int r = 0; r < 4; ++r) { const int t = j + r * TPF; YC[rowa + t] = z[r].x; YC[rowb + t] = z[r].y; }
  __syncthreads();
}

DI void fin_item(const Params& p, int l, int tile, float* lds) {
  const int tid = otid(), lane = tid & 63, wid = tid >> 6; const int rowb = tile * 64;
  const float* YS0 = (const float*)(p.ws + WS_YS); const float* YS1 = YS0 + (size_t)TT * 256;
  const float* RW = (const float*)(p.ws + WS_RW); const float* G = (const float*)(p.ws + WS_G); const float* BC = (const float*)(p.ws + WS_BC);
  u16* MC = (u16*)(p.ws + WS_MIXCAT);
  {
    const int l16 = lane & 15, sub = lane >> 4;
#pragma unroll 2
    for (int q = 0; q < 8; ++q) {
      const int pair = wid * 32 + q * 4 + sub, tok = pair >> 2, h = pair & 3, row = rowb + tok, c = h * 64 + l16 * 4;
      const float4 y0 = ldnt_f4(YS0 + (size_t)row * 256 + c), y1 = ldnt_f4(YS1 + (size_t)row * 256 + c);
      const float4 y = make_float4(y0.x + y1.x, y0.y + y1.y, y0.z + y1.z, y0.w + y1.w);
      const float mu = allreduce16(y.x + y.y + y.z + y.w) * (1.f / 64.f);
      const float4 dv = make_float4(y.x - mu, y.y - mu, y.z - mu, y.w - mu);
      const float var = allreduce16(dv.x * dv.x + dv.y * dv.y + dv.z * dv.z + dv.w * dv.w) * (1.f / 64.f);
      const float rs = rsqrtf(var + 64e-5f);
      const float4 lw = *(const float4*)(p.in[23] + l * 256 + c), lb = *(const float4*)(p.in[24] + l * 256 + c);
      const float4 v = ldnt_f4(RW + ((size_t)(row * 4 + h) * 9 + 2) * 64 + l16 * 4); const float bc = BC[(size_t)(row * 4 + h) * 8 + 4];
      const float4 g = ldnt_f4(G + (size_t)row * 256 + c);
      const float o0 = (dv.x * rs * lw.x + lb.x + bc * v.x) * g.x, o1 = (dv.y * rs * lw.y + lb.y + bc * v.y) * g.y;
      const float o2 = (dv.z * rs * lw.z + lb.z + bc * v.z) * g.z, o3 = (dv.w * rs * lw.w + lb.w + bc * v.w) * g.w;
      *(uint2*)(MC + (size_t)row * 1024 + c) = make_uint2(pack2(o0, o1), pack2(o2, o3));
    }
  }
  const float* YC = (const float*)(p.ws + WS_YC);
#pragma unroll
  for (int it = 0; it < 8; ++it) { const int idx = tid + it * 512; const int c = idx >> 4, t4 = (idx & 15) * 4;
    const float4 v = ldnt_f4(YC + (size_t)c * TT + rowb + t4); float* d = lds + c * 65 + t4; d[0] = v.x; d[1] = v.y; d[2] = v.z; d[3] = v.w; }
  __syncthreads();
#pragma unroll
  for (int it = 0; it < 8; ++it) { const int idx = tid + it * 512; const int tt = idx >> 6, c4 = (idx & 63) * 4;
    *(uint2*)(MC + (size_t)(rowb + tt) * 1024 + 768 + c4) = make_uint2(pack2(lds[c4 * 65 + tt], lds[(c4 + 1) * 65 + tt]), pack2(lds[(c4 + 2) * 65 + tt], lds[(c4 + 3) * 65 + tt])); }
  __syncthreads();
}

constexpr int NPH = 2 + 9 * 4;

DI void run_phase(const Params& p, int ph, unsigned char* smem) {
  float* lds = (float*)smem;
  PG8_LAS unsigned char* ldsp = (PG8_LAS unsigned char*)smem;
  const int nb = gridDim.x, bid = blockIdx.x;
  if (ph == 0) {
    int& s_ip = *(int*)(smem + 131072 + 28);
    unsigned* ctr0 = (unsigned*)(p.ws + WS_CTL + 16384) + 4 * 64;
    for (;;) {
      __syncthreads();
      if (threadIdx.x == 0) s_ip = (int)atomicAdd(ctr0, 1u);
      __syncthreads();
      const int q0 = s_ip;
      if (q0 >= 384 + AUX_ITEMS + 1 + 32) break;
      const int it = q0 < 288 ? 384 + AUX_ITEMS - 288 + q0 : (q0 - 288 < 384 + AUX_ITEMS - 288 ? q0 - 288 : q0);
      if (it < 384) mod_item(p, it, lds);
      else if (it < 384 + AUX_ITEMS) aux_item(p, 0, it - 384, lds);
      else if (it >= 384 + AUX_ITEMS + 1) {
        const int q = it - (384 + AUX_ITEMS + 1), ll = q >> 3, c0 = (q & 7) * 32; u16* WT = (u16*)(p.ws + WS_WTL);
        for (int e = otid(); e < 32 * 384; e += 512) { const int k = e >> 5, cc = e & 31, col = c0 + cc; float v;
          if (k < 64) v = p.in[16][((size_t)(ll * 2 + 0) * 64 + k) * 256 + col];
          else if (k < 128) v = p.in[16][((size_t)(ll * 2 + 1) * 64 + (k - 64)) * 256 + col];
          else if (k < 192) v = p.in[18][((size_t)(ll * 2 + 0) * 64 + (k - 128)) * 256 + col];
          else if (k < 256) v = p.in[18][((size_t)(ll * 2 + 1) * 64 + (k - 192)) * 256 + col];
          else v = p.in[19][((size_t)ll * 128 + (k - 256)) * 256 + col];
          WT[((size_t)ll * 256 + col) * 384 + k] = f2bf(v); }
      }
      else { float2* tab = (float2*)(p.ws + WS_ROPE); for (int e = otid(); e < 1024; e += 512) { const int pidx = e >> 4, i = e & 15;
               const float inv = exp2f(-(float)(2 * i) * (13.287712379549449f / 32.f)); const float ang = (float)pidx * inv; tab[e] = make_float2(cosf(ang), sinf(ang)); } }
    }
    return;
  }
  if (ph == 1) { row_phase(p, 0, 0);
#ifdef PROBE_R
    __syncthreads(); row_phase(p, 0, 0);
#endif
    return; }
  const int l = (ph - 2) / 9, k = (ph - 2) % 9;
  unsigned char* slot = p.ws + WS_W + (size_t)(l & 1) * W_SLOT;
  const u16* win = (const u16*)slot; const u16* wout = (const u16*)(slot + W_IN_B); const u16* wff1 = (const u16*)(slot + W_IN_B + W_OUT_B); const u16* wff2 = (const u16*)(slot + W_IN_B + W_OUT_B + W_FF_B);
  const int nrep = (k != 2 && k != 5 && k != 8 && ((PROBE_DUPK >> k) & 1)) ? 2 : 1;
  for (int rep = 0; rep < nrep; ++rep)
  switch (k) {
    case 0: { pg8::Gemm g{(const u16*)(p.ws + WS_H), win, TT, 3584, 1024}; pg8::StaticOrder S; S.init(TT, 3584, nb, bid);
              pg8::EpiU E{(u16*)(p.ws + WS_U), p.out, l}; pg8::gemm_phase(ldsp, g, S, E, nullptr);
#ifdef PROBE_G
              __syncthreads(); pg8::gemm_phase(ldsp, g, S, E, nullptr);
#endif
              } break;
    case 1: {
      int& s_it = *(int*)(smem + 131072 + 24);
#ifdef PROBE_P
      _Pragma("unroll") for (int pp_ = 0; pp_ < 2; ++pp_) {
      unsigned* ctr = (unsigned*)(p.ws + WS_CTL + 16384) + l * 64 + 32 + pp_ * 8;
#else
      {
      unsigned* ctr = (unsigned*)(p.ws + WS_CTL + 16384) + l * 64 + 32;
#endif
      for (;;) {
        __syncthreads();
        if (threadIdx.x == 0) s_it = (int)atomicAdd(ctr, 1u);
        __syncthreads();
        const int it = s_it;
        if (it >= 1280) break;
        if (it < 384) rwkv_prep_item(p, l, it, lds);
        else if (it < 576) hy_prep_item(p, l, it - 384, lds);
        else if (it < 960) attn_prep_item(p, l, it - 576, lds);
        else if (it < 1216) hspec_item(p, 1, it - 960, lds);
        else if (it < 1248) hspec_item(p, 0, it - 1216, lds);
        else cache_item(p, l, it - 1248, lds);
      }
      }
    } break;
    case 2: {
      int& s_item = *(int*)(smem + 131072 + 16); float& s_lam = *(float*)(smem + 131072 + 20);
      const float lam_init = 0.8f - 0.6f * expf(-0.3f * (float)l);
      const int tid2 = otid();
      if (tid2 < 64) {
        int ln = tid2; float a = p.in[25][l * 64 + ln] * p.in[26][l * 64 + ln]; float b = p.in[27][l * 64 + ln] * p.in[28][l * 64 + ln];
        a = wave_sum(a); b = wave_sum(b); if (ln == 0) s_lam = expf(a) - expf(b) + lam_init;
      }
      __syncthreads();
      const float lam = s_lam;
#ifdef PROBE_M
      const int npass = 2;
#else
      const int npass = 1;
#endif
      _Pragma("unroll") for (int pass = 0; pass < npass; ++pass) {
      unsigned* ctr = (unsigned*)(p.ws + WS_CTL + 16384) + l * 64 + pass * 16;
      const int mask = pass == 0 ? 7 : PROBE_MIXMASK;
      for (;;) {
        __syncthreads();
        if (threadIdx.x == 0) s_item = (int)atomicAdd(ctr, 1u);
        __syncthreads();
        int it = s_item;
        if (it >= 1536) break;
        if (it < 128) { if (mask & 1) scan_item(p, l, 16 + (it >> 5), (it >> 3) & 3, (it >> 2) & 1, it & 3, 4, lds); }
        else if (it < 384) { int j = it - 128; if (mask & 2) attn_item(p, l, 16 + (j >> 6), (j >> 4) & 3, j & 15, smem, lam, lam_init); }
        else if (it < 640) { int j = it - 384; if (mask & 1) scan_item(p, l, j >> 4, (j >> 2) & 3, (j >> 1) & 1, j & 1, 8, lds); }
        else if (it < 1152) { int j = it - 640; if (mask & 4) hyena_fft_item(p, l, 1, j, lds); }
        else if (it < 1280) { int j = it - 1152; if (mask & 2) attn_item(p, l, j >> 3, (j >> 1) & 3, j & 1, smem, lam, lam_init); }
        else { int j = it - 1280; if (mask & 4) hyena_fft_item(p, l, 0, j, lds); }
      }
      }
    } break;
    case 3: for (int it = bid; it < 192; it += nb) fin_item(p, l, it, lds);
#ifdef PROBE_F
      for (int it = bid; it < 192; it += nb) fin_item(p, l, it, lds);
#endif
      break;
    case 4: { pg8::Gemm g{(const u16*)(p.ws + WS_MIXCAT), wout, TT, 1024, 1024}; pg8::StaticOrder S; S.init(TT, 1024, nb, bid);
              pg8::EpiBf E{(u16*)(p.ws + WS_F), 1024}; pg8::gemm_phase(ldsp, g, S, E, nullptr);
#ifdef PROBE_G
              __syncthreads(); pg8::gemm_phase(ldsp, g, S, E, nullptr);
#endif
              } break;
    case 5:
      row_phase(p, l, 1);
      if (l < 3) {
        int& s_ia = *(int*)(smem + 131072 + 28);
        unsigned* ctr = (unsigned*)(p.ws + WS_CTL + 16384) + l * 64 + 48;
        for (;;) {
          __syncthreads();
          if (threadIdx.x == 0) s_ia = (int)atomicAdd(ctr, 1u);
          __syncthreads();
          const int q = s_ia;
          if (q >= AUX_ITEMS) break;
          aux_item(p, l + 1, q < 288 ? AUX_ITEMS - 288 + q : q - 288, lds);
        }
      }
#ifdef PROBE_A
      if (l < 3) for (int it = bid; it < AUX_ITEMS; it += nb) aux_item(p, l + 1, it, lds);
#endif
#ifdef PROBE_A1
      if (l < 3) for (int it = bid; it < AUX_ITEMS - 288; it += nb) aux_item(p, l + 1, it, lds);
#endif
#ifdef PROBE_A2
      if (l < 3) for (int it = AUX_ITEMS - 288 + bid; it < AUX_ITEMS; it += nb) aux_item(p, l + 1, it, lds);
#endif
      break;
    case 6: { pg8::Gemm g{(const u16*)(p.ws + WS_H), wff1, TT, 4096, 1024}; pg8::StaticOrder S; S.init(TT, 4096, nb, bid);
              pg8::EpiRelu2 E{(u16*)(p.ws + WS_A), 4096}; pg8::gemm_phase(ldsp, g, S, E, nullptr);
#ifdef PROBE_G
              __syncthreads(); pg8::gemm_phase(ldsp, g, S, E, nullptr);
#endif
              } break;
    case 7: { pg8::Gemm g{(const u16*)(p.ws + WS_A), wff2, TT, 1024, 4096}; pg8::StaticOrder S; S.init(TT, 1024, nb, bid);
              pg8::EpiBf E{(u16*)(p.ws + WS_F), 1024}; pg8::gemm_phase(ldsp, g, S, E, nullptr);
#ifdef PROBE_G
              __syncthreads(); pg8::gemm_phase(ldsp, g, S, E, nullptr);
#endif
              } break;
    case 8: row_phase(p, l, 2); break;
  }
}

__global__ void __launch_bounds__(512) mega(Params p, int ph_lo, int ph_hi) {
  extern __shared__ __attribute__((aligned(16))) unsigned char smem[];
  uint4& xb_words = *(uint4*)(smem + 131072);
  if (threadIdx.x == 0) xb_words = make_uint4(0u, 0u, 0u, 0u);
  __syncthreads();
  (void)xcd_barrier_post((unsigned*)(p.ws + WS_CTL), (volatile LAS unsigned*)&xb_words);
  for (int ph = ph_lo; ph < ph_hi; ++ph) {
    if (ph > ph_lo) { XcdBarrier xb; xb.bar = (unsigned*)(p.ws + WS_CTL); xb.x = xb_xcc_id(); xb.st = (volatile LAS unsigned*)(smem + 131072); xcd_barrier(xb);
#ifdef PROBE_B
      xcd_barrier(xb);
#endif
    }
    run_phase(p, ph, smem);
  }
}

extern "C" void kernel_launch(void* const* d_in, const int* in_sizes, int n_in, void* d_out, int out_size, void* d_ws, size_t ws_size, hipStream_t stream) {
  static int grid = 0;
  if (!grid) {
    int dev = 0, cus = 0, per_cu = 0;
    hipGetDevice(&dev);
    hipDeviceGetAttribute(&cus, hipDeviceAttributeMultiprocessorCount, dev);
    hipFuncSetAttribute((const void*)mega, hipFuncAttributeMaxDynamicSharedMemorySize, (int)LDS_BYTES);
    hipOccupancyMaxActiveBlocksPerMultiprocessor(&per_cu, (const void*)mega, NT, LDS_BYTES);
    if (per_cu < 1) { fprintf(stderr, "occupancy query says %d blocks/CU\n", per_cu); per_cu = 1; }
    grid = cus;
  }
  if (n_in != 43 || ws_size < WS_END) { fprintf(stderr, "kernel_launch: bad n_in %d or ws %zu < %zu\n", n_in, ws_size, (size_t)WS_END); return; }
  Params p{};
  for (int i = 0; i < 43; ++i) p.in[i] = (const float*)d_in[i];
  p.out = (float*)d_out; p.ws = (unsigned char*)d_ws;
  (void)hipMemsetAsync((unsigned char*)d_ws + WS_CTL, 0, 32768, stream);
#if ONE_LAUNCH
  int lo = 0, hi = NPH; void* args[] = {&p, &lo, &hi};
  hipError_t e = hipLaunchCooperativeKernel((const void*)mega, dim3(grid), dim3(NT), args, LDS_BYTES, stream);
  if (e != hipSuccess) fprintf(stderr, "cooperative launch failed: %s\n", hipGetErrorString(e));
#else
  for (int ph = 0; ph < NPH; ++ph) hipLaunchKernelGGL(mega, dim3(grid), dim3(NT), LDS_BYTES, stream, p, ph, ph + 1);
#endif
}
```

```cpp
#include <hip/hip_runtime.h>
#include <hip/hip_cooperative_groups.h>
#include <stdint.h>
#include <stdio.h>
namespace cg = cooperative_groups;

#ifndef ONE_LAUNCH
#define ONE_LAUNCH 1
#endif

#ifndef PROBE_DUPK
#define PROBE_DUPK 0
#endif
#ifndef PROBE_MIXMASK
#define PROBE_MIXMASK 7
#endif
#define DI __device__ __forceinline__
typedef unsigned short u16;
using bf16x8 = __attribute__((ext_vector_type(8))) short;
using s16x4  = __attribute__((ext_vector_type(4))) short;
using f32x4  = __attribute__((ext_vector_type(4))) float;
using f32x16 = __attribute__((ext_vector_type(16))) float;

constexpr int NT = 512;
constexpr int TT = 12288;
constexpr int NU = 3456;
constexpr size_t LDS_BYTES = 131072 + 64;

constexpr size_t WS_CTL = 0;
constexpr size_t WS_MOD = 32768;
constexpr size_t WS_W   = WS_MOD + 491520;
constexpr size_t W_IN_B = 3584ull * 1024 * 2, W_OUT_B = 1024ull * 1024 * 2, W_FF_B = 4096ull * 1024 * 2;
constexpr size_t W_SLOT = W_IN_B + W_OUT_B + 2 * W_FF_B;
constexpr size_t WS_H   = WS_W + 2 * W_SLOT;
constexpr size_t WS_U   = WS_H + (size_t)TT * 1024 * 2;
constexpr size_t WS_MIXCAT = WS_U + (size_t)TT * NU * 2;
constexpr size_t WS_KL  = WS_MIXCAT + (size_t)TT * 1024 * 2;
constexpr size_t WS_VL  = WS_KL + 4ull * 2304 * 512 * 2;
constexpr size_t WS_RW  = WS_VL + 4ull * 2304 * 512 * 2;
constexpr size_t WS_G   = WS_RW + (size_t)TT * 4 * 9 * 64 * 4;
constexpr size_t WS_BC  = WS_G + (size_t)TT * 256 * 4;
constexpr size_t WS_HYT = WS_BC + (size_t)TT * 4 * 8 * 4;
constexpr size_t WS_FILT = WS_HYT + 3ull * 256 * TT * 4;
constexpr size_t WS_HSPEC = WS_FILT + 2ull * 256 * (512 + 4096) * 4;
constexpr size_t WS_ROPE = WS_HSPEC + 2ull * 256 * (512 + 4096) * 8;
constexpr size_t WS_WTL = WS_ROPE + 8192;
constexpr size_t WS_END = WS_WTL + 4ull * 256 * 384 * 2;
constexpr size_t WS_Q  = WS_H;
constexpr size_t WS_KC = WS_Q + (size_t)TT * 512 * 2;
constexpr size_t WS_VC = WS_KC + 16ull * 256 * 512 * 2;
constexpr size_t WS_YS = WS_U;
constexpr size_t WS_YC = WS_U + 2ull * TT * 256 * 4;
constexpr size_t WS_F  = WS_U;
constexpr size_t WS_A  = WS_RW;
static_assert(WS_VC + 16ull * 256 * 512 * 2 <= WS_U, "alias");
static_assert(WS_YC + 256ull * TT * 4 <= WS_MIXCAT, "alias");
static_assert((size_t)TT * 4096 * 2 <= (size_t)TT * 4 * 9 * 64 * 4, "alias");

constexpr size_t OUT_STATE = 12582912, OUT_CK = 14680064, OUT_CV = 23068672;

struct Params {
  const float* in[43];
  float* out;
  unsigned char* ws;
};

DI u16 f2bf(float x) { unsigned u = __float_as_uint(x); u += 0x7fffu + ((u >> 16) & 1u); return (u16)(u >> 16); }
DI float bf2f(u16 b) { return __uint_as_float(((unsigned)b) << 16); }
DI unsigned pack2(float a, float b) { return (unsigned)f2bf(a) | ((unsigned)f2bf(b) << 16); }
template <int CTRL> DI float dppf(float x) {
  return __builtin_bit_cast(float, __builtin_amdgcn_update_dpp(0, __builtin_bit_cast(int, x), CTRL, 0xF, 0xF, true));
}
DI float allreduce16(float x) {
  x += dppf<0xB1>(x); x += dppf<0x4E>(x); x += dppf<0x124>(x); x += dppf<0x128>(x);
  return x;
}
DI float wave_sum(float v) {
  v = allreduce16(v);
  const int iv = __builtin_bit_cast(int, v);
  const float a = __builtin_bit_cast(float, __builtin_amdgcn_readlane(iv, 0)), b = __builtin_bit_cast(float, __builtin_amdgcn_readlane(iv, 16));
  const float c = __builtin_bit_cast(float, __builtin_amdgcn_readlane(iv, 32)), d = __builtin_bit_cast(float, __builtin_amdgcn_readlane(iv, 48));
  return (a + b) + (c + d);
}
DI void seq_of(int row, int& s, int& t, int& L, int& row0) {
  if (row < 4096) { s = row >> 8; t = row & 255; L = 256; row0 = s * 256; }
  else { int r = row - 4096; s = 16 + (r >> 11); t = r & 2047; L = 2048; row0 = 4096 + (r >> 11) * 2048; }
}
DI unsigned cvtpk(float lo, float hi) { unsigned r; asm volatile("v_cvt_pk_bf16_f32 %0, %1, %2" : "=v"(r) : "v"(lo), "v"(hi)); return r; }
DI float ozero() { float z; asm volatile("v_mov_b32 %0, 0" : "=v"(z)); return z; }
DI float shfl32(float v, int lane) { return __builtin_bit_cast(float, __builtin_amdgcn_ds_bpermute((lane ^ 32) << 2, __builtin_bit_cast(int, v))); }
typedef unsigned u32x4_t __attribute__((ext_vector_type(4)));
DI uint4 ldnt_u4(const void* p) { const u32x4_t t = __builtin_nontemporal_load((const u32x4_t*)p); return make_uint4(t[0], t[1], t[2], t[3]); }
DI float4 ldnt_f4(const float* p) { const f32x4 t = __builtin_nontemporal_load((const f32x4*)p); return make_float4(t[0], t[1], t[2], t[3]); }
DI int otid() { int t = threadIdx.x; asm volatile("" : "+v"(t)); return t; }
DI float sigmoidf_(float x) { return 1.f / (1.f + expf(-x)); }
DI float fexp(float x) { return __builtin_amdgcn_exp2f(x * 1.4426950408889634f); }
DI float fsig(float x) { return __builtin_amdgcn_rcpf(1.f + fexp(-x)); }


#define XB_TMO      128
#define XB_XCNT(j)  (256  + 64 * (j))
#define XB_XSUB(j)  (1280 + 64 * (j))
#define XB_XGEN(j)  (2304 + 64 * (j))
#define XB_TOP      3328
#define XB_TOPGEN   3392
#define XB_SPIN_CAP (1u << 22)
#define LAS __attribute__((address_space(3)))
DI unsigned xb_ld(unsigned* p)              { return __hip_atomic_load(p, __ATOMIC_RELAXED, __HIP_MEMORY_SCOPE_AGENT); }
DI unsigned xb_add(unsigned* p, unsigned v) { return __hip_atomic_fetch_add(p, v, __ATOMIC_RELAXED, __HIP_MEMORY_SCOPE_AGENT); }
DI unsigned xb_xcc_id() { return (unsigned)__builtin_amdgcn_s_getreg((3 << 11) | 20) & 0xFu; }
#define XB_SPIN(cond, bar) do { unsigned _sp = 0; while (cond) { __builtin_amdgcn_s_sleep(1); \
    if ((++_sp & 255u) == 0u) { if (xb_ld(&(bar)[XB_TMO])) break; if (_sp > XB_SPIN_CAP) { atomicAdd(&(bar)[XB_TMO], 1u); break; } } } } while (0)
struct XcdBarrier { unsigned* bar; unsigned x; volatile LAS unsigned* st; };
DI XcdBarrier xcd_barrier_post(unsigned* bar, volatile LAS unsigned* st) {
  XcdBarrier b; b.bar = bar; b.x = xb_xcc_id(); b.st = st;
  if (threadIdx.x == 0) (void)xb_add(&bar[XB_XCNT(b.x)], 1u);
  return b;
}
DI void xcd_barrier_complete(unsigned* bar, unsigned x, unsigned& nloc, unsigned& nx) {
  const unsigned G = gridDim.x * gridDim.y * gridDim.z;
  unsigned sum, cnt, mine, sp = 0u;
  for (;;) {
    sum = 0u; cnt = 0u; mine = 0u;
#pragma unroll
    for (unsigned j = 0; j < 16; ++j) { const unsigned c = xb_ld(&bar[XB_XCNT(j)]); sum += c; cnt += (c > 0u) ? 1u : 0u; mine = (j == x) ? c : mine; }
    if (sum == G) break;
    __builtin_amdgcn_s_sleep(1);
    if ((++sp & 255u) == 0u) { if (xb_ld(&bar[XB_TMO])) break; if (sp > XB_SPIN_CAP) { atomicAdd(&bar[XB_TMO], 1u); break; } }
  }
  nloc = mine > 0u ? mine : 1u; nx = cnt > 0u ? cnt : 1u;
}
DI void xcd_barrier(const XcdBarrier& b) {
  asm volatile("s_waitcnt vmcnt(0)" ::: "memory");
  __syncthreads();
  if (threadIdx.x == 0) {
    unsigned* bar = b.bar;
    __builtin_amdgcn_s_waitcnt(0);
    unsigned nloc = b.st[0], nx = b.st[1];
    if (nloc == 0u) { xcd_barrier_complete(bar, b.x, nloc, nx); b.st[0] = nloc; b.st[1] = nx; }
    const unsigned old = xb_add(&bar[XB_XSUB(b.x)], 1u);
    const unsigned gen = old / nloc;
    if (old + 1u == (gen + 1u) * nloc) {
      __builtin_amdgcn_fence(__ATOMIC_RELEASE, "agent");
      asm volatile("s_waitcnt vmcnt(0)" ::: "memory");
      const unsigned og = xb_add(&bar[XB_TOP], 1u);
      const unsigned tg = og / nx;
      if (og + 1u == (tg + 1u) * nx) xb_add(&bar[XB_TOPGEN], 1u);
      else XB_SPIN(xb_ld(&bar[XB_TOPGEN]) == tg, bar);
      __builtin_amdgcn_fence(__ATOMIC_ACQUIRE, "agent");
      xb_add(&bar[XB_XGEN(b.x)], 1u);
      asm volatile("s_waitcnt vmcnt(0)" ::: "memory");
    } else {
      XB_SPIN(xb_ld(&bar[XB_XGEN(b.x)]) == gen, bar);
      __builtin_amdgcn_fence(__ATOMIC_ACQUIRE, "agent");
      asm volatile("s_waitcnt vmcnt(0)" ::: "memory");
    }
  }
  __syncthreads();
}

DI void tr_tile(const float* __restrict__ W, int K, int N, u16* __restrict__ Wt, int k0, int n0, float* lds) {
  const int tid = otid();
  float4 v[4];
#pragma unroll
  for (int i = 0; i < 4; ++i) { int idx = tid + i * 512; int kk = idx >> 5, n4 = (idx & 31) * 4; const f32x4 t_ = __builtin_nontemporal_load((const f32x4*)(W + (size_t)(k0 + kk) * N + n0 + n4)); v[i] = make_float4(t_[0], t_[1], t_[2], t_[3]); }
#pragma unroll
  for (int i = 0; i < 4; ++i) { int idx = tid + i * 512; int kk = idx >> 5, n4 = (idx & 31) * 4; float* d = lds + kk * 129 + n4; d[0] = v[i].x; d[1] = v[i].y; d[2] = v[i].z; d[3] = v[i].w; }
  __syncthreads();
#pragma unroll
  for (int hlf = 0; hlf < 2; ++hlf) {
    const int n = hlf * 64 + (tid >> 3), kg = tid & 7;
    unsigned pk[4];
#pragma unroll
    for (int j = 0; j < 4; ++j) pk[j] = pack2(lds[(kg * 8 + 2 * j) * 129 + n], lds[(kg * 8 + 2 * j + 1) * 129 + n]);
    { const u32x4_t t_ = {pk[0], pk[1], pk[2], pk[3]}; __builtin_nontemporal_store(t_, (u32x4_t*)(Wt + (size_t)(n0 + n) * K + k0 + kg * 8)); }
  }
  __syncthreads();
}

DI void filt_item(const Params& p, int l, int it, float* lds) {
  const int Lsel = it >= 32; const int chunk = Lsel ? it - 32 : it; const int L = Lsel ? 2048 : 256;
  float* emb = lds; float* h1 = lds + 8 * 36; float* h2 = h1 + 512;
  const int tid = otid();
  const float* w1 = p.in[32] + l * 33 * 64; const float* b1 = p.in[33] + l * 64; const float* fr = p.in[34] + l * 64;
  const float* w2 = p.in[35] + l * 4096; const float* b2 = p.in[36] + l * 64; const float* w3 = p.in[37] + (size_t)l * 64 * 1024;
  const float* dec = p.in[38] + l * 256;
  if (tid < 8 * 33) {
    int ti = tid / 33, j = tid % 33; int i = chunk * 8 + ti; float v;
    float ang = (float)(2.0 * 3.14159265358979323846 / (double)L) * (float)i;
    if (j == 0) v = (float)i / (float)(L - 1);
    else if (j <= 16) { float band = 1e-4f + (float)(j - 1) * ((15.f - 1e-4f) / 15.f); v = cosf(band * ang); }
    else { float band = 1e-4f + (float)(j - 17) * ((15.f - 1e-4f) / 15.f); v = -sinf(band * ang); }
    emb[ti * 36 + j] = v;
  }
  __syncthreads();
  { int ti = tid >> 6, j = tid & 63; float a = b1[j];
    for (int k = 0; k < 32; k += 4) { const float q0 = w1[k * 64 + j], q1 = w1[(k + 1) * 64 + j], q2 = w1[(k + 2) * 64 + j], q3 = w1[(k + 3) * 64 + j];
      a += emb[ti * 36 + k] * q0 + emb[ti * 36 + k + 1] * q1 + emb[ti * 36 + k + 2] * q2 + emb[ti * 36 + k + 3] * q3; }
    a += emb[ti * 36 + 32] * w1[32 * 64 + j];
    h1[ti * 64 + j] = sinf(fr[j] * a); }
  __syncthreads();
  { int ti = tid >> 6, j = tid & 63; float a = b2[j];
#pragma unroll 2
    for (int k = 0; k < 64; k += 4) { const float q0 = w2[k * 64 + j], q1 = w2[(k + 1) * 64 + j], q2 = w2[(k + 2) * 64 + j], q3 = w2[(k + 3) * 64 + j];
      const float4 hv = *(const float4*)(h1 + ti * 64 + k); a += hv.x * q0 + hv.y * q1 + hv.z * q2 + hv.w * q3; }
    h2[ti * 64 + j] = sinf(fr[j] * a); }
  __syncthreads();
  float* FILT = (float*)(p.ws + WS_FILT) + (Lsel ? 262144 : 0);
  {
    float acc[2][8];
#pragma unroll
    for (int ti = 0; ti < 8; ++ti) { acc[0][ti] = 0.f; acc[1][ti] = 0.f; }
#pragma unroll 2
    for (int k = 0; k < 64; k += 4) {
      const float2 q0 = *(const float2*)(w3 + k * 1024 + 2 * tid), q1 = *(const float2*)(w3 + (k + 1) * 1024 + 2 * tid);
      const float2 q2 = *(const float2*)(w3 + (k + 2) * 1024 + 2 * tid), q3 = *(const float2*)(w3 + (k + 3) * 1024 + 2 * tid);
#pragma unroll
      for (int ti = 0; ti < 8; ++ti) { const float4 hv = *(const float4*)(h2 + ti * 64 + k);
        acc[0][ti] += hv.x * q0.x + hv.y * q1.x + hv.z * q2.x + hv.w * q3.x;
        acc[1][ti] += hv.x * q0.y + hv.y * q1.y + hv.z * q2.y + hv.w * q3.y; }
    }
#pragma unroll
    for (int cc = 0; cc < 2; ++cc) {
      const int col = 2 * tid + cc;
      int order = col >> 9, dir = (col >> 8) & 1, c = col & 255; float dc = fabsf(dec[c]);
      float* g = FILT + (size_t)(order * 256 + c) * (2 * L);
#pragma unroll
      for (int ti = 0; ti < 8; ++ti) {
        int i = chunk * 8 + ti; float t = (float)i / (float)(L - 1); float val = acc[cc][ti] * expf(-t * dc);
        if (dir == 0) g[L + i] = val; else { if (i == 0) g[0] = 0.f; else g[L - i] = val; }
      }
    }
  }
  __syncthreads();
}

constexpr int AUX_ITEMS = 432 + 128 + 512 + 512 + 1 + 288;
DI void aux_item(const Params& p, int l, int it, float* lds) {
  unsigned char* slot = p.ws + WS_W + (size_t)(l & 1) * W_SLOT;
  u16* win = (u16*)slot; u16* wout = (u16*)(slot + W_IN_B); u16* wff1 = (u16*)(slot + W_IN_B + W_OUT_B); u16* wff2 = (u16*)(slot + W_IN_B + W_OUT_B + W_FF_B);
  if (it < 432) { int kt = it / 27, nt = it % 27; tr_tile(p.in[13] + (size_t)l * 1024 * NU, 1024, NU, win, kt * 64, nt * 128, lds); return; }
  it -= 432;
  if (it < 128) { int kt = it >> 3, nt = it & 7; tr_tile(p.in[40] + (size_t)l * 1024 * 1024, 1024, 1024, wout, kt * 64, nt * 128, lds); return; }
  it -= 128;
  if (it < 512) { int kt = it >> 5, nt = it & 31; tr_tile(p.in[41] + (size_t)l * 1024 * 4096, 1024, 4096, wff1, kt * 64, nt * 128, lds); return; }
  it -= 512;
  if (it < 512) { int kt = it >> 3, nt = it & 7; tr_tile(p.in[42] + (size_t)l * 4096 * 1024, 4096, 1024, wff2, kt * 64, nt * 128, lds); return; }
  it -= 512;
  if (it < 1) { uint4* z = (uint4*)(win + (size_t)NU * 1024); for (int i = otid(); i < 16384; i += 512) z[i] = make_uint4(0, 0, 0, 0); return; }
  it -= 1;
  filt_item(p, l, it, lds);
}

DI void mod_item(const Params& p, int it, float* lds) {
  const int l = it / 96, cgp = it % 96, tid = otid();
  float* sc = lds; float* red = lds + 5120;
  for (int i = tid; i < 5120; i += 512) { int j = i >> 10, k = i & 1023; float c = (j == 0) ? p.in[6][k] : p.in[5][(j - 1) * 1024 + k]; sc[i] = c / (1.f + expf(-c)); }
  __syncthreads();
  const int c4 = (tid & 15) * 4, kg = tid >> 4; const float* w = p.in[7] + (size_t)l * 1024 * 6144 + cgp * 64 + c4;
  float4 acc[5];
#pragma unroll
  for (int j = 0; j < 5; ++j) acc[j] = make_float4(0.f, 0.f, 0.f, 0.f);
#pragma unroll 8
  for (int k = kg; k < 1024; k += 32) { const f32x4 wt_ = __builtin_nontemporal_load((const f32x4*)(w + (size_t)k * 6144)); const float4 wv = make_float4(wt_[0], wt_[1], wt_[2], wt_[3]);
#pragma unroll
    for (int j = 0; j < 5; ++j) { const float sv = sc[j * 1024 + k]; acc[j].x += sv * wv.x; acc[j].y += sv * wv.y; acc[j].z += sv * wv.z; acc[j].w += sv * wv.w; } }
#pragma unroll
  for (int j = 0; j < 5; ++j) *(float4*)(red + (kg * 5 + j) * 64 + c4) = acc[j];
  __syncthreads();
  if (tid < 320) { int j = tid >> 6, cc = tid & 63; float sm = 0.f; for (int g = 0; g < 32; ++g) sm += red[(g * 5 + j) * 64 + cc];
    sm += p.in[8][l * 6144 + cgp * 64 + cc]; ((float*)(p.ws + WS_MOD))[(l * 5 + j) * 6144 + cgp * 64 + cc] = sm; }
  __syncthreads();
}

DI void row_phase(const Params& p, int l, int mode) {
  const int tid = otid(), lane = tid & 63; const int gw = blockIdx.x * 8 + (tid >> 6), nw = gridDim.x * 8;
  float* x = p.out; const u16* F = (const u16*)(p.ws + WS_F); u16* H = (u16*)(p.ws + WS_H); const float* MOD = (const float*)(p.ws + WS_MOD);
  const float* gpost = nullptr; const float* gpre = nullptr; int gate_ch = 0, sc_ch = 0, sh_ch = 0, lm = l; bool do_h = true;
  if (mode == 0) { gpre = p.in[9] + l * 1024; sc_ch = 1; sh_ch = 0; lm = l; }
  else if (mode == 1) { gpost = p.in[10] + l * 1024; gate_ch = 2; gpre = p.in[11] + l * 1024; sc_ch = 4; sh_ch = 3; lm = l; }
  else { gpost = p.in[12] + l * 1024; gate_ch = 5; if (l < 3) { gpre = p.in[9] + (l + 1) * 1024; sc_ch = 1; sh_ch = 0; lm = l + 1; } else do_h = false; }
  const int rpw = (TT + nw - 1) / nw;
  float4 fa[4], fb[4], fc[4]; int jprev = -1;
#pragma unroll
  for (int i = 0; i < 4; ++i) { fa[i] = make_float4(0.f, 0.f, 0.f, 0.f); fb[i] = fa[i]; fc[i] = fa[i]; }
  for (int rr = 0; rr < rpw; ++rr) {
    const int row = gw * rpw + rr; if (row >= TT) break;
    const int j = row < 4096 ? 0 : 1 + ((row - 4096) >> 11);
    if (j != jprev) {
      jprev = j;
#pragma unroll
      for (int i = 0; i < 4; ++i) {
        const int col = i * 256 + lane * 4;
        if (mode != 0) { const float4 g4 = *(const float4*)(MOD + (l * 5 + j) * 6144 + gate_ch * 1024 + col); const float4 p4 = *(const float4*)(gpost + col);
          fa[i] = make_float4(g4.x * p4.x, g4.y * p4.y, g4.z * p4.z, g4.w * p4.w); }
        if (do_h) { const float4 g4 = *(const float4*)(gpre + col); const float4 s4 = *(const float4*)(MOD + (lm * 5 + j) * 6144 + sc_ch * 1024 + col);
          fb[i] = make_float4(g4.x * (1.f + s4.x), g4.y * (1.f + s4.y), g4.z * (1.f + s4.z), g4.w * (1.f + s4.w));
          fc[i] = *(const float4*)(MOD + (lm * 5 + j) * 6144 + sh_ch * 1024 + col); }
      }
    }
    const float* xs = (mode == 0) ? (row < 4096 ? p.in[0] + (size_t)row * 1024 : p.in[1] + (size_t)(row - 4096) * 1024) : x + (size_t)row * 1024;
    float4 xv[4];
#pragma unroll
    for (int i = 0; i < 4; ++i) xv[i] = ldnt_f4(xs + i * 256 + lane * 4);
    if (mode != 0) {
      float4 dv[4]; float ss = 0.f;
#pragma unroll
      for (int i = 0; i < 4; ++i) { const unsigned long long fq_ = __builtin_nontemporal_load((const unsigned long long*)(F + (size_t)row * 1024 + i * 256 + lane * 4)); const uint2 fw = make_uint2((unsigned)fq_, (unsigned)(fq_ >> 32)); dv[i] = make_float4(bf2f((u16)fw.x), bf2f((u16)(fw.x >> 16)), bf2f((u16)fw.y), bf2f((u16)(fw.y >> 16))); ss += dv[i].x * dv[i].x + dv[i].y * dv[i].y + dv[i].z * dv[i].z + dv[i].w * dv[i].w; }
      ss = wave_sum(ss); const float rs = rsqrtf(ss * (1.f / 1024.f) + 1e-6f);
#pragma unroll
      for (int i = 0; i < 4; ++i) { xv[i].x += fa[i].x * dv[i].x * rs; xv[i].y += fa[i].y * dv[i].y * rs; xv[i].z += fa[i].z * dv[i].z * rs; xv[i].w += fa[i].w * dv[i].w * rs; }
    }
#pragma unroll
    for (int i = 0; i < 4; ++i) { const f32x4 t_ = {xv[i].x, xv[i].y, xv[i].z, xv[i].w}; __builtin_nontemporal_store(t_, (f32x4*)(x + (size_t)row * 1024 + i * 256 + lane * 4)); }
    if (do_h) {
      float ss = 0.f;
#pragma unroll
      for (int i = 0; i < 4; ++i) ss += xv[i].x * xv[i].x + xv[i].y * xv[i].y + xv[i].z * xv[i].z + xv[i].w * xv[i].w;
      ss = wave_sum(ss); const float rs = rsqrtf(ss * (1.f / 1024.f) + 1e-6f);
#pragma unroll
      for (int i = 0; i < 4; ++i) { const int col = i * 256 + lane * 4;
        const float a = xv[i].x * rs * fb[i].x + fc[i].x, b2 = xv[i].y * rs * fb[i].y + fc[i].y, c = xv[i].z * rs * fb[i].z + fc[i].z, d = xv[i].w * rs * fb[i].w + fc[i].w;
        *(uint2*)(H + (size_t)row * 1024 + col) = make_uint2(pack2(a, b2), pack2(c, d)); }
    }
  }
}

template <int EPI>
DI void gemm_phase(const Params& p, const u16* __restrict__ A, const u16* __restrict__ Wt, int K, int NTn, int l, void* Cout, int ldc, unsigned char* smem) {
  u16* As = (u16*)smem; u16* Bs = As + 2 * 128 * 72;
  const int tid = otid(), lane = tid & 63, wid = tid >> 6, wm = wid & 1, wn = wid >> 1, fr = lane & 15, fq = lane >> 4;
  const int ntiles = 96 * NTn, nk = K / 64;
  for (int tile = blockIdx.x; tile < ntiles; tile += gridDim.x) {
    const int mt = tile / NTn, nt = tile % NTn; const int m0 = mt * 128, n0 = nt * 256;
    f32x4 acc[4][4];
#pragma unroll
    for (int i = 0; i < 4; ++i)
#pragma unroll
      for (int j = 0; j < 4; ++j) acc[i][j] = f32x4{0.f, 0.f, 0.f, 0.f};
    uint4 pa0, pa1, pb0, pb1, pb2, pb3, qa0, qa1, qb0, qb1, qb2, qb3;
    const int lrow = tid >> 3, lkc = tid & 7;
    const u16* ag = A + (size_t)(m0 + lrow) * K + lkc * 8;
    const u16* bg = Wt + (size_t)(n0 + lrow) * K + lkc * 8;
#define GLOAD(P, kt) { P##a0 = *(const uint4*)(ag + (kt) * 64); P##a1 = *(const uint4*)(ag + (size_t)64 * K + (kt) * 64); \
      P##b0 = *(const uint4*)(bg + (kt) * 64); P##b1 = *(const uint4*)(bg + (size_t)64 * K + (kt) * 64); \
      P##b2 = *(const uint4*)(bg + (size_t)128 * K + (kt) * 64); P##b3 = *(const uint4*)(bg + (size_t)192 * K + (kt) * 64); }
#define SSTORE(P, buf) { u16* sa_ = As + (buf) * 128 * 72 + lrow * 72 + lkc * 8; u16* sb_ = Bs + (buf) * 256 * 72 + lrow * 72 + lkc * 8; \
      *(uint4*)sa_ = P##a0; *(uint4*)(sa_ + 64 * 72) = P##a1; *(uint4*)sb_ = P##b0; *(uint4*)(sb_ + 64 * 72) = P##b1; *(uint4*)(sb_ + 128 * 72) = P##b2; *(uint4*)(sb_ + 192 * 72) = P##b3; }
#define COMPUTE(buf) { const u16* as = As + (buf) * 128 * 72 + (wm * 64 + fr) * 72 + fq * 8; const u16* bs = Bs + (buf) * 256 * 72 + (wn * 64 + fr) * 72 + fq * 8; \
      _Pragma("unroll") for (int ks = 0; ks < 2; ++ks) { bf16x8 wf[4], af[4]; \
        _Pragma("unroll") for (int i = 0; i < 4; ++i) { wf[i] = *(const bf16x8*)(bs + i * 16 * 72 + ks * 32); af[i] = *(const bf16x8*)(as + i * 16 * 72 + ks * 32); } \
        _Pragma("unroll") for (int i = 0; i < 4; ++i) _Pragma("unroll") for (int j = 0; j < 4; ++j) acc[i][j] = __builtin_amdgcn_mfma_f32_16x16x32_bf16(wf[i], af[j], acc[i][j], 0, 0, 0); } }
    GLOAD(p, 0); SSTORE(p, 0);
    GLOAD(p, 1); GLOAD(q, 2);
    __syncthreads();
    for (int kt = 0; kt < nk; kt += 2) {
      SSTORE(p, 1);
      if (kt + 3 < nk) GLOAD(p, kt + 3);
      COMPUTE(0);
      __syncthreads();
      if (kt + 2 < nk) SSTORE(q, 0);
      if (kt + 4 < nk) GLOAD(q, kt + 4);
      COMPUTE(1);
      __syncthreads();
    }
#undef GLOAD
#undef SSTORE
#undef COMPUTE
#pragma unroll
    for (int i = 0; i < 4; ++i)
#pragma unroll
      for (int j = 0; j < 4; ++j) {
        const int row = m0 + wm * 64 + j * 16 + fr; const int col = n0 + wn * 64 + i * 16 + fq * 4; const f32x4 v = acc[i][j];
        if (EPI == 0) {
          if (col < NU) {
            *(uint2*)((u16*)Cout + (size_t)row * NU + col) = make_uint2(pack2(v[0], v[1]), pack2(v[2], v[3]));
            if (row < 4096 && col >= 1664 && col < 2688) {
              int b = row >> 8, t = row & 255;
              float* dst = (col < 2176) ? p.out + OUT_CK + ((size_t)((b * 4 + l) * 256 + t)) * 512 + (col - 1664)
                                        : p.out + OUT_CV + ((size_t)((b * 4 + l) * 256 + t)) * 512 + (col - 2176);
              *(float4*)dst = make_float4(v[0], v[1], v[2], v[3]);
            }
          }
        } else if (EPI == 1) {
          *(float4*)((float*)Cout + (size_t)row * ldc + col) = make_float4(v[0], v[1], v[2], v[3]);
        } else {
          float a = fmaxf(v[0], 0.f), b = fmaxf(v[1], 0.f), c = fmaxf(v[2], 0.f), d = fmaxf(v[3], 0.f);
          *(uint2*)((u16*)Cout + (size_t)row * ldc + col) = make_uint2(pack2(a * a, b * b), pack2(c * c, d * d));
        }
      }
  }
}

namespace pg8 {
#define PG8_LAS __attribute__((address_space(3)))
typedef unsigned short bf16_t;
typedef short bf16x8 __attribute__((ext_vector_type(8)));
typedef float f32x4 __attribute__((ext_vector_type(4)));
typedef unsigned u32x4 __attribute__((ext_vector_type(4)));
constexpr int BM = 256, BK = 64, HALF = 128, HTB = HALF * BK * 2  , STAGE_BYTES = 8 * HTB, NXCD = 8, WGM = 8;

__host__ __device__ __forceinline__ int lds_byte(int r, int c) { const int st = (r >> 4) * 2 + (c >> 5), rr = r & 15, cc = c & 31, ob = rr * 64 + cc * 2; return st * 1024 + (ob ^ (((ob >> 9) & 1) << 5)); }
__host__ __device__ __forceinline__ void stage_rc(int b, int& R, int& C) { const int st = b / 1024, sb = b % 1024, swz = sb ^ (((sb >> 9) & 1) << 5); R = (st >> 1) * 16 + swz / 64; C = (st & 1) * 32 + (swz % 64) / 2; }
__host__ __device__ __forceinline__ int perm32(int rho) { const int n = rho >> 4, i = rho & 15; return 8 * (i >> 2) + 4 * n + (i & 3); }

struct Unit { int pm, pn; };
struct Gemm { const bf16_t* A; const bf16_t* Bt; int M, N, K; };
struct StaticOrder {
    int nM, nN, nwg, G, c;
    __host__ __device__ void init(int M, int N, int G_, int c_) { nM = M / BM; nN = N / BM; nwg = nM * nN; G = G_; c = c_; }
    __host__ __device__ bool next(int i, Unit& u) const {
        const long L = (long)i * G + c; if (L >= nwg) return false;
        int wgid = (int)L; { const int q = nwg / NXCD, r = nwg % NXCD, xcd = wgid % NXCD, off = wgid / NXCD; wgid = (xcd < r ? xcd * (q + 1) : r * (q + 1) + (xcd - r) * q) + off; }
        const int nig = WGM * nN, gid = wgid / nig, fm = gid * WGM, gsz = (nM - fm) < WGM ? (nM - fm) : WGM;
        u.pm = fm + ((wgid % nig) % gsz); u.pn = (wgid % nig) / gsz; return true;
    }
    __device__ __forceinline__ void a_ready(const Unit&) const {}
    __device__ __forceinline__ void done(const Unit&) const {}
};
__device__ __forceinline__ unsigned cvt_pk_bf16(float lo, float hi) { unsigned r; asm volatile("v_cvt_pk_bf16_f32 %0, %1, %2" : "=v"(r) : "v"(lo), "v"(hi)); return r; }
template <class Epi, class Sched, bool STAMP = false>
__device__ __forceinline__ void gemm_phase(PG8_LAS unsigned char* lds, const Gemm g, const Sched& S, const Epi& E, unsigned long long* stamps) {
    const int tid = otid(), wid = __builtin_amdgcn_readfirstlane(tid >> 6), lane = tid & 63, wr = wid >> 2, wc = wid & 3, fr = lane & 15, fq = lane >> 4;
    const int K = g.K, nt = K / BK;
    int ts_lo = 0, ts_hi = 0, nts = 0; const unsigned long long rt_entry = STAMP ? (unsigned long long)wall_clock64() : 0ull;
#define PG8_STAMP() do { if (STAMP && wid == 0 && nts < 64) { const unsigned long long _c = (unsigned long long)clock64(); \
        ts_lo = (lane == nts) ? (int)(unsigned)_c : ts_lo; ts_hi = (lane == nts) ? (int)(unsigned)(_c >> 32) : ts_hi; ++nts; } } while (0)
    PG8_STAMP();
    unsigned voffA[2], voffB[2];
#pragma unroll
    for (int i = 0; i < 2; ++i) { int R, C; stage_rc(tid * 16 + i * 8192, R, C); const int Rb = Epi::PERM ? ((R & ~31) + perm32(R & 31)) : R;
        voffA[i] = (unsigned)(R * K + C) * 2u; voffB[i] = (unsigned)(Rb * K + C) * 2u; }
    const size_t kstep = (size_t)(BK * 2);
    const size_t hstep = (size_t)HALF * K * 2;
    const size_t tstep = 2 * hstep;
    const unsigned ldsw = (unsigned)wid * 1024u;
    const int aoff = lds_byte(wr * 64 + fr, fq * 8), boff = lds_byte(wc * 32 + fr, fq * 8);
#define PG8_SA(b, h) (((b) * 2 + (h)) * HTB)
#define PG8_SB(b, h) ((4 + (b) * 2 + (h)) * HTB)
#define PG8_STAGE(bufoff, gbase, voff) do { _Pragma("unroll") for (int _i = 0; _i < 2; ++_i) \
        __builtin_amdgcn_global_load_lds((const unsigned*)((const char*)(gbase) + (voff)[_i]), (PG8_LAS unsigned*)(lds + (bufoff) + ldsw + _i * 8192), 16, 0, 0); } while (0)
#define PG8_LDA(dst, b, h) do { _Pragma("unroll") for (int m = 0; m < 4; ++m) _Pragma("unroll") for (int k = 0; k < 2; ++k) dst[m][k] = *(const PG8_LAS bf16x8*)(lds + PG8_SA(b, h) + aoff + m * 2048 + k * 1024); } while (0)
#define PG8_LDB(dst, b, h) do { _Pragma("unroll") for (int n = 0; n < 2; ++n) _Pragma("unroll") for (int k = 0; k < 2; ++k) dst[n][k] = *(const PG8_LAS bf16x8*)(lds + PG8_SB(b, h) + boff + n * 2048 + k * 1024); } while (0)
#define PG8_MMA(ai, bj, At, Bt) do { __builtin_amdgcn_s_setprio(1); _Pragma("unroll") for (int m = 0; m < 4; ++m) _Pragma("unroll") for (int n = 0; n < 2; ++n) _Pragma("unroll") for (int k = 0; k < 2; ++k) \
        acc[ai][bj][m][n] = __builtin_amdgcn_mfma_f32_16x16x32_bf16(Bt[n][k], At[m][k], acc[ai][bj][m][n], 0, 0, 0); __builtin_amdgcn_s_setprio(0); } while (0)
#define PG8_WAIT_V(n) asm volatile("s_waitcnt vmcnt(" #n ")" ::: "memory")
#define PG8_WAIT_L(n) asm volatile("s_waitcnt lgkmcnt(" #n ")" ::: "memory")
#define PG8_BAR __builtin_amdgcn_s_barrier()
#define PG8_SCHED __builtin_amdgcn_sched_barrier(0)
    Unit cur, nxt; int ui = 0;
    if (!S.next(0, cur)) return;
    f32x4 acc[2][2][4][2];
#pragma unroll
    for (int a = 0; a < 2; ++a)
#pragma unroll
        for (int b = 0; b < 2; ++b)
#pragma unroll
            for (int m = 0; m < 4; ++m)
#pragma unroll
                for (int n = 0; n < 2; ++n) { const float z_ = ozero(); acc[a][b][m][n] = (f32x4){z_, z_, z_, z_}; }
    bf16x8 At[4][2], B0[2][2], B1[2][2];
    const char* cA = (const char*)g.A + (size_t)cur.pm * tstep; const char* cB = (const char*)g.Bt + (size_t)cur.pn * tstep;
    S.a_ready(cur);
    PG8_STAGE(PG8_SB(0, 0), cB, voffB); PG8_STAGE(PG8_SA(0, 0), cA, voffA); PG8_STAGE(PG8_SB(0, 1), cB + hstep, voffB); PG8_STAGE(PG8_SA(0, 1), cA + hstep, voffA);
    if (wr == 1) PG8_BAR;
    PG8_WAIT_V(4); PG8_BAR;
    PG8_STAGE(PG8_SB(1, 0), cB + kstep, voffB); PG8_STAGE(PG8_SA(1, 0), cA + kstep, voffA); PG8_STAGE(PG8_SB(1, 1), cB + hstep + kstep, voffB);
    PG8_WAIT_V(6); PG8_BAR;
    PG8_STAMP();
    for (;;) {
        const bool has_next = S.next(ui + 1, nxt);
        const char* nA = has_next ? (const char*)g.A + (size_t)nxt.pm * tstep : cA; const char* nB = has_next ? (const char*)g.Bt + (size_t)nxt.pn * tstep : cB;
        for (int t = 0; t < nt; t += 2) {
            const bool last = (t == nt - 2);
            const char* a1 = cA + (size_t)(t + 1) * kstep;
            const char* a2 = last ? nA : cA + (size_t)(t + 2) * kstep; const char* b2 = last ? nB : cB + (size_t)(t + 2) * kstep;
            const char* a3 = a2 + kstep; const char* b3 = b2 + kstep;
            if (last && has_next) S.a_ready(nxt);
            PG8_LDB(B0, 0, 0); PG8_SCHED; PG8_LDA(At, 0, 0); PG8_STAGE(PG8_SA(1, 1), a1 + hstep, voffA);
            PG8_WAIT_L(8); PG8_BAR; PG8_WAIT_L(0); PG8_MMA(0, 0, At, B0); PG8_BAR; PG8_SCHED;
            PG8_LDB(B1, 0, 1); PG8_STAGE(PG8_SB(0, 0), b2, voffB);
            PG8_BAR; PG8_WAIT_L(0); PG8_MMA(0, 1, At, B1); PG8_BAR;
            PG8_LDA(At, 0, 1); PG8_STAGE(PG8_SA(0, 0), a2, voffA);
            PG8_BAR; PG8_WAIT_L(0); PG8_MMA(1, 0, At, B0); PG8_BAR; PG8_SCHED;
            PG8_STAGE(PG8_SB(0, 1), b2 + hstep, voffB);
            PG8_WAIT_V(6); PG8_BAR; PG8_MMA(1, 1, At, B1); PG8_BAR;
            PG8_LDB(B0, 1, 0); PG8_SCHED; PG8_LDA(At, 1, 0); PG8_STAGE(PG8_SA(0, 1), a2 + hstep, voffA);
            PG8_WAIT_L(8); PG8_BAR; PG8_WAIT_L(0); PG8_MMA(0, 0, At, B0); PG8_BAR; PG8_SCHED;
            PG8_LDB(B1, 1, 1); PG8_STAGE(PG8_SB(1, 0), b3, voffB);
            PG8_BAR; PG8_WAIT_L(0); PG8_MMA(0, 1, At, B1); PG8_BAR;
            PG8_LDA(At, 1, 1); PG8_STAGE(PG8_SA(1, 0), a3, voffA);
            PG8_BAR; PG8_WAIT_L(0); PG8_MMA(1, 0, At, B0); PG8_BAR; PG8_SCHED;
            PG8_STAGE(PG8_SB(1, 1), b3 + hstep, voffB);
            PG8_WAIT_V(6); PG8_BAR; PG8_MMA(1, 1, At, B1); PG8_BAR;
        }
        PG8_STAMP();
        if constexpr (!Epi::AFTER_DRAIN) { E(acc, cur, wr, wc, fr, fq); S.done(cur); }
        PG8_STAMP();
        if (!has_next) break;
#pragma unroll
        for (int a = 0; a < 2; ++a)
#pragma unroll
            for (int b = 0; b < 2; ++b)
#pragma unroll
                for (int m = 0; m < 4; ++m)
#pragma unroll
                    for (int n = 0; n < 2; ++n) { const float z_ = ozero(); acc[a][b][m][n] = (f32x4){z_, z_, z_, z_}; }
        cur = nxt; cA = nA; cB = nB; ++ui;
    }
    PG8_WAIT_V(0);
    if (wr == 0) PG8_BAR;
    PG8_BAR;
    if constexpr (Epi::AFTER_DRAIN) { E.fused(acc, cur, wr, wc, fr, fq, lds, wid, lane); S.done(cur); }
    PG8_STAMP();
    if (STAMP && wid == 0) { stamps[lane] = lane < nts ? (((unsigned long long)(unsigned)ts_hi << 32) | (unsigned)ts_lo) : 0ull;
        if (lane == 62) stamps[62] = rt_entry; if (lane == 63) stamps[63] = (unsigned long long)wall_clock64(); }
#undef PG8_STAMP
#undef PG8_SA
#undef PG8_SB
#undef PG8_STAGE
#undef PG8_LDA
#undef PG8_LDB
#undef PG8_MMA
#undef PG8_WAIT_V
#undef PG8_WAIT_L
#undef PG8_BAR
#undef PG8_SCHED
}

struct EpiF32 {
    static constexpr bool PERM = false, AFTER_DRAIN = false;
    float* C; int ldc;
    __device__ __forceinline__ void operator()(const f32x4 (&acc)[2][2][4][2], const Unit& u, int wr, int wc, int fr, int fq) const {
        const int row0 = u.pm * BM + wr * 64 + fr, col0 = u.pn * BM + wc * 32 + 4 * fq;
#pragma unroll
        for (int ai = 0; ai < 2; ++ai)
#pragma unroll
            for (int m = 0; m < 4; ++m) { float* rowp = C + (size_t)(row0 + ai * HALF + m * 16) * ldc + col0;
#pragma unroll
                for (int bj = 0; bj < 2; ++bj)
#pragma unroll
                    for (int n = 0; n < 2; ++n) *(f32x4*)(rowp + bj * HALF + n * 16) = acc[ai][bj][m][n]; }
    }
};
struct EpiBf {
    static constexpr bool PERM = true, AFTER_DRAIN = false;
    bf16_t* O; int ldc;
    __device__ __forceinline__ void operator()(const f32x4 (&acc)[2][2][4][2], const Unit& u, int wr, int wc, int fr, int fq) const {
        const int row0 = u.pm * BM + wr * 64 + fr, col0 = u.pn * BM + wc * 32 + 8 * fq;
#pragma unroll
        for (int ai = 0; ai < 2; ++ai)
#pragma unroll
            for (int m = 0; m < 4; ++m) { bf16_t* rowp = O + (size_t)(row0 + ai * HALF + m * 16) * ldc + col0;
#pragma unroll
                for (int bj = 0; bj < 2; ++bj) { const f32x4 v0 = acc[ai][bj][m][0], v1 = acc[ai][bj][m][1];
                    u32x4 w; w.x = cvt_pk_bf16(v0[0], v0[1]); w.y = cvt_pk_bf16(v0[2], v0[3]); w.z = cvt_pk_bf16(v1[0], v1[1]); w.w = cvt_pk_bf16(v1[2], v1[3]);
                    *(u32x4*)(rowp + bj * HALF) = w; } }
    }
};
struct EpiRelu2 {
    static constexpr bool PERM = true, AFTER_DRAIN = false;
    bf16_t* O; int ldc;
    __device__ __forceinline__ void operator()(const f32x4 (&acc)[2][2][4][2], const Unit& u, int wr, int wc, int fr, int fq) const {
        const int row0 = u.pm * BM + wr * 64 + fr, col0 = u.pn * BM + wc * 32 + 8 * fq;
#pragma unroll
        for (int ai = 0; ai < 2; ++ai)
#pragma unroll
            for (int m = 0; m < 4; ++m) { bf16_t* rowp = O + (size_t)(row0 + ai * HALF + m * 16) * ldc + col0;
#pragma unroll
                for (int bj = 0; bj < 2; ++bj) { f32x4 v0 = acc[ai][bj][m][0], v1 = acc[ai][bj][m][1];
#pragma unroll
                    for (int j = 0; j < 4; ++j) { float a = fmaxf(v0[j], 0.f), b = fmaxf(v1[j], 0.f); v0[j] = a * a; v1[j] = b * b; }
                    u32x4 w; w.x = cvt_pk_bf16(v0[0], v0[1]); w.y = cvt_pk_bf16(v0[2], v0[3]); w.z = cvt_pk_bf16(v1[0], v1[1]); w.w = cvt_pk_bf16(v1[2], v1[3]);
                    *(u32x4*)(rowp + bj * HALF) = w; } }
    }
};
struct EpiU {
    static constexpr bool PERM = true, AFTER_DRAIN = false;
    bf16_t* O; float* out; int l;
    __device__ __forceinline__ void operator()(const f32x4 (&acc)[2][2][4][2], const Unit& u, int wr, int wc, int fr, int fq) const {
        const int row0 = u.pm * BM + wr * 64 + fr, col0 = u.pn * BM + wc * 32 + 8 * fq;
#pragma unroll
        for (int ai = 0; ai < 2; ++ai)
#pragma unroll
            for (int m = 0; m < 4; ++m) { const int row = row0 + ai * HALF + m * 16;
#pragma unroll
                for (int bj = 0; bj < 2; ++bj) { const int col = col0 + bj * HALF; const f32x4 v0 = acc[ai][bj][m][0], v1 = acc[ai][bj][m][1];
                    if (col < 3456) {
                        u32x4 w; w.x = cvt_pk_bf16(v0[0], v0[1]); w.y = cvt_pk_bf16(v0[2], v0[3]); w.z = cvt_pk_bf16(v1[0], v1[1]); w.w = cvt_pk_bf16(v1[2], v1[3]);
                        *(u32x4*)(O + (size_t)row * 3456 + col) = w;
                        if (row < 4096 && col >= 1664 && col < 2688) {
                            const int b = row >> 8, t = row & 255;
                            float* dst = (col < 2176) ? out + 14680064 + ((size_t)((b * 4 + l) * 256 + t)) * 512 + (col - 1664)
                                                      : out + 23068672 + ((size_t)((b * 4 + l) * 256 + t)) * 512 + (col - 2176);
                            __builtin_nontemporal_store(v0, (f32x4*)dst); __builtin_nontemporal_store(v1, (f32x4*)(dst + 4));
                        }
                    } } }
    }
};
}

DI void rwkv_prep_item(const Params& p, int l, int tile, float* lds) {
  const int tid = otid(), lane = tid & 63, wid = tid >> 6, fr = lane & 15, fq = lane >> 4;
  const int rowb = tile * 32; int s, t0, L, row0; seq_of(rowb, s, t0, L, row0);
  const u16* U = (const u16*)(p.ws + WS_U);
  u16* X = (u16*)lds;
  for (int ch = tid; ch < 32 * 48; ch += 512) {
    const int tok = ch / 48, c8 = (ch % 48) * 8;
    const uint4 raw = ldnt_u4(U + (size_t)(rowb + tok) * NU + 768 + c8);
    const unsigned w[4] = {raw.x, raw.y, raw.z, raw.w}; float f[8];
#pragma unroll
    for (int j = 0; j < 8; ++j) { float v = bf2f((u16)(w[j >> 1] >> ((j & 1) * 16))); f[j] = c8 < 128 ? (2.f * fsig(2.f * v) - 1.f) : (c8 < 256 ? v : fsig(v)); }
    *(uint4*)(X + tok * 392 + c8) = make_uint4(pack2(f[0], f[1]), pack2(f[2], f[3]), pack2(f[4], f[5]), pack2(f[6], f[7]));
  }
  u16* UT = X + 32 * 392;
  for (int ch = tid; ch < 34 * 96; ch += 512) {
    const int rr = ch / 96, c8 = (ch % 96) * 8; const int t = t0 - 1 + rr;
    uint4 raw = make_uint4(0u, 0u, 0u, 0u);
    if (t >= 0 && t < L) raw = ldnt_u4(U + (size_t)(rowb - 1 + rr) * NU + c8);
    *(uint4*)(UT + rr * 776 + c8) = raw;
  }
  __syncthreads();
  const int h = wid & 3, tg = wid >> 2;
  const u16* WT = (const u16*)(p.ws + WS_WTL) + ((size_t)l * 256 + h * 64 + 4 * fr) * 384 + fq * 8;
  const u16* xa = X + (tg * 16 + fr) * 392 + fq * 8;
  f32x4 awf[4], awb[4], aaf[4], aab[4], ag[4];
#pragma unroll
  for (int n = 0; n < 4; ++n) { const float z_ = ozero(); awf[n] = f32x4{z_, z_, z_, z_}; awb[n] = awf[n]; aaf[n] = awf[n]; aab[n] = awf[n]; ag[n] = awf[n]; }
#pragma unroll
  for (int ks = 0; ks < 2; ++ks) {
    const bf16x8 x0 = *(const bf16x8*)(xa + ks * 32), x1 = *(const bf16x8*)(xa + 64 + ks * 32), x2 = *(const bf16x8*)(xa + 128 + ks * 32), x3 = *(const bf16x8*)(xa + 192 + ks * 32);
#pragma unroll
    for (int n = 0; n < 4; ++n) {
      const u16* wp = WT + (size_t)n * 384 + ks * 32;
      awf[n] = __builtin_amdgcn_mfma_f32_16x16x32_bf16(x0, *(const bf16x8*)(wp), awf[n], 0, 0, 0);
      awb[n] = __builtin_amdgcn_mfma_f32_16x16x32_bf16(x1, *(const bf16x8*)(wp + 64), awb[n], 0, 0, 0);
      aaf[n] = __builtin_amdgcn_mfma_f32_16x16x32_bf16(x2, *(const bf16x8*)(wp + 128), aaf[n], 0, 0, 0);
      aab[n] = __builtin_amdgcn_mfma_f32_16x16x32_bf16(x3, *(const bf16x8*)(wp + 192), aab[n], 0, 0, 0);
    }
  }
#pragma unroll
  for (int ks = 0; ks < 4; ++ks) {
    const bf16x8 x4 = *(const bf16x8*)(xa + 256 + ks * 32);
#pragma unroll
    for (int n = 0; n < 4; ++n) ag[n] = __builtin_amdgcn_mfma_f32_16x16x32_bf16(x4, *(const bf16x8*)(WT + (size_t)n * 384 + 256 + ks * 32), ag[n], 0, 0, 0);
  }
  const float* cw = p.in[14] + (size_t)l * 3 * 768;
  float cr[4][3], ck[4][3], cv[4][3], kkw[4], ka[4], rk[4], w0f[4], w0b[4], a0f[4], a0b[4];
  {
    const int c0 = h * 64 + 4 * fr;
#define LD4(dst, ptr) { const float4 t_ = *(const float4*)(ptr); dst[0] = t_.x; dst[1] = t_.y; dst[2] = t_.z; dst[3] = t_.w; }
#pragma unroll
    for (int q = 0; q < 3; ++q) {
      const float4 a_ = *(const float4*)(cw + q * 768 + c0), b_ = *(const float4*)(cw + q * 768 + 256 + c0), c_ = *(const float4*)(cw + q * 768 + 512 + c0);
      cr[0][q] = a_.x; cr[1][q] = a_.y; cr[2][q] = a_.z; cr[3][q] = a_.w; ck[0][q] = b_.x; ck[1][q] = b_.y; ck[2][q] = b_.z; ck[3][q] = b_.w;
      cv[0][q] = c_.x; cv[1][q] = c_.y; cv[2][q] = c_.z; cv[3][q] = c_.w;
    }
    LD4(kkw, p.in[20] + l * 256 + c0); LD4(ka, p.in[21] + l * 256 + c0); LD4(rk, p.in[22] + l * 256 + c0);
    LD4(w0f, p.in[15] + (l * 2 + 0) * 256 + c0); LD4(w0b, p.in[15] + (l * 2 + 1) * 256 + c0);
    LD4(a0f, p.in[17] + (l * 2 + 0) * 256 + c0); LD4(a0b, p.in[17] + (l * 2 + 1) * 256 + c0);
#undef LD4
  }
  float* RW = (float*)(p.ws + WS_RW); float* G = (float*)(p.ws + WS_G); float* BC = (float*)(p.ws + WS_BC);
#pragma unroll
  for (int j = 0; j < 4; ++j) {
    const int tok = tg * 16 + fq * 4 + j, row = rowb + tok, t = t0 + tok;
    float r_[4], k_[4], v_[4], kkr[4]; float ss = 0.f;
#pragma unroll
    for (int n = 0; n < 4; ++n) {
      const u16* ur = UT + (tok + 1) * 776 + h * 64 + 4 * fr + n;
      const float r0 = bf2f(ur[0]), k0 = bf2f(ur[256]), v0 = bf2f(ur[512]);
      const float rm = bf2f(ur[-776]), km = bf2f(ur[256 - 776]), vm = bf2f(ur[512 - 776]);
      const float rp = bf2f(ur[776]), kp = bf2f(ur[256 + 776]), vp = bf2f(ur[512 + 776]);
      r_[n] = cr[n][0] * rm + cr[n][1] * r0 + cr[n][2] * rp;
      k_[n] = ck[n][0] * km + ck[n][1] * k0 + ck[n][2] * kp;
      v_[n] = cv[n][0] * vm + cv[n][1] * v0 + cv[n][2] * vp;
      kkr[n] = k_[n] * kkw[n]; ss += kkr[n] * kkr[n];
    }
    ss = allreduce16(ss); const float rn = rsqrtf(ss + 1e-12f);
    float bonus = 0.f, brf = 0.f, krf = 0.f, brb = 0.f, krb = 0.f;
    float* dst0 = RW + ((size_t)(row * 4 + h) * 9) * 64 + 4 * fr;
    float okk[4], odf[4], obf[4], okf[4], odb[4], obb[4], okb[4];
#pragma unroll
    for (int n = 0; n < 4; ++n) {
      const float kk = kkr[n] * rn;
      const float decf = fexp(-0.60653066f * fsig(w0f[n] + awf[n][j])), decb = fexp(-0.60653066f * fsig(w0b[n] + awb[n][j]));
      const float af_ = fsig(a0f[n] + aaf[n][j]), ab_ = fsig(a0b[n] + aab[n][j]);
      const float kdf = k_[n] * (1.f + (af_ - 1.f) * ka[n]), kdb = k_[n] * (1.f + (ab_ - 1.f) * ka[n]);
      const float bf_ = kk * af_, bb_ = kk * ab_;
      bonus += r_[n] * (kdf + kdb) * rk[n]; brf += bf_ * r_[n]; krf += kdf * r_[n]; brb += bb_ * r_[n]; krb += kdb * r_[n];
      okk[n] = kk; odf[n] = decf; obf[n] = bf_; okf[n] = kdf; odb[n] = decb; obb[n] = bb_; okb[n] = kdb;
    }
    *(float4*)(dst0) = make_float4(r_[0], r_[1], r_[2], r_[3]);
    *(float4*)(dst0 + 64) = make_float4(okk[0], okk[1], okk[2], okk[3]);
    *(float4*)(dst0 + 128) = make_float4(v_[0], v_[1], v_[2], v_[3]);
    *(float4*)(dst0 + 192) = make_float4(odf[0], odf[1], odf[2], odf[3]);
    *(float4*)(dst0 + 256) = make_float4(obf[0], obf[1], obf[2], obf[3]);
    *(float4*)(dst0 + 320) = make_float4(okf[0], okf[1], okf[2], okf[3]);
    *(float4*)(dst0 + 384) = make_float4(odb[0], odb[1], odb[2], odb[3]);
    *(float4*)(dst0 + 448) = make_float4(obb[0], obb[1], obb[2], obb[3]);
    *(float4*)(dst0 + 512) = make_float4(okb[0], okb[1], okb[2], okb[3]);
    *(float4*)(G + (size_t)row * 256 + h * 64 + 4 * fr) = make_float4(ag[0][j], ag[1][j], ag[2][j], ag[3][j]);
    bonus = allreduce16(bonus); brf = allreduce16(brf); krf = allreduce16(krf); brb = allreduce16(brb); krb = allreduce16(krb);
    if (fr == 0) { float* bc = BC + (size_t)(row * 4 + h) * 8; *(float4*)bc = make_float4(brf, krf, brb, krb); bc[4] = bonus; }
  }
  __syncthreads();
}

DI void attn_prep_item(const Params& p, int l, int tile, float* lds) {
  const int tid = otid();
  const int rowb = tile * 32; int s, t0, L, row0; seq_of(rowb, s, t0, L, row0);
  const bool lat = s >= 16;
  const u16* U = (const u16*)(p.ws + WS_U);
  u16* Q = (u16*)(p.ws + WS_Q);
  u16* Kd = lat ? (u16*)(p.ws + WS_KL) + ((size_t)(s - 16) * 2304 + 256) * 512 : (u16*)(p.ws + WS_KC) + (size_t)s * 256 * 512;
  u16* Vd = lat ? (u16*)(p.ws + WS_VL) + (size_t)(s - 16) * 2304 * 512 + 256 : (u16*)(p.ws + WS_VC) + (size_t)s * 256 * 512;
  for (int uidx = tid; uidx < 2048; uidx += 512) {
    const int g = uidx & 1, pb = (uidx >> 1) & 1, hm = (uidx >> 2) & 7, which = (uidx >> 5) & 1, tok = uidx >> 6;
    const int row = rowb + tok, t = t0 + tok;
    const u16* src = U + (size_t)row * NU + (which ? 1664 : 1152) + hm * 64 + pb * 32 + g * 8;
    const uint4 va = ldnt_u4(src); const uint4 vb = ldnt_u4(src + 16);
    const unsigned wa[4] = {va.x, va.y, va.z, va.w}, wb[4] = {vb.x, vb.y, vb.z, vb.w};
    float oa[8], ob[8];
#pragma unroll
    for (int j = 0; j < 8; ++j) {
      float xa = bf2f((u16)(wa[j >> 1] >> ((j & 1) * 16))), xb = bf2f((u16)(wb[j >> 1] >> ((j & 1) * 16)));
      if (lat) {
        const int pidx = pb == 0 ? (t >> 6) : (t & 63); const int i = g * 8 + j;
        const float2 csn = ((const float2*)(p.ws + WS_ROPE))[pidx * 16 + i];
        oa[j] = xa * csn.x - xb * csn.y; ob[j] = xb * csn.x + xa * csn.y;
      } else { oa[j] = xa; ob[j] = xb; }
    }
    u16* dst = (which == 0) ? Q + (size_t)row * 512 + hm * 64 + pb * 32 + g * 8 : Kd + (size_t)t * 512 + hm * 64 + pb * 32 + g * 8;
    *(uint4*)dst = make_uint4(pack2(oa[0], oa[1]), pack2(oa[2], oa[3]), pack2(oa[4], oa[5]), pack2(oa[6], oa[7]));
    *(uint4*)(dst + 16) = make_uint4(pack2(ob[0], ob[1]), pack2(ob[2], ob[3]), pack2(ob[4], ob[5]), pack2(ob[6], ob[7]));
  }
  u16* vl = (u16*)lds;
  for (int uidx = tid; uidx < 2048; uidx += 512) {
    const int tok = uidx >> 6, ch = uidx & 63;
    *(uint4*)(vl + tok * 520 + ch * 8) = ldnt_u4(U + (size_t)(rowb + tok) * NU + 2176 + ch * 8);
  }
  __syncthreads();
  {
    const int col = tid, hv = col >> 7, e = col & 127; const int Lk = lat ? 2304 : 256;
    u16* dst = Vd + (size_t)(hv * 128 + e) * Lk + t0;
#pragma unroll
    for (int q = 0; q < 4; ++q) {
      unsigned w[4];
#pragma unroll
      for (int j = 0; j < 4; ++j) w[j] = (unsigned)vl[(q * 8 + 2 * j) * 520 + col] | ((unsigned)vl[(q * 8 + 2 * j + 1) * 520 + col] << 16);
      *(uint4*)(dst + q * 8) = make_uint4(w[0], w[1], w[2], w[3]);
    }
  }
  __syncthreads();
}

DI void cache_item(const Params& p, int l, int it, float* lds) {
  const int b = it >> 3, pc = it & 7; const int tid = otid();
  u16* KL = (u16*)(p.ws + WS_KL); u16* VL = (u16*)(p.ws + WS_VL);
  u16* vl = (u16*)lds;
  for (int idx = tid; idx < 32 * 128; idx += 512) {
    const int r = idx >> 7, c4 = idx & 127, prow = pc * 32 + r;
    const size_t so = ((size_t)(b * 4 + l) * 256 + prow) * 512 + c4 * 4; const size_t d_o = ((size_t)b * 2304 + prow) * 512 + c4 * 4;
    float4 kv = *(const float4*)(p.in[3] + so); float4 vv = *(const float4*)(p.in[4] + so);
    *(uint2*)(KL + d_o) = make_uint2(pack2(kv.x, kv.y), pack2(kv.z, kv.w));
    *(uint2*)(vl + r * 520 + c4 * 4) = make_uint2(pack2(vv.x, vv.y), pack2(vv.z, vv.w));
  }
  __syncthreads();
  {
    const int col = tid, hv = col >> 7, e = col & 127;
    u16* dst = VL + (size_t)b * 2304 * 512 + (size_t)(hv * 128 + e) * 2304 + pc * 32;
#pragma unroll
    for (int q = 0; q < 4; ++q) {
      unsigned w[4];
#pragma unroll
      for (int j = 0; j < 4; ++j) w[j] = (unsigned)vl[(q * 8 + 2 * j) * 520 + col] | ((unsigned)vl[(q * 8 + 2 * j + 1) * 520 + col] << 16);
      *(uint4*)(dst + q * 8) = make_uint4(w[0], w[1], w[2], w[3]);
    }
  }
  __syncthreads();
}

DI void hy_prep_item(const Params& p, int l, int tile, float* lds) {
  const int tid = otid();
  const int rowb = tile * 64; int s, t0, L, row0; seq_of(rowb, s, t0, L, row0);
  const u16* U = (const u16*)(p.ws + WS_U); float* HYT = (float*)(p.ws + WS_HYT);
  u16* UT = (u16*)lds;
  for (int ch = tid; ch < 66 * 96; ch += 512) {
    const int rr = ch / 96, c8 = (ch % 96) * 8; const int t = t0 - 1 + rr;
    uint4 raw = make_uint4(0u, 0u, 0u, 0u);
    if (t >= 0 && t < L) raw = ldnt_u4(U + (size_t)(rowb - 1 + rr) * NU + 2688 + c8);
    *(uint4*)(UT + rr * 776 + c8) = raw;
  }
  __syncthreads();
  const int cc = tid >> 1, half = tid & 1;
#pragma unroll
  for (int which = 0; which < 3; ++which) {
    const int col = which * 256 + cc;
    const float w0 = p.in[30][(size_t)l * 3 * 768 + col], w1 = p.in[30][(size_t)l * 3 * 768 + 768 + col], w2 = p.in[30][(size_t)l * 3 * 768 + 1536 + col];
    const float bias = p.in[31][l * 768 + col];
    const u16* up = UT + (half * 32) * 776 + col;
    float um = bf2f(up[0]), u0 = bf2f(up[776]);
    float* dst = HYT + (size_t)col * TT + rowb + half * 32;
#pragma unroll
    for (int i = 0; i < 32; i += 4) {
      float o[4];
#pragma unroll
      for (int q = 0; q < 4; ++q) { const float un = bf2f(up[(i + q + 2) * 776]); o[q] = w0 * um + w1 * u0 + w2 * un + bias; um = u0; u0 = un; }
      *(float4*)(dst + i) = make_float4(o[0], o[1], o[2], o[3]);
    }
  }
  __syncthreads();
}

DI void scan_item(const Params& p, int l, int s, int h, int d, int rg, int nact, float* lds) {
  int L, row0; if (s < 16) { L = 256; row0 = s * 256; } else { L = 2048; row0 = 4096 + (s - 16) * 2048; }
  const float* RW = (const float*)(p.ws + WS_RW); float* YS = (float*)(p.ws + WS_YS) + (size_t)d * TT * 256;
  const float* BC = (const float*)(p.ws + WS_BC);
  const int tid = otid(), lane = tid & 63, wid = tid >> 6, lane16 = lane & 15, rsub = lane >> 4;
  const int row = rg * (nact * 4) + (wid & (nact - 1)) * 4 + rsub;
  float4 st = make_float4(0.f, 0.f, 0.f, 0.f);
  if (s >= 16 && wid < nact) st = *(const float4*)(p.in[2] + ((((size_t)(s - 16) * 4 + l) * 2 + d) * 4 + h) * 4096 + row * 64 + lane16 * 4);
  const int nch = L / 32;
  float4 pre0, pre1, pre2, pre3, pre4, pre5; float2 presc = make_float2(0.f, 0.f);
  auto ldpre = [&](int ch, int j) -> float4 {
    int f = tid + j * 512; int step = f / 96, within = f % 96; int slot6 = within >> 4, q = within & 15;
    int srcslot = slot6 < 3 ? slot6 : 3 + 3 * d + (slot6 - 3); int i = ch * 32 + step; int t = d ? L - 1 - i : i;
    return *(const float4*)(RW + ((size_t)((row0 + t) * 4 + h) * 9 + srcslot) * 64 + q * 4); };
#define PREFETCH(ch) { pre0 = ldpre(ch, 0); pre1 = ldpre(ch, 1); pre2 = ldpre(ch, 2); pre3 = ldpre(ch, 3); pre4 = ldpre(ch, 4); pre5 = ldpre(ch, 5); \
    if (tid < 32) { int i = (ch) * 32 + tid; int t = d ? L - 1 - i : i; presc = *(const float2*)(BC + (size_t)((row0 + t) * 4 + h) * 8 + 2 * d); } }
  PREFETCH(0);
  float* scl = lds + 12288;
  for (int ch = 0; ch < nch; ++ch) {
    *(float4*)(lds + (size_t)(tid + 0 * 512) * 4) = pre0; *(float4*)(lds + (size_t)(tid + 1 * 512) * 4) = pre1;
    *(float4*)(lds + (size_t)(tid + 2 * 512) * 4) = pre2; *(float4*)(lds + (size_t)(tid + 3 * 512) * 4) = pre3;
    *(float4*)(lds + (size_t)(tid + 4 * 512) * 4) = pre4; *(float4*)(lds + (size_t)(tid + 5 * 512) * 4) = pre5;
    if (tid < 32) *(float2*)(scl + tid * 2) = presc;
    __syncthreads();
    if (ch + 1 < nch) PREFETCH(ch + 1);
    if (wid < nact) {
      float4 r4 = *(const float4*)(lds + lane16 * 4), kk4 = *(const float4*)(lds + 64 + lane16 * 4);
      float vrow = lds[128 + row];
      float4 w4 = *(const float4*)(lds + 192 + lane16 * 4), b4 = *(const float4*)(lds + 256 + lane16 * 4), kd4 = *(const float4*)(lds + 320 + lane16 * 4);
      float2 sc = *(const float2*)scl;
      float ykeep = 0.f;
#pragma unroll 16
      for (int step = 0; step < 32; ++step) {
        const int sn = (step + 1) & 31;
        const float* bn = lds + sn * 384;
        const float4 nr4 = *(const float4*)(bn + lane16 * 4), nkk4 = *(const float4*)(bn + 64 + lane16 * 4);
        const float nvrow = bn[128 + row];
        const float4 nw4 = *(const float4*)(bn + 192 + lane16 * 4), nb4 = *(const float4*)(bn + 256 + lane16 * 4), nkd4 = *(const float4*)(bn + 320 + lane16 * 4);
        const float2 nsc = *(const float2*)(scl + sn * 2);
        __builtin_amdgcn_sched_barrier(0);
        float psa = st.x * kk4.x + st.y * kk4.y + st.z * kk4.z + st.w * kk4.w;
        float py = st.x * (w4.x * r4.x) + st.y * (w4.y * r4.y) + st.z * (w4.z * r4.z) + st.w * (w4.w * r4.w);
        psa += dppf<0xB1>(psa); py += dppf<0xB1>(py);
        psa += dppf<0x4E>(psa); py += dppf<0x4E>(py);
        psa += dppf<0x124>(psa); py += dppf<0x124>(py);
        psa += dppf<0x128>(psa); py += dppf<0x128>(py);
        const float sa = -psa;
        const float y = py + sa * sc.x + vrow * sc.y;
        st.x = st.x * w4.x + (sa * b4.x + vrow * kd4.x);
        st.y = st.y * w4.y + (sa * b4.y + vrow * kd4.y);
        st.z = st.z * w4.z + (sa * b4.z + vrow * kd4.z);
        st.w = st.w * w4.w + (sa * b4.w + vrow * kd4.w);
        ykeep = (lane16 == (step & 15)) ? y : ykeep;
        if ((step & 15) == 15) { const int i = ch * 32 + (step - 15) + lane16; const int t = d ? L - 1 - i : i; YS[(size_t)(row0 + t) * 256 + h * 64 + row] = ykeep; }
        r4 = nr4; kk4 = nkk4; vrow = nvrow; w4 = nw4; b4 = nb4; kd4 = nkd4; sc = nsc;
        __builtin_amdgcn_sched_barrier(0);
      }
    }
    __syncthreads();
  }
#undef PREFETCH
  if (s < 16 && wid < nact) *(float4*)(p.out + OUT_STATE + ((((size_t)s * 4 + l) * 2 + d) * 4 + h) * 4096 + row * 64 + lane16 * 4) = st;
}

DI void attn_item(const Params& p, int l, int s, int h, int qt, unsigned char* smem, float lam, float lam_init) {
  u16* Ks0 = (u16*)smem; float* Ex = (float*)smem;
  const bool lat = s >= 16; const int Lk = lat ? 2304 : 256;
  const u16* Kg = lat ? (const u16*)(p.ws + WS_KL) + (size_t)(s - 16) * 2304 * 512 : (const u16*)(p.ws + WS_KC) + (size_t)s * 256 * 512;
  const u16* Vg = (lat ? (const u16*)(p.ws + WS_VL) + (size_t)(s - 16) * 2304 * 512 : (const u16*)(p.ws + WS_VC) + (size_t)s * 256 * 512) + (size_t)h * 128 * Lk;
  const int row0 = lat ? 4096 + (s - 16) * 2048 : s * 256; const int qrow0 = row0 + qt * 128;
  const u16* Q = (const u16*)(p.ws + WS_Q);
  const int tid = otid(), lane = tid & 63, wid = tid >> 6, m = wid & 1, qs = wid >> 1, r = lane & 31, hh = lane >> 5;
  bf16x8 qf[4];
#pragma unroll
  for (int ks = 0; ks < 4; ++ks) qf[ks] = __builtin_nontemporal_load((const bf16x8*)(Q + (size_t)(qrow0 + qs * 32 + r) * 512 + h * 128 + m * 64 + ks * 16 + hh * 8));
  f32x16 o[4];
#pragma unroll
  for (int et = 0; et < 4; ++et)
#pragma unroll
    for (int i = 0; i < 16; ++i) o[et][i] = ozero();
  float mrun = -1e30f, lsum = 0.f, lsum2 = 0.f; const float cs = 0.125f * 1.4426950408889634f;
  uint4 kr0, kr1, vr0, vr1;
  const int kkey = tid >> 4, kch = tid & 15, ve = tid >> 3, vkc = tid & 7;
#define ALOAD(kt0) { kr0 = *(const uint4*)(Kg + (size_t)((kt0) + kkey) * 512 + h * 128 + kch * 8); kr1 = *(const uint4*)(Kg + (size_t)((kt0) + kkey + 32) * 512 + h * 128 + kch * 8); \
                     vr0 = *(const uint4*)(Vg + (size_t)ve * Lk + (kt0) + vkc * 8); vr1 = *(const uint4*)(Vg + (size_t)(ve + 64) * Lk + (kt0) + vkc * 8); }
#define ASTORE(b) { u16* ks_ = Ks0 + (b) * 17920; u16* vs_ = ks_ + 64 * 136; \
    *(uint4*)(ks_ + kkey * 136 + kch * 8) = kr0; *(uint4*)(ks_ + (kkey + 32) * 136 + kch * 8) = kr1; \
    *(uint2*)(vs_ + ve * 68 + vkc * 8) = make_uint2(vr0.x, vr0.y); *(uint2*)(vs_ + ve * 68 + vkc * 8 + 4) = make_uint2(vr0.z, vr0.w); \
    *(uint2*)(vs_ + (ve + 64) * 68 + vkc * 8) = make_uint2(vr1.x, vr1.y); *(uint2*)(vs_ + (ve + 64) * 68 + vkc * 8 + 4) = make_uint2(vr1.z, vr1.w); }
  ALOAD(0);
  __syncthreads();
  ASTORE(0);
  if (64 < Lk) ALOAD(64);
  __syncthreads();
  for (int kt0 = 0; kt0 < Lk; kt0 += 64) {
    const int cb = (kt0 >> 6) & 1;
    const u16* Ks = Ks0 + cb * 17920; const u16* Vs = Ks + 64 * 136;
    f32x16 st[2];
#pragma unroll
    for (int kt = 0; kt < 2; ++kt) {
#pragma unroll
      for (int i = 0; i < 16; ++i) st[kt][i] = 0.f;
#pragma unroll
      for (int ks = 0; ks < 4; ++ks) { const bf16x8 kf = *(const bf16x8*)(Ks + (kt * 32 + r) * 136 + m * 64 + ks * 16 + hh * 8);
        st[kt] = __builtin_amdgcn_mfma_f32_32x32x16_bf16(kf, qf[ks], st[kt], 0, 0, 0); }
    }
    float mx = st[0][0];
#pragma unroll
    for (int i = 0; i < 16; ++i) { mx = fmaxf(mx, st[0][i]); mx = fmaxf(mx, st[1][i]); }
    mx = fmaxf(mx, shfl32(mx, lane));
    const float mnew = fmaxf(mrun, mx);
    if (__builtin_amdgcn_ballot_w64((mnew - mrun) * cs > 4.f) != 0ull) {
      const float alpha = __builtin_amdgcn_exp2f((mrun - mnew) * cs); mrun = mnew;
      lsum *= alpha; lsum2 *= alpha;
#pragma unroll
      for (int et = 0; et < 4; ++et)
#pragma unroll
        for (int i = 0; i < 16; ++i) o[et][i] *= alpha;
    }
    const float nb = -mrun * cs;
#pragma unroll
    for (int kt = 0; kt < 2; ++kt)
#pragma unroll
      for (int i = 0; i < 16; i += 2) {
        const float p0 = __builtin_amdgcn_exp2f(__builtin_fmaf(st[kt][i], cs, nb)), p1 = __builtin_amdgcn_exp2f(__builtin_fmaf(st[kt][i + 1], cs, nb));
        lsum += p0; lsum2 += p1; st[kt][i] = p0; st[kt][i + 1] = p1; }
#pragma unroll
    for (int kt = 0; kt < 2; ++kt)
#pragma unroll
      for (int ss = 0; ss < 2; ++ss) {
        unsigned pw0, pw1, pw2, pw3;
        asm volatile("v_cvt_pk_bf16_f32 %0, %4, %5\n\tv_cvt_pk_bf16_f32 %1, %6, %7\n\tv_cvt_pk_bf16_f32 %2, %8, %9\n\tv_cvt_pk_bf16_f32 %3, %10, %11\n\ts_nop 1"
                     : "=&v"(pw0), "=&v"(pw1), "=&v"(pw2), "=&v"(pw3)
                     : "v"(st[kt][8 * ss + 0]), "v"(st[kt][8 * ss + 1]), "v"(st[kt][8 * ss + 2]), "v"(st[kt][8 * ss + 3]),
                       "v"(st[kt][8 * ss + 4]), "v"(st[kt][8 * ss + 5]), "v"(st[kt][8 * ss + 6]), "v"(st[kt][8 * ss + 7]));
        const bf16x8 pf = __builtin_bit_cast(bf16x8, make_uint4(pw0, pw1, pw2, pw3));
#pragma unroll
        for (int et = 0; et < 4; ++et) {
          const u16* vp = Vs + (et * 32 + r) * 68 + kt * 32 + 16 * ss + 4 * hh;
          const s16x4 lo = *(const s16x4*)vp, hi = *(const s16x4*)(vp + 8);
          const bf16x8 vf = __builtin_shufflevector(lo, hi, 0, 1, 2, 3, 4, 5, 6, 7);
          o[et] = __builtin_amdgcn_mfma_f32_32x32x16_bf16(vf, pf, o[et], 0, 0, 0);
        }
      }
    if (kt0 + 64 < Lk) ASTORE(cb ^ 1);
    __syncthreads();
    if (kt0 + 128 < Lk) ALOAD(kt0 + 128);
  }
#undef ALOAD
#undef ASTORE
  lsum += lsum2; lsum += shfl32(lsum, lane); const float inv = 1.f / lsum;
  float* ex = Ex + qs * (32 * 132);
  if (m == 1) {
#pragma unroll
    for (int et = 0; et < 4; ++et)
#pragma unroll
      for (int i = 0; i < 16; ++i) { int e = et * 32 + (i & 3) + 8 * (i >> 2) + 4 * hh; ex[r * 132 + e] = o[et][i] * inv; }
  }
  __syncthreads();
  if (m == 0) {
    float ssq = 0.f;
#pragma unroll
    for (int et = 0; et < 4; ++et)
#pragma unroll
      for (int i = 0; i < 16; ++i) { int e = et * 32 + (i & 3) + 8 * (i >> 2) + 4 * hh; float v = o[et][i] * inv - lam * ex[r * 132 + e]; o[et][i] = v; ssq += v * v; }
    ssq += shfl32(ssq, lane);
    const float rs = rsqrtf(ssq * (1.f / 128.f) + 1e-6f) * (1.f - lam_init);
    const float* subln = p.in[29] + l * 128;
    u16* dstrow = (u16*)(p.ws + WS_MIXCAT) + (size_t)(qrow0 + qs * 32 + r) * 1024 + 256 + h * 128;
#pragma unroll
    for (int et = 0; et < 4; ++et)
#pragma unroll
      for (int g4 = 0; g4 < 4; ++g4) {
        const int e0 = et * 32 + 8 * g4 + 4 * hh; const float4 sl = *(const float4*)(subln + e0);
        *(uint2*)(dstrow + e0) = make_uint2(pack2(o[et][4 * g4] * rs * sl.x, o[et][4 * g4 + 1] * rs * sl.y), pack2(o[et][4 * g4 + 2] * rs * sl.z, o[et][4 * g4 + 3] * rs * sl.w));
      }
  }
}

DI void hy_conv(const float* g, const float* z, int L, int t0, float& a0, float& a1, float& a2, float& a3) {
  a0 = a1 = a2 = a3 = 0.f;
  const float* gp = g + L + t0 - 4;
  const int nb = L >> 2;
#pragma unroll 4
  for (int sb = 0; sb < nb; ++sb) {
    const float4 zz = *(const float4*)(z + sb * 4);
    const float4 ga = *(const float4*)(gp - 4 * sb), gb = *(const float4*)(gp - 4 * sb + 4);
    a0 += gb.x * zz.x + ga.w * zz.y + ga.z * zz.z + ga.y * zz.w;
    a1 += gb.y * zz.x + gb.x * zz.y + ga.w * zz.z + ga.z * zz.w;
    a2 += gb.z * zz.x + gb.y * zz.y + gb.x * zz.z + ga.w * zz.w;
    a3 += gb.w * zz.x + gb.z * zz.y + gb.y * zz.z + gb.x * zz.w;
  }
}

DI void hyena_item(const Params& p, int l, int s, int c0, float* lds) {
  const bool lat = s >= 16; const int L = lat ? 2048 : 256; const int row0 = lat ? 4096 + (s - 16) * 2048 : s * 256;
  const int TPC = L >> 2; const int tid = otid(), lane = tid & 63, wid = tid >> 6;
  const int ch = tid / TPC, tl = tid % TPC, t0 = tl * 4, c = c0 + ch;
  float* G = lds; float* Z = lds + 8192; float* red = lds + 8192 + 2048;
  const float* F = (const float*)(p.ws + WS_FILT) + (lat ? 262144 : 0);
  const float* HYT = (const float*)(p.ws + WS_HYT);
  float ssq[2];
#pragma unroll
  for (int o = 0; o < 2; ++o) {
    const float* src = F + (size_t)(o * 256 + c) * (2 * L); float* dst = G + (size_t)(ch * 2 + o) * (2 * L); float sacc = 0.f;
#pragma unroll
    for (int i = 0; i < 2; ++i) { int idx = (tl + i * TPC) * 4; float4 v = *(const float4*)(src + idx); *(float4*)(dst + idx) = v; sacc += v.x * v.x + v.y * v.y + v.z * v.z + v.w * v.w; }
    ssq[o] = wave_sum(sacc);
  }
  if (lane == 0) { red[wid * 2] = ssq[0]; red[wid * 2 + 1] = ssq[1]; }
  const float4 x1 = *(const float4*)(HYT + (size_t)(0 * 256 + c) * TT + row0 + t0);
  const float4 x2 = *(const float4*)(HYT + (size_t)(1 * 256 + c) * TT + row0 + t0);
  const float4 v4 = *(const float4*)(HYT + (size_t)(2 * 256 + c) * TT + row0 + t0);
  *(float4*)(Z + ch * L + t0) = v4;
  __syncthreads();
  const int wpc = TPC >> 6, w0 = ch * wpc; float sc0 = 0.f, sc1 = 0.f;
  for (int w = 0; w < wpc; ++w) { sc0 += red[(w0 + w) * 2]; sc1 += red[(w0 + w) * 2 + 1]; }
  sc0 = rsqrtf(sc0 + 1e-6f); sc1 = rsqrtf(sc1 + 1e-6f);
  const float bias0 = p.in[39][(l * 2 + 0) * 256 + c], bias1 = p.in[39][(l * 2 + 1) * 256 + c];
  float a0, a1, a2, a3;
  hy_conv(G + (size_t)(ch * 2 + 0) * (2 * L), Z + ch * L, L, t0, a0, a1, a2, a3);
  float4 z1;
  z1.x = x1.x * (sc0 * a0 + bias0 * v4.x); z1.y = x1.y * (sc0 * a1 + bias0 * v4.y); z1.z = x1.z * (sc0 * a2 + bias0 * v4.z); z1.w = x1.w * (sc0 * a3 + bias0 * v4.w);
  __syncthreads();
  *(float4*)(Z + ch * L + t0) = z1;
  __syncthreads();
  hy_conv(G + (size_t)(ch * 2 + 1) * (2 * L), Z + ch * L, L, t0, a0, a1, a2, a3);
  float4 yo;
  yo.x = x2.x * (sc1 * a0 + bias1 * z1.x); yo.y = x2.y * (sc1 * a1 + bias1 * z1.y); yo.z = x2.z * (sc1 * a2 + bias1 * z1.z); yo.w = x2.w * (sc1 * a3 + bias1 * z1.w);
  *(float4*)((float*)(p.ws + WS_YC) + (size_t)c * TT + row0 + t0) = yo;
  __syncthreads();
}


DI float2 cmul(float2 a, float2 b) { return make_float2(a.x * b.x - a.y * b.y, a.x * b.y + a.y * b.x); }
#define BF2(a, b) { float2 t_ = a; a.x = t_.x + b.x; a.y = t_.y + b.y; b.x = t_.x - b.x; b.y = t_.y - b.y; }
#define MNI(a) { float t_ = a.x; a.x = a.y; a.y = -t_; }
DI void fft_fwd(float2 (&v)[8], int j, int TPF, int npass, float2* lds) {
  int Ns = 1;
  for (int ps = 0; ps < npass; ++ps) {
    const int k = j & (Ns - 1);
    if (ps > 0) {
      const float a2 = -2.f * (float)k / (float)(Ns * 8);
      const float2 w1 = make_float2(cospif(a2), sinpif(a2));
      float2 w = w1; v[1] = cmul(v[1], w);
      w = cmul(w, w1); v[2] = cmul(v[2], w);
      w = cmul(w, w1); v[3] = cmul(v[3], w);
      w = cmul(w, w1); v[4] = cmul(v[4], w);
      w = cmul(w, w1); v[5] = cmul(v[5], w);
      w = cmul(w, w1); v[6] = cmul(v[6], w);
      w = cmul(w, w1); v[7] = cmul(v[7], w);
    }
    BF2(v[0], v[4]); BF2(v[1], v[5]); BF2(v[2], v[6]); BF2(v[3], v[7]);
    v[5] = cmul(v[5], make_float2(0.70710678118654752f, -0.70710678118654752f)); MNI(v[6]); v[7] = cmul(v[7], make_float2(-0.70710678118654752f, -0.70710678118654752f));
    BF2(v[0], v[2]); BF2(v[1], v[3]); BF2(v[4], v[6]); BF2(v[5], v[7]);
    MNI(v[3]); MNI(v[7]);
    BF2(v[0], v[1]); BF2(v[2], v[3]); BF2(v[4], v[5]); BF2(v[6], v[7]);
    { float2 t1 = v[1], t3 = v[3]; v[1] = v[4]; v[3] = v[6]; v[4] = t1; v[6] = t3; }
    if (ps == npass - 1) break;
    __syncthreads();
    const int base = (j - k) * 8 + k;
#pragma unroll
    for (int r = 0; r < 8; ++r) { const int idx = base + r * Ns; lds[idx + (idx >> 3)] = v[r]; }
    __syncthreads();
#pragma unroll
    for (int r = 0; r < 8; ++r) { const int idx = j + r * TPF; v[r] = lds[idx + (idx >> 3)]; }
    Ns *= 8;
  }
}

DI void hspec_item(const Params& p, int lat, int item, float* ldsf) {
  const int tid = otid(), lane = tid & 63, wid = tid >> 6;
  const int TPF = lat ? 512 : 64, npass = lat ? 4 : 3, L = lat ? 2048 : 256, N = 2 * L;
  const int unit = lat ? 0 : wid; const int j = tid & (TPF - 1);
  const int c = lat ? item : item * 8 + unit;
  float2* lds = (float2*)ldsf + unit * (N + (N >> 3));
  float* red = ldsf + 9216;
  const float* F = (const float*)(p.ws + WS_FILT) + (lat ? 262144 : 0);
  const float* g0 = F + (size_t)c * N; const float* g1 = F + (size_t)(256 + c) * N;
  float2 v[8]; float s0 = 0.f, s1 = 0.f;
#pragma unroll
  for (int r = 0; r < 8; ++r) { const int n = j + r * TPF; const int gi = (n + L) & (N - 1); const float a = g0[gi], b = g1[gi]; v[r] = make_float2(a, b); s0 += a * a; s1 += b * b; }
  s0 = wave_sum(s0); s1 = wave_sum(s1);
  if (lane == 0) { red[wid * 2] = s0; red[wid * 2 + 1] = s1; }
  __syncthreads();
  if (lat) { s0 = 0.f; s1 = 0.f; for (int w = 0; w < 8; ++w) { s0 += red[w * 2]; s1 += red[w * 2 + 1]; } }
  const float sc0 = rsqrtf(s0 + 1e-6f), sc1 = rsqrtf(s1 + 1e-6f);
#pragma unroll
  for (int r = 0; r < 8; ++r) { v[r].x *= sc0; v[r].y *= sc1; }
  fft_fwd(v, j, TPF, npass, lds);
  __syncthreads();
#pragma unroll
  for (int r = 0; r < 8; ++r) { const int idx = j + r * TPF; lds[idx + (idx >> 3)] = v[r]; }
  __syncthreads();
  const float hn = 0.5f / (float)N;
  float2* HS = (float2*)(p.ws + WS_HSPEC) + (lat ? 0 : 2 * 256 * 4096);
  float2* H0 = HS + (size_t)c * N; float2* H1 = HS + (size_t)(256 + c) * N;
#pragma unroll
  for (int r = 0; r < 8; ++r) {
    const int k = j + r * TPF; const int km = (N - k) & (N - 1); const float2 wm = lds[km + (km >> 3)];
    const float2 sm = make_float2(v[r].x + wm.x, v[r].y - wm.y); const float2 df = make_float2(v[r].x - wm.x, v[r].y + wm.y);
    H0[k] = make_float2(sm.x * hn, sm.y * hn); H1[k] = make_float2(df.y * hn, -df.x * hn);
  }
  __syncthreads();
}

DI void hyena_fft_item(const Params& p, int l, int lat, int item, float* ldsf) {
  const int tid = otid(), wid = tid >> 6;
  const int TPF = lat ? 512 : 64, npass = lat ? 4 : 3, L = lat ? 2048 : 256, N = 2 * L;
  const int unit = lat ? 0 : wid; const int j = tid & (TPF - 1);
  int c, rowa, rowb;
  if (lat) { const int bp = item >> 8; c = item & 255; rowa = 4096 + (2 * bp) * 2048; rowb = rowa + 2048; }
  else { const int gidx = item * 8 + unit; const int pair = gidx >> 8; c = gidx & 255; rowa = (2 * pair) * 256; rowb = rowa + 256; }
  float2* lds = (float2*)ldsf + unit * (N + (N >> 3));
  const float2* HS = (const float2*)(p.ws + WS_HSPEC) + (lat ? 0 : 2 * 256 * 4096);
  const float* HYT = (const float*)(p.ws + WS_HYT);
  float2 v[8], z[4];
#pragma unroll
  for (int r = 0; r < 4; ++r) { const int t = j + r * TPF; z[r] = make_float2(__builtin_nontemporal_load(HYT + (size_t)(512 + c) * TT + rowa + t), __builtin_nontemporal_load(HYT + (size_t)(512 + c) * TT + rowb + t)); v[r] = z[r]; v[4 + r] = make_float2(0.f, 0.f); }
  for (int order = 0; order < 2; ++order) {
    const float2* H = HS + (size_t)(order * 256 + c) * N;
    const float* xq = HYT + (size_t)(order * 256 + c) * TT;
    float2 h[8];
#pragma unroll
    for (int r = 0; r < 8; ++r) h[r] = H[j + r * TPF];
    float xa[4], xb[4];
#pragma unroll
    for (int r = 0; r < 4; ++r) { xa[r] = __builtin_nontemporal_load(xq + rowa + j + r * TPF); xb[r] = __builtin_nontemporal_load(xq + rowb + j + r * TPF); }
    fft_fwd(v, j, TPF, npass, lds);
#pragma unroll
    for (int r = 0; r < 8; ++r) { const float2 y = cmul(v[r], h[r]); v[r] = make_float2(y.x, -y.y); }
    fft_fwd(v, j, TPF, npass, lds);
    const float bias = p.in[39][(l * 2 + order) * 256 + c];
#pragma unroll
    for (int r = 0; r < 4; ++r) {
      const float ya = v[r].x, yb = -v[r].y;
      z[r] = make_float2(xa[r] * (ya + bias * z[r].x), xb[r] * (yb + bias * z[r].y));
      v[r] = z[r]; v[4 + r] = make_float2(0.f, 0.f);
    }
  }
  float* YC = (float*)(p.ws + WS_YC) + (size_t)c * TT;
#pragma unroll
  for (int r = 0; r < 4; ++r) { const int t = j + r * TPF; YC[rowa + t] = z[r].x; YC[rowb + t] = z[r].y; }
  __syncthreads();
}

DI void fin_item(const Params& p, int l, int tile, float* lds) {
  const int tid = otid(), lane = tid & 63, wid = tid >> 6; const int rowb = tile * 64;
  const float* YS0 = (const float*)(p.ws + WS_YS); const float* YS1 = YS0 + (size_t)TT * 256;
  const float* RW = (const float*)(p.ws + WS_RW); const float* G = (const float*)(p.ws + WS_G); const float* BC = (const float*)(p.ws + WS_BC);
  u16* MC = (u16*)(p.ws + WS_MIXCAT);
  {
    const int l16 = lane & 15, sub = lane >> 4;
#pragma unroll 2
    for (int q = 0; q < 8; ++q) {
      const int pair = wid * 32 + q * 4 + sub, tok = pair >> 2, h = pair & 3, row = rowb + tok, c = h * 64 + l16 * 4;
      const float4 y0 = ldnt_f4(YS0 + (size_t)row * 256 + c), y1 = ldnt_f4(YS1 + (size_t)row * 256 + c);
      const float4 y = make_float4(y0.x + y1.x, y0.y + y1.y, y0.z + y1.z, y0.w + y1.w);
      const float mu = allreduce16(y.x + y.y + y.z + y.w) * (1.f / 64.f);
      const float4 dv = make_float4(y.x - mu, y.y - mu, y.z - mu, y.w - mu);
      const float var = allreduce16(dv.x * dv.x + dv.y * dv.y + dv.z * dv.z + dv.w * dv.w) * (1.f / 64.f);
      const float rs = rsqrtf(var + 64e-5f);
      const float4 lw = *(const float4*)(p.in[23] + l * 256 + c), lb = *(const float4*)(p.in[24] + l * 256 + c);
      const float4 v = ldnt_f4(RW + ((size_t)(row * 4 + h) * 9 + 2) * 64 + l16 * 4); const float bc = BC[(size_t)(row * 4 + h) * 8 + 4];
      const float4 g = ldnt_f4(G + (size_t)row * 256 + c);
      const float o0 = (dv.x * rs * lw.x + lb.x + bc * v.x) * g.x, o1 = (dv.y * rs * lw.y + lb.y + bc * v.y) * g.y;
      const float o2 = (dv.z * rs * lw.z + lb.z + bc * v.z) * g.z, o3 = (dv.w * rs * lw.w + lb.w + bc * v.w) * g.w;
      *(uint2*)(MC + (size_t)row * 1024 + c) = make_uint2(pack2(o0, o1), pack2(o2, o3));
    }
  }
  const float* YC = (const float*)(p.ws + WS_YC);
#pragma unroll
  for (int it = 0; it < 8; ++it) { const int idx = tid + it * 512; const int c = idx >> 4, t4 = (idx & 15) * 4;
    const float4 v = ldnt_f4(YC + (size_t)c * TT + rowb + t4); float* d = lds + c * 65 + t4; d[0] = v.x; d[1] = v.y; d[2] = v.z; d[3] = v.w; }
  __syncthreads();
#pragma unroll
  for (int it = 0; it < 8; ++it) { const int idx = tid + it * 512; const int tt = idx >> 6, c4 = (idx & 63) * 4;
    *(uint2*)(MC + (size_t)(rowb + tt) * 1024 + 768 + c4) = make_uint2(pack2(lds[c4 * 65 + tt], lds[(c4 + 1) * 65 + tt]), pack2(lds[(c4 + 2) * 65 + tt], lds[(c4 + 3) * 65 + tt])); }
  __syncthreads();
}

constexpr int NPH = 2 + 9 * 4;

DI void run_phase(const Params& p, int ph, unsigned char* smem) {
  float* lds = (float*)smem;
  PG8_LAS unsigned char* ldsp = (PG8_LAS unsigned char*)smem;
  const int nb = gridDim.x, bid = blockIdx.x;
  if (ph == 0) {
    int& s_ip = *(int*)(smem + 131072 + 28);
    unsigned* ctr0 = (unsigned*)(p.ws + WS_CTL + 16384) + 4 * 64;
    for (;;) {
      __syncthreads();
      if (threadIdx.x == 0) s_ip = (int)atomicAdd(ctr0, 1u);
      __syncthreads();
      const int q0 = s_ip;
      if (q0 >= 384 + AUX_ITEMS + 1 + 32) break;
      const int it = q0 < 288 ? 384 + AUX_ITEMS - 288 + q0 : (q0 - 288 < 384 + AUX_ITEMS - 288 ? q0 - 288 : q0);
      if (it < 384) mod_item(p, it, lds);
      else if (it < 384 + AUX_ITEMS) aux_item(p, 0, it - 384, lds);
      else if (it >= 384 + AUX_ITEMS + 1) {
        const int q = it - (384 + AUX_ITEMS + 1), ll = q >> 3, c0 = (q & 7) * 32; u16* WT = (u16*)(p.ws + WS_WTL);
        for (int e = otid(); e < 32 * 384; e += 512) { const int k = e >> 5, cc = e & 31, col = c0 + cc; float v;
          if (k < 64) v = p.in[16][((size_t)(ll * 2 + 0) * 64 + k) * 256 + col];
          else if (k < 128) v = p.in[16][((size_t)(ll * 2 + 1) * 64 + (k - 64)) * 256 + col];
          else if (k < 192) v = p.in[18][((size_t)(ll * 2 + 0) * 64 + (k - 128)) * 256 + col];
          else if (k < 256) v = p.in[18][((size_t)(ll * 2 + 1) * 64 + (k - 192)) * 256 + col];
          else v = p.in[19][((size_t)ll * 128 + (k - 256)) * 256 + col];
          WT[((size_t)ll * 256 + col) * 384 + k] = f2bf(v); }
      }
      else { float2* tab = (float2*)(p.ws + WS_ROPE); for (int e = otid(); e < 1024; e += 512) { const int pidx = e >> 4, i = e & 15;
               const float inv = exp2f(-(float)(2 * i) * (13.287712379549449f / 32.f)); const float ang = (float)pidx * inv; tab[e] = make_float2(cosf(ang), sinf(ang)); } }
    }
    return;
  }
  if (ph == 1) { row_phase(p, 0, 0);
#ifdef PROBE_R
    __syncthreads(); row_phase(p, 0, 0);
#endif
    return; }
  const int l = (ph - 2) / 9, k = (ph - 2) % 9;
  unsigned char* slot = p.ws + WS_W + (size_t)(l & 1) * W_SLOT;
  const u16* win = (const u16*)slot; const u16* wout = (const u16*)(slot + W_IN_B); const u16* wff1 = (const u16*)(slot + W_IN_B + W_OUT_B); const u16* wff2 = (const u16*)(slot + W_IN_B + W_OUT_B + W_FF_B);
  const int nrep = (k != 2 && k != 5 && k != 8 && ((PROBE_DUPK >> k) & 1)) ? 2 : 1;
  for (int rep = 0; rep < nrep; ++rep)
  switch (k) {
    case 0: { pg8::Gemm g{(const u16*)(p.ws + WS_H), win, TT, 3584, 1024}; pg8::StaticOrder S; S.init(TT, 3584, nb, bid);
              pg8::EpiU E{(u16*)(p.ws + WS_U), p.out, l}; pg8::gemm_phase(ldsp, g, S, E, nullptr);
#ifdef PROBE_G
              __syncthreads(); pg8::gemm_phase(ldsp, g, S, E, nullptr);
#endif
              } break;
    case 1: {
      int& s_it = *(int*)(smem + 131072 + 24);
#ifdef PROBE_P
      _Pragma("unroll") for (int pp_ = 0; pp_ < 2; ++pp_) {
      unsigned* ctr = (unsigned*)(p.ws + WS_CTL + 16384) + l * 64 + 32 + pp_ * 8;
#else
      {
      unsigned* ctr = (unsigned*)(p.ws + WS_CTL + 16384) + l * 64 + 32;
#endif
      for (;;) {
        __syncthreads();
        if (threadIdx.x == 0) s_it = (int)atomicAdd(ctr, 1u);
        __syncthreads();
        const int it = s_it;
        if (it >= 1280) break;
        if (it < 384) rwkv_prep_item(p, l, it, lds);
        else if (it < 576) hy_prep_item(p, l, it - 384, lds);
        else if (it < 960) attn_prep_item(p, l, it - 576, lds);
        else if (it < 1216) hspec_item(p, 1, it - 960, lds);
        else if (it < 1248) hspec_item(p, 0, it - 1216, lds);
        else cache_item(p, l, it - 1248, lds);
      }
      }
    } break;
    case 2: {
      int& s_item = *(int*)(smem + 131072 + 16); float& s_lam = *(float*)(smem + 131072 + 20);
      const float lam_init = 0.8f - 0.6f * expf(-0.3f * (float)l);
      const int tid2 = otid();
      if (tid2 < 64) {
        int ln = tid2; float a = p.in[25][l * 64 + ln] * p.in[26][l * 64 + ln]; float b = p.in[27][l * 64 + ln] * p.in[28][l * 64 + ln];
        a = wave_sum(a); b = wave_sum(b); if (ln == 0) s_lam = expf(a) - expf(b) + lam_init;
      }
      __syncthreads();
      const float lam = s_lam;
#ifdef PROBE_M
      const int npass = 2;
#else
      const int npass = 1;
#endif
      _Pragma("unroll") for (int pass = 0; pass < npass; ++pass) {
      unsigned* ctr = (unsigned*)(p.ws + WS_CTL + 16384) + l * 64 + pass * 16;
      const int mask = pass == 0 ? 7 : PROBE_MIXMASK;
      for (;;) {
        __syncthreads();
        if (threadIdx.x == 0) s_item = (int)atomicAdd(ctr, 1u);
        __syncthreads();
        int it = s_item;
        if (it >= 1536) break;
        if (it < 128) { if (mask & 1) scan_item(p, l, 16 + (it >> 5), (it >> 3) & 3, (it >> 2) & 1, it & 3, 4, lds); }
        else if (it < 384) { int j = it - 128; if (mask & 2) attn_item(p, l, 16 + (j >> 6), (j >> 4) & 3, j & 15, smem, lam, lam_init); }
        else if (it < 640) { int j = it - 384; if (mask & 1) scan_item(p, l, j >> 4, (j >> 2) & 3, (j >> 1) & 1, j & 1, 8, lds); }
        else if (it < 1152) { int j = it - 640; if (mask & 4) hyena_fft_item(p, l, 1, j, lds); }
        else if (it < 1280) { int j = it - 1152; if (mask & 2) attn_item(p, l, j >> 3, (j >> 1) & 3, j & 1, smem, lam, lam_init); }
        else { int j = it - 1280; if (mask & 4) hyena_fft_item(p, l, 0, j, lds); }
      }
      }
    } break;
    case 3: for (int it = bid; it < 192; it += nb) fin_item(p, l, it, lds);
#ifdef PROBE_F
      for (int it = bid; it < 192; it += nb) fin_item(p, l, it, lds);
#endif
      break;
    case 4: { pg8::Gemm g{(const u16*)(p.ws + WS_MIXCAT), wout, TT, 1024, 1024}; pg8::StaticOrder S; S.init(TT, 1024, nb, bid);
              pg8::EpiBf E{(u16*)(p.ws + WS_F), 1024}; pg8::gemm_phase(ldsp, g, S, E, nullptr);
#ifdef PROBE_G
              __syncthreads(); pg8::gemm_phase(ldsp, g, S, E, nullptr);
#endif
              } break;
    case 5:
      row_phase(p, l, 1);
      if (l < 3) {
        int& s_ia = *(int*)(smem + 131072 + 28);
        unsigned* ctr = (unsigned*)(p.ws + WS_CTL + 16384) + l * 64 + 48;
        for (;;) {
          __syncthreads();
          if (threadIdx.x == 0) s_ia = (int)atomicAdd(ctr, 1u);
          __syncthreads();
          const int q = s_ia;
          if (q >= AUX_ITEMS) break;
          aux_item(p, l + 1, q < 288 ? AUX_ITEMS - 288 + q : q - 288, lds);
        }
      }
#ifdef PROBE_A
      if (l < 3) for (int it = bid; it < AUX_ITEMS; it += nb) aux_item(p, l + 1, it, lds);
#endif
#ifdef PROBE_A1
      if (l < 3) for (int it = bid; it < AUX_ITEMS - 288; it += nb) aux_item(p, l + 1, it, lds);
#endif
#ifdef PROBE_A2
      if (l < 3) for (int it = AUX_ITEMS - 288 + bid; it < AUX_ITEMS; it += nb) aux_item(p, l + 1, it, lds);
#endif
      break;
    case 6: { pg8::Gemm g{(const u16*)(p.ws + WS_H), wff1, TT, 4096, 1024}; pg8::StaticOrder S; S.init(TT, 4096, nb, bid);
              pg8::EpiRelu2 E{(u16*)(p.ws + WS_A), 4096}; pg8::gemm_phase(ldsp, g, S, E, nullptr);
#ifdef PROBE_G
              __syncthreads(); pg8::gemm_phase(ldsp, g, S, E, nullptr);
#endif
              } break;
    case 7: { pg8::Gemm g{(const u16*)(p.ws + WS_A), wff2, TT, 1024, 4096}; pg8::StaticOrder S; S.init(TT, 1024, nb, bid);
              pg8::EpiBf E{(u16*)(p.ws + WS_F), 1024}; pg8::gemm_phase(ldsp, g, S, E, nullptr);
#ifdef PROBE_G
              __syncthreads(); pg8::gemm_phase(ldsp, g, S, E, nullptr);
#endif
              } break;
    case 8: row_phase(p, l, 2); break;
  }
}

__global__ void __launch_bounds__(512) mega(Params p, int ph_lo, int ph_hi) {
  extern __shared__ __attribute__((aligned(16))) unsigned char smem[];
  uint4& xb_words = *(uint4*)(smem + 131072);
  if (threadIdx.x == 0) xb_words = make_uint4(0u, 0u, 0u, 0u);
  __syncthreads();
  (void)xcd_barrier_post((unsigned*)(p.ws + WS_CTL), (volatile LAS unsigned*)&xb_words);
  for (int ph = ph_lo; ph < ph_hi; ++ph) {
    if (ph > ph_lo) { XcdBarrier xb; xb.bar = (unsigned*)(p.ws + WS_CTL); xb.x = xb_xcc_id(); xb.st = (volatile LAS unsigned*)(smem + 131072); xcd_barrier(xb);
#ifdef PROBE_B
      xcd_barrier(xb);
#endif
    }
    run_phase(p, ph, smem);
  }
}

extern "C" void kernel_launch(void* const* d_in, const int* in_sizes, int n_in, void* d_out, int out_size, void* d_ws, size_t ws_size, hipStream_t stream) {
  static int grid = 0;
  if (!grid) {
    int dev = 0, cus = 0, per_cu = 0;
    hipGetDevice(&dev);
    hipDeviceGetAttribute(&cus, hipDeviceAttributeMultiprocessorCount, dev);
    hipFuncSetAttribute((const void*)mega, hipFuncAttributeMaxDynamicSharedMemorySize, (int)LDS_BYTES);
    hipOccupancyMaxActiveBlocksPerMultiprocessor(&per_cu, (const void*)mega, NT, LDS_BYTES);
    if (per_cu < 1) { fprintf(stderr, "occupancy query says %d blocks/CU\n", per_cu); per_cu = 1; }
    grid = cus;
  }
  if (n_in != 43 || ws_size < WS_END) { fprintf(stderr, "kernel_launch: bad n_in %d or ws %zu < %zu\n", n_in, ws_size, (size_t)WS_END); return; }
  Params p{};
  for (int i = 0; i < 43; ++i) p.in[i] = (const float*)d_in[i];
  p.out = (float*)d_out; p.ws = (unsigned char*)d_ws;
  (void)hipMemsetAsync((unsigned char*)d_ws + WS_CTL, 0, 32768, stream);
#if ONE_LAUNCH
  int lo = 0, hi = NPH; void* args[] = {&p, &lo, &hi};
  hipError_t e = hipLaunchCooperativeKernel((const void*)mega, dim3(grid), dim3(NT), args, LDS_BYTES, stream);
  if (e != hipSuccess) fprintf(stderr, "cooperative launch failed: %s\n", hipGetErrorString(e));
#else
  for (int ph = 0; ph < NPH; ++ph) hipLaunchKernelGGL(mega, dim3(grid), dim3(NT), LDS_BYTES, stream, p, ph, ph + 1);
#endif
}
```
